# Optimizing an MI355X kernel written in HIP

```python
import math
import jax
import jax.numpy as jnp
from jax import lax
import numpy as np

D_MODEL = 1024
BATCH = 16
SEQ = 2048
DEPTH = 1

CHUNK = 64
EPS = 1e-6

ATTN_HEAD_DIM = 64
ATTN_WIDTH = D_MODEL // 2
ATTN_HEADS = ATTN_WIDTH // ATTN_HEAD_DIM
LEFT_CHUNKS = 8
BAND = (LEFT_CHUNKS + 1) * CHUNK
REL_CLIP = 128
N_REL = 2 * REL_CLIP + 1

DN_HEAD_DIM = 128
DN_WIDTH = D_MODEL - ATTN_WIDTH
DN_HEADS = DN_WIDTH // DN_HEAD_DIM
CONV_WIDTH = 4

MIX_WIDTH = ATTN_WIDTH + DN_WIDTH
IN_PROJ_WIDTH = 3 * ATTN_WIDTH + 4 * DN_WIDTH + 2 * DN_HEADS

PEER_HEADS = 8
PEER_KEY_DIM = 256
PEER_HALF = PEER_KEY_DIM // 2
N_KEYS = 128
N_EXPERTS = N_KEYS * N_KEYS
PEER_TOPK = 16
PEER_BLOCK = 128

kernel_name = "hymba_chunkattn_gdn_peer_adaln"


def rms_norm(x, gain):
    xf = x.astype(jnp.float32)
    y = xf * lax.rsqrt(jnp.mean(xf * xf, axis=-1, keepdims=True) + EPS)
    return (y * gain.astype(jnp.float32)).astype(x.dtype)


def l2_norm(x):
    xf = x.astype(jnp.float32)
    return xf * lax.rsqrt(jnp.sum(xf * xf, axis=-1, keepdims=True) + EPS)


def modulate(h, shift, scale):
    return h * (1.0 + scale) + shift


def chunked_band_attention(q, k, v, q_gain, k_gain, rel_bias):
    B, S = q.shape[:2]
    nc = S // CHUNK
    shp = (B, nc, CHUNK, ATTN_HEADS, ATTN_HEAD_DIM)
    pad = ((0, 0), (LEFT_CHUNKS, 0), (0, 0), (0, 0), (0, 0))
    q = rms_norm(q, q_gain).reshape(shp)
    k = jnp.pad(rms_norm(k, k_gain).reshape(shp), pad)
    v = jnp.pad(v.reshape(shp), pad)
    band_idx = np.arange(nc)[:, None] + np.arange(LEFT_CHUNKS + 1)[None, :]
    kb = k[:, band_idx].reshape(B, nc, BAND, ATTN_HEADS, ATTN_HEAD_DIM)
    vb = v[:, band_idx].reshape(B, nc, BAND, ATTN_HEADS, ATTN_HEAD_DIM)
    scores = jnp.einsum("bnqhd,bnkhd->bhnqk", q, kb,
                        preferred_element_type=jnp.float32) * (ATTN_HEAD_DIM ** -0.5)
    rel = np.arange(CHUNK)[:, None] + LEFT_CHUNKS * CHUNK - np.arange(BAND)[None, :]
    rel_idx = np.clip(rel, -REL_CLIP, REL_CLIP) + REL_CLIP
    bias = rel_bias.astype(jnp.float32)[:, rel_idx]
    valid = (np.arange(nc)[:, None] + np.arange(BAND)[None, :] // CHUNK) >= LEFT_CHUNKS
    scores = jnp.where(valid[None, None, :, None, :], scores + bias[None, :, None], -jnp.inf)
    p = jax.nn.softmax(scores, axis=-1).astype(vb.dtype)
    o = jnp.einsum("bhnqk,bnkhd->bnqhd", p, vb)
    return o.reshape(B, S, ATTN_WIDTH)


def causal_depthwise_conv(x, w):
    S = x.shape[1]
    xp = jnp.pad(x, ((0, 0), (CONV_WIDTH - 1, 0), (0, 0)))
    y = xp[:, 0:S] * w[0]
    for i in range(1, CONV_WIDTH):
        y = y + xp[:, i:i + S] * w[i]
    return jax.nn.silu(y)


def gated_delta_rule(q, k, v, g, beta):
    B, S, H, Dk = q.shape
    Dv = v.shape[-1]
    nc = S // CHUNK

    def to_chunks(t):
        return t.astype(jnp.float32).reshape(B, nc, CHUNK, H, -1).transpose(1, 0, 3, 2, 4)

    q = to_chunks(q) * (Dk ** -0.5)
    k = to_chunks(k)
    v = to_chunks(v)
    g = g.astype(jnp.float32).reshape(B, nc, CHUNK, H).transpose(1, 0, 3, 2)
    beta = beta.astype(jnp.float32).reshape(B, nc, CHUNK, H).transpose(1, 0, 3, 2)
    gc = jnp.cumsum(g, axis=-1)
    tri = np.tril(np.ones((CHUNK, CHUNK), dtype=bool))
    strict = np.tril(np.ones((CHUNK, CHUNK), dtype=bool), -1)
    decay = jnp.exp(jnp.where(tri, gc[..., :, None] - gc[..., None, :], -jnp.inf))
    k_beta = k * beta[..., None]
    v_beta = v * beta[..., None]
    lower = jnp.where(strict, jnp.einsum("nbhid,nbhjd->nbhij", k_beta, k) * decay, 0.0)
    rhs = jnp.concatenate([v_beta, k_beta * jnp.exp(gc)[..., None]], axis=-1)
    sol = lax.linalg.triangular_solve(jnp.eye(CHUNK, dtype=jnp.float32) + lower, rhs,
                                      left_side=True, lower=True, unit_diagonal=True)
    u = sol[..., :Dv]
    w = sol[..., Dv:]
    intra = jnp.einsum("nbhid,nbhjd->nbhij", q, k) * decay

    def step(state, xs):
        q_c, k_c, u_c, w_c, a_c, g_c = xs
        v_new = u_c - jnp.einsum("bhcd,bhde->bhce", w_c, state)
        o = (jnp.einsum("bhcd,bhde->bhce", q_c * jnp.exp(g_c)[..., None], state)
             + jnp.einsum("bhij,bhje->bhie", a_c, v_new))
        g_last = g_c[..., -1]
        k_dec = k_c * jnp.exp(g_last[..., None] - g_c)[..., None]
        state = state * jnp.exp(g_last)[..., None, None] + jnp.einsum("bhcd,bhce->bhde", k_dec, v_new)
        return state, o

    state0 = jnp.zeros((B, H, Dk, Dv), jnp.float32)
    _, o = lax.scan(step, state0, (q, k, u, w, intra, gc))
    return o.transpose(1, 0, 3, 2, 4).reshape(B, S, H, Dv)


def peer(h, w_query, query_gain, sub_keys_1, sub_keys_2, expert_down, expert_up):
    B, S, D = h.shape
    n_blocks = (B * S) // PEER_BLOCK

    def block(hb):
        qry = (hb @ w_query).reshape(PEER_BLOCK, PEER_HEADS, PEER_KEY_DIM)
        qry = rms_norm(qry, query_gain)
        s1 = jnp.einsum("thd,nd->thn", qry[..., :PEER_HALF], sub_keys_1, preferred_element_type=jnp.float32)
        s2 = jnp.einsum("thd,nd->thn", qry[..., PEER_HALF:], sub_keys_2, preferred_element_type=jnp.float32)
        v1, i1 = lax.top_k(s1, PEER_TOPK)
        v2, i2 = lax.top_k(s2, PEER_TOPK)
        cand_s = (v1[..., :, None] + v2[..., None, :]).reshape(PEER_BLOCK, PEER_HEADS, PEER_TOPK * PEER_TOPK)
        cand_i = (i1[..., :, None] * N_KEYS + i2[..., None, :]).reshape(PEER_BLOCK, PEER_HEADS, PEER_TOPK * PEER_TOPK)
        top_s, pos = lax.top_k(cand_s, PEER_TOPK)
        experts = jnp.take_along_axis(cand_i, pos, axis=-1)
        gates = jax.nn.softmax(top_s, axis=-1)
        u = expert_down[experts]
        vv = expert_up[experts]
        act = jax.nn.gelu(jnp.einsum("thkd,td->thk", u, hb, preferred_element_type=jnp.float32),
                          approximate=False)
        return jnp.einsum("thk,thkd->td", (gates * act).astype(vv.dtype), vv)

    out = lax.map(block, h.reshape(n_blocks, PEER_BLOCK, D))
    return out.reshape(B, S, D)


def hybrid_layer(x, c, w_ada, b_ada, norm1_gain, w_in, attn_q_gain, attn_k_gain, attn_rel_bias,
                 attn_out_gain, dn_conv_w, dn_a_log, dn_dt_bias, dn_out_gain, w_out, norm2_gain,
                 peer_w_query, peer_query_gain, peer_sub_keys_1, peer_sub_keys_2,
                 peer_expert_down, peer_expert_up):
    B, S, _ = x.shape
    mod = jax.nn.silu(c) @ w_ada + b_ada
    shift1, scale1, gate1, shift2, scale2, gate2 = [m[:, None, :] for m in jnp.split(mod, 6, axis=-1)]

    h = modulate(rms_norm(x, norm1_gain), shift1, scale1)
    proj = h @ w_in
    cuts = [ATTN_WIDTH, 2 * ATTN_WIDTH, 3 * ATTN_WIDTH, 3 * ATTN_WIDTH + 3 * DN_WIDTH,
            3 * ATTN_WIDTH + 4 * DN_WIDTH, 3 * ATTN_WIDTH + 4 * DN_WIDTH + DN_HEADS]
    qa, ka, va, qkv_b, z_b, b_raw, a_raw = jnp.split(proj, cuts, axis=-1)

    hd_a = (B, S, ATTN_HEADS, ATTN_HEAD_DIM)
    o_a = chunked_band_attention(qa.reshape(hd_a), ka.reshape(hd_a), va.reshape(hd_a),
                                 attn_q_gain, attn_k_gain, attn_rel_bias)
    o_a = rms_norm(o_a, attn_out_gain)

    qkv_b = causal_depthwise_conv(qkv_b, dn_conv_w)
    q_b, k_b, v_b = jnp.split(qkv_b, 3, axis=-1)
    hd_b = (B, S, DN_HEADS, DN_HEAD_DIM)
    q_b = l2_norm(q_b.reshape(hd_b))
    k_b = l2_norm(k_b.reshape(hd_b))
    beta = jax.nn.sigmoid(b_raw.astype(jnp.float32))
    g = -jnp.exp(dn_a_log.astype(jnp.float32)) * jax.nn.softplus(
        a_raw.astype(jnp.float32) + dn_dt_bias.astype(jnp.float32))
    o_b = gated_delta_rule(q_b, k_b, v_b.reshape(hd_b), g, beta)
    o_b = rms_norm(o_b, dn_out_gain) * jax.nn.silu(z_b.reshape(hd_b).astype(jnp.float32))
    o_b = o_b.reshape(B, S, DN_WIDTH).astype(x.dtype)

    mix = jnp.concatenate([o_a, o_b], axis=-1) @ w_out
    x = x + gate1 * mix

    h2 = modulate(rms_norm(x, norm2_gain), shift2, scale2)
    y = peer(h2, peer_w_query, peer_query_gain, peer_sub_keys_1, peer_sub_keys_2,
             peer_expert_down, peer_expert_up)
    return x + gate2 * y


def setup_inputs(seed: int = 0) -> dict:
    key = jax.random.key(seed)
    ks = iter(jax.random.split(key, 32))
    L = DEPTH

    def nrm(shape, scale):
        return scale * jax.random.normal(next(ks), shape, jnp.float32)

    def gain(shape):
        return 1.0 + nrm(shape, 0.02)

    x = nrm((BATCH, SEQ, D_MODEL), 1.0)
    c = nrm((BATCH, D_MODEL), 1.0)
    w_ada = nrm((L, D_MODEL, 6 * D_MODEL), 0.5 * D_MODEL ** -0.5)
    b_ada = nrm((L, 6 * D_MODEL), 0.02)
    norm1_gain = gain((L, D_MODEL))
    w_in = nrm((L, D_MODEL, IN_PROJ_WIDTH), D_MODEL ** -0.5)
    attn_q_gain = gain((L, ATTN_HEAD_DIM))
    attn_k_gain = gain((L, ATTN_HEAD_DIM))
    attn_rel_bias = nrm((L, ATTN_HEADS, N_REL), 0.5)
    attn_out_gain = gain((L, ATTN_WIDTH))
    dn_conv_w = nrm((L, CONV_WIDTH, 3 * DN_WIDTH), CONV_WIDTH ** -0.5)
    dn_a_log = jnp.log(jax.random.uniform(next(ks), (L, DN_HEADS), jnp.float32, 1.0, 16.0))
    dt = jnp.exp(jax.random.uniform(next(ks), (L, DN_HEADS), jnp.float32,
                                    math.log(1e-3), math.log(1e-1)))
    dn_dt_bias = dt + jnp.log(-jnp.expm1(-dt))
    dn_out_gain = gain((L, DN_HEAD_DIM))
    w_out = nrm((L, MIX_WIDTH, D_MODEL), MIX_WIDTH ** -0.5)
    norm2_gain = gain((L, D_MODEL))
    peer_w_query = nrm((L, D_MODEL, PEER_HEADS * PEER_KEY_DIM), D_MODEL ** -0.5)
    peer_query_gain = gain((L, PEER_KEY_DIM))
    peer_sub_keys_1 = nrm((L, N_KEYS, PEER_HALF), PEER_HALF ** -0.5)
    peer_sub_keys_2 = nrm((L, N_KEYS, PEER_HALF), PEER_HALF ** -0.5)
    peer_expert_down = nrm((L, N_EXPERTS, D_MODEL), D_MODEL ** -0.5)
    peer_expert_up = nrm((L, N_EXPERTS, D_MODEL), 0.5)
    return {"x": x, "c": c, "w_ada": w_ada, "b_ada": b_ada, "norm1_gain": norm1_gain,
            "w_in": w_in, "attn_q_gain": attn_q_gain, "attn_k_gain": attn_k_gain,
            "attn_rel_bias": attn_rel_bias, "attn_out_gain": attn_out_gain,
            "dn_conv_w": dn_conv_w, "dn_a_log": dn_a_log, "dn_dt_bias": dn_dt_bias,
            "dn_out_gain": dn_out_gain, "w_out": w_out, "norm2_gain": norm2_gain,
            "peer_w_query": peer_w_query, "peer_query_gain": peer_query_gain,
            "peer_sub_keys_1": peer_sub_keys_1, "peer_sub_keys_2": peer_sub_keys_2,
            "peer_expert_down": peer_expert_down, "peer_expert_up": peer_expert_up}


def reference(x, c, w_ada, b_ada, norm1_gain, w_in, attn_q_gain, attn_k_gain, attn_rel_bias,
              attn_out_gain, dn_conv_w, dn_a_log, dn_dt_bias, dn_out_gain, w_out, norm2_gain,
              peer_w_query, peer_query_gain, peer_sub_keys_1, peer_sub_keys_2,
              peer_expert_down, peer_expert_up):
    for layer in range(DEPTH):
        x = hybrid_layer(x, c, w_ada[layer], b_ada[layer], norm1_gain[layer], w_in[layer],
                         attn_q_gain[layer], attn_k_gain[layer], attn_rel_bias[layer],
                         attn_out_gain[layer], dn_conv_w[layer], dn_a_log[layer], dn_dt_bias[layer],
                         dn_out_gain[layer], w_out[layer], norm2_gain[layer], peer_w_query[layer],
                         peer_query_gain[layer], peer_sub_keys_1[layer], peer_sub_keys_2[layer],
                         peer_expert_down[layer], peer_expert_up[layer])
    return x
```

```cpp
#include <hip/hip_runtime.h>
#include <hip/hip_cooperative_groups.h>
#include <cstdio>
#include <cstdint>
namespace cg = cooperative_groups;

#ifndef MULTI_LAUNCH
#define MULTI_LAUNCH 1
#endif

typedef unsigned short bf16_t;
typedef short bf16x8 __attribute__((ext_vector_type(8)));
typedef float f32x4 __attribute__((ext_vector_type(4)));
typedef float f32x16 __attribute__((ext_vector_type(16)));
typedef unsigned u32x4 __attribute__((ext_vector_type(4)));
typedef unsigned u32x2 __attribute__((ext_vector_type(2)));
typedef __bf16 bf16x2_t __attribute__((ext_vector_type(2)));

constexpr int NB = 16, SEQ = 2048, DM = 1024, NTOK = NB * SEQ;
constexpr int CH = 64, NCH = SEQ / CH;
constexpr int AH = 8, AHD = 64;
constexpr int DH = 4, DHD = 128;
constexpr int IPW = 3592, NPAD = 3712;
constexpr int PBW = 2048;
constexpr int NEXP = 16384;
constexpr float EPS = 1e-6f;
constexpr int NTHREADS = 512;

constexpr size_t MiB = 1u << 20;
constexpr size_t WS_MOD = 1 * MiB;
constexpr size_t WS_SK = 2 * MiB;
constexpr size_t WS_WINT = 3 * MiB;
constexpr size_t WS_WOUTT = 11 * MiB;
constexpr size_t WS_WQT = 13 * MiB;
constexpr size_t WS_ED = 17 * MiB;
constexpr size_t WS_EU = 49 * MiB;
constexpr size_t WS_H = 81 * MiB;
constexpr size_t WS_PB = 145 * MiB;
constexpr size_t WS_QA = 273 * MiB;
constexpr size_t WS_KA = 305 * MiB;
constexpr size_t WS_VT = 337 * MiB;
constexpr size_t WS_QP = 369 * MiB;
constexpr size_t WS_OL = 401 * MiB;
constexpr size_t WS_BETA = 433 * MiB;
constexpr size_t WS_G = 433 * MiB + 512 * 1024;
constexpr size_t WS_EGL = 434 * MiB;
constexpr size_t WS_NEGM = 435 * MiB;
constexpr size_t WS_END = 499 * MiB;
constexpr size_t WS_SNT = WS_QA;
constexpr size_t WS_IDS = WS_QA;
constexpr size_t WS_GATES = WS_QA + 16 * MiB;

struct Params {
    const float *x, *c, *w_ada, *b_ada, *norm1_gain, *w_in, *q_gain, *k_gain, *rel_bias, *attn_out_gain, *conv_w, *a_log, *dt_bias,
        *dn_out_gain, *w_out, *norm2_gain, *w_query, *query_gain, *sk1, *sk2, *e_down, *e_up;
    float* out;
    unsigned char* ws;
};

__device__ __forceinline__ unsigned f2bf(float f) { unsigned u = __float_as_uint(f); return (u + 0x7fffu + ((u >> 16) & 1u)) >> 16; }
__device__ __forceinline__ unsigned pk2(float lo, float hi) { return f2bf(lo) | (f2bf(hi) << 16); }
__device__ __forceinline__ float bflo(unsigned u) { return __uint_as_float(u << 16); }
__device__ __forceinline__ float bfhi(unsigned u) { return __uint_as_float(u & 0xffff0000u); }
__device__ __forceinline__ float bf2f(bf16_t v) { return __uint_as_float(((unsigned)v) << 16); }
__device__ __forceinline__ float silu_f(float v) { return v / (1.0f + __expf(-v)); }
__device__ __forceinline__ float dot2bf(unsigned a, unsigned b, float acc) {
    return __builtin_amdgcn_fdot2_f32_bf16(__builtin_bit_cast(bf16x2_t, a), __builtin_bit_cast(bf16x2_t, b), acc, false);
}
__device__ __forceinline__ f32x4 mfma16(bf16x8 a, bf16x8 b, f32x4 c) { return __builtin_amdgcn_mfma_f32_16x16x32_bf16(a, b, c, 0, 0, 0); }
__device__ __forceinline__ f32x16 mfma32(bf16x8 a, bf16x8 b, f32x16 c) { return __builtin_amdgcn_mfma_f32_32x32x16_bf16(a, b, c, 0, 0, 0); }
__device__ __forceinline__ bf16x8 pack8(float a0, float a1, float a2, float a3, float a4, float a5, float a6, float a7) {
    u32x4 u; u.x = pk2(a0, a1); u.y = pk2(a2, a3); u.z = pk2(a4, a5); u.w = pk2(a6, a7); return __builtin_bit_cast(bf16x8, u);
}
__device__ __forceinline__ int swap23(int v) { return (v & ~12) | ((v & 4) << 1) | ((v & 8) >> 1); }

constexpr int LDS_BYTES = 153600;

__device__ void phase0(const Params& P, unsigned char* lds, int bid, int nblk) {
    const int tid = threadIdx.x;
    float* sc = (float*)lds;
    float* red = (float*)(lds + 65536);
    float* tile = (float*)(lds + 98304);
    float* mod = (float*)(P.ws + WS_MOD);
    if (bid < 384) {
        for (int e = tid; e < 16384; e += NTHREADS) { int b = e >> 10, k = e & 1023; float v = P.c[e]; sc[k * 16 + b] = silu_f(v); }
        __syncthreads();
        for (int it = bid; it < 384; it += nblk) {
            const int j0 = it * 16, cl = tid & 15, kg = tid >> 4;
            float acc[16];
#pragma unroll
            for (int b = 0; b < 16; ++b) acc[b] = 0.f;
            for (int i = 0; i < 32; ++i) {
                const int k = kg + 32 * i;
                const float w = P.w_ada[(size_t)k * 6144 + j0 + cl];
                const f32x4* sp = (const f32x4*)(sc + k * 16);
#pragma unroll
                for (int q = 0; q < 4; ++q) { f32x4 s4 = sp[q]; acc[4 * q] += s4[0] * w; acc[4 * q + 1] += s4[1] * w; acc[4 * q + 2] += s4[2] * w; acc[4 * q + 3] += s4[3] * w; }
            }
#pragma unroll
            for (int b = 0; b < 16; ++b) red[(kg * 16 + b) * 16 + cl] = acc[b];
            __syncthreads();
            if (tid < 256) {
                const int b = tid >> 4, c2 = tid & 15; float s = 0.f;
                for (int g = 0; g < 32; ++g) s += red[(g * 16 + b) * 16 + c2];
                mod[b * 6144 + j0 + c2] = s + P.b_ada[j0 + c2];
            }
            __syncthreads();
        }
    }
    for (int it = bid; it < 928 + 256 + 512; it += nblk) {
        const float* src; bf16_t* dst; int N, nt, kt;
        if (it < 928) { src = P.w_in; dst = (bf16_t*)(P.ws + WS_WINT); N = IPW; nt = it % 58; kt = it / 58; }
        else if (it < 928 + 256) { const int r = it - 928; src = P.w_out; dst = (bf16_t*)(P.ws + WS_WOUTT); N = 1024; nt = r % 16; kt = r / 16; }
        else { const int r = it - 1184; src = P.w_query; dst = (bf16_t*)(P.ws + WS_WQT); N = 2048; nt = r % 32; kt = r / 32; }
        const int n0 = nt * 64, k0 = kt * 64;
        {
            const int nl = tid & 63, kb = tid >> 6;
#pragma unroll
            for (int i = 0; i < 8; ++i) { const int kk = kb + 8 * i; const int n = n0 + nl; tile[kk * 65 + nl] = (n < N) ? src[(size_t)(k0 + kk) * N + n] : 0.f; }
        }
        __syncthreads();
        {
            const int kl = (tid & 7) * 8, nl = tid >> 3;
            u32x4 o;
            o.x = pk2(tile[(kl + 0) * 65 + nl], tile[(kl + 1) * 65 + nl]); o.y = pk2(tile[(kl + 2) * 65 + nl], tile[(kl + 3) * 65 + nl]);
            o.z = pk2(tile[(kl + 4) * 65 + nl], tile[(kl + 5) * 65 + nl]); o.w = pk2(tile[(kl + 6) * 65 + nl], tile[(kl + 7) * 65 + nl]);
            *(u32x4*)(dst + (size_t)(n0 + nl) * 1024 + k0 + kl) = o;
        }
        __syncthreads();
    }
    {
        const size_t total = (size_t)2 * NEXP * 1024 / 8;
        const size_t half = (size_t)NEXP * 1024 / 8;
        for (size_t g = (size_t)bid * NTHREADS + tid; g < total; g += (size_t)nblk * NTHREADS) {
            const bool up = g >= half; const size_t gg = up ? g - half : g;
            const float* s = (up ? P.e_up : P.e_down) + gg * 8;
            bf16_t* d = (bf16_t*)(P.ws + (up ? WS_EU : WS_ED)) + gg * 8;
            const f32x4 a = *(const f32x4*)s, b = *(const f32x4*)(s + 4);
            u32x4 o; o.x = pk2(a[0], a[1]); o.y = pk2(a[2], a[3]); o.z = pk2(b[0], b[1]); o.w = pk2(b[2], b[3]);
            *(u32x4*)d = o;
        }
    }
    {
        const int gid = bid * NTHREADS + tid;
        if (gid < 32768) {
            const int p = gid >> 14, rem = gid & 16383, d = rem & 127;
            const float v = (p ? P.sk2 : P.sk1)[rem] * P.query_gain[128 * p + d];
            ((bf16_t*)(P.ws + WS_SK))[gid] = (bf16_t)f2bf(v);
        }
    }
}

__device__ void norm_mod_phase(const float* __restrict__ src, const float* __restrict__ gain, const float* __restrict__ mod, int shift_off, int scale_off,
                               bf16_t* __restrict__ dst, int bid, int nblk) {
    const int lane = threadIdx.x & 63, wid = threadIdx.x >> 6;
    for (int row = bid * 8 + wid; row < NTOK; row += nblk * 8) {
        const int b = row >> 11;
        f32x4 v[4]; float ss = 0.f;
#pragma unroll
        for (int i = 0; i < 4; ++i) { v[i] = *(const f32x4*)(src + (size_t)row * DM + 256 * i + 4 * lane); ss += v[i][0] * v[i][0] + v[i][1] * v[i][1] + v[i][2] * v[i][2] + v[i][3] * v[i][3]; }
#pragma unroll
        for (int o = 32; o > 0; o >>= 1) ss += __shfl_xor(ss, o);
        const float rstd = rsqrtf(ss * (1.0f / DM) + EPS);
#pragma unroll
        for (int i = 0; i < 4; ++i) {
            const int c = 256 * i + 4 * lane;
            const f32x4 g = *(const f32x4*)(gain + c), sh = *(const f32x4*)(mod + b * 6144 + shift_off + c), sc = *(const f32x4*)(mod + b * 6144 + scale_off + c);
            float y[4];
#pragma unroll
            for (int j = 0; j < 4; ++j) y[j] = v[i][j] * rstd * g[j] * (1.0f + sc[j]) + sh[j];
            u32x2 o; o.x = pk2(y[0], y[1]); o.y = pk2(y[2], y[3]);
            *(u32x2*)(dst + (size_t)row * DM + c) = o;
        }
    }
}

__device__ __forceinline__ int swz(int row, int ch) { return row * 128 + ((ch ^ (row & 7)) << 4); }

template <class Epi>
__device__ void gemm_phase(const bf16_t* __restrict__ A, const bf16_t* __restrict__ Bt, int M, int N, int K, const Epi& epi, unsigned char* lds, int bid, int nblk) {
    const int tid = threadIdx.x, wid = tid >> 6, lane = tid & 63, wr = wid >> 1, wc = wid & 1, fr = lane & 15, fq = lane >> 4;
    const int nM = M / 256, nN = N / 128, ntiles = nM * nN, nk = K / 64;
    for (int tl = bid; tl < ntiles; tl += nblk) {
        const int pm = tl / nN, pn = tl % nN;
        const bf16_t* Ag = A + (size_t)pm * 256 * K;
        const bf16_t* Bg = Bt + (size_t)pn * 128 * K;
        u32x4 ra[4], rb[2];
        auto gload = [&](int kt) {
#pragma unroll
            for (int i = 0; i < 4; ++i) { const int c = tid + 512 * i, row = c >> 3, ch = c & 7; ra[i] = *(const u32x4*)(Ag + (size_t)row * K + kt * 64 + ch * 8); }
#pragma unroll
            for (int i = 0; i < 2; ++i) { const int c = tid + 512 * i, row = c >> 3, ch = c & 7; rb[i] = *(const u32x4*)(Bg + (size_t)row * K + kt * 64 + ch * 8); }
        };
        auto lstore = [&](int buf) {
            unsigned char* xs = lds + buf * 49152; unsigned char* wsm = xs + 32768;
#pragma unroll
            for (int i = 0; i < 4; ++i) { const int c = tid + 512 * i, row = c >> 3, ch = c & 7; *(u32x4*)(xs + swz(row, ch)) = ra[i]; }
#pragma unroll
            for (int i = 0; i < 2; ++i) {
                const int c = tid + 512 * i, row = c >> 3, ch = c & 7;
                const int cw = row & 63, pos = (row & 64) | (((cw >> 2) & 3) << 4) | ((cw >> 4) << 2) | (cw & 3);
                *(u32x4*)(wsm + swz(pos, ch)) = rb[i];
            }
        };
        f32x4 acc[4][4];
#pragma unroll
        for (int n = 0; n < 4; ++n)
#pragma unroll
            for (int m = 0; m < 4; ++m) acc[n][m] = (f32x4){0.f, 0.f, 0.f, 0.f};
        gload(0); lstore(0); __syncthreads();
        for (int kt = 0; kt < nk; ++kt) {
            if (kt + 1 < nk) gload(kt + 1);
            const unsigned char* xs = lds + (kt & 1) * 49152; const unsigned char* wsm = xs + 32768;
#pragma unroll
            for (int ks = 0; ks < 2; ++ks) {
                bf16x8 wf[4], xf[4];
#pragma unroll
                for (int n = 0; n < 4; ++n) wf[n] = *(const bf16x8*)(wsm + swz(wc * 64 + n * 16 + fr, ks * 4 + fq));
#pragma unroll
                for (int m = 0; m < 4; ++m) xf[m] = *(const bf16x8*)(xs + swz(wr * 64 + m * 16 + fr, ks * 4 + fq));
#pragma unroll
                for (int n = 0; n < 4; ++n)
#pragma unroll
                    for (int m = 0; m < 4; ++m) acc[n][m] = mfma16(wf[n], xf[m], acc[n][m]);
            }
            if (kt + 1 < nk) lstore((kt + 1) & 1);
            __syncthreads();
        }
        epi(acc, pm, pn, wr, wc, fr, fq);
    }
}

struct EpiIn {
    const float *q_gain, *k_gain, *a_log, *dt_bias;
    bf16_t *qa, *ka, *vt, *pb; float *beta, *g;
    __device__ __forceinline__ void operator()(const f32x4 (&acc)[4][4], int pm, int pn, int wr, int wc, int fr, int fq) const {
        if (pn < 8) {
            const bool isq = pn < 4; const int head = (isq ? pn : pn - 4) * 2 + wc;
            const float* gn = isq ? q_gain : k_gain; bf16_t* dst = isq ? qa : ka; const float sc = isq ? 0.125f : 1.0f;
            float gv[16];
#pragma unroll
            for (int i = 0; i < 16; ++i) gv[i] = gn[16 * fq + i] * sc;
#pragma unroll
            for (int m = 0; m < 4; ++m) {
                const int tok = pm * 256 + wr * 64 + m * 16 + fr, b = tok >> 11, s = tok & 2047;
                float ss = 0.f;
#pragma unroll
                for (int n = 0; n < 4; ++n)
#pragma unroll
                    for (int r = 0; r < 4; ++r) ss += acc[n][m][r] * acc[n][m][r];
                ss += __shfl_xor(ss, 16); ss += __shfl_xor(ss, 32);
                const float rstd = rsqrtf(ss * (1.0f / 64.0f) + EPS);
                u32x4 o0, o1;
                o0.x = pk2(acc[0][m][0] * rstd * gv[0], acc[0][m][1] * rstd * gv[1]); o0.y = pk2(acc[0][m][2] * rstd * gv[2], acc[0][m][3] * rstd * gv[3]);
                o0.z = pk2(acc[1][m][0] * rstd * gv[4], acc[1][m][1] * rstd * gv[5]); o0.w = pk2(acc[1][m][2] * rstd * gv[6], acc[1][m][3] * rstd * gv[7]);
                o1.x = pk2(acc[2][m][0] * rstd * gv[8], acc[2][m][1] * rstd * gv[9]); o1.y = pk2(acc[2][m][2] * rstd * gv[10], acc[2][m][3] * rstd * gv[11]);
                o1.z = pk2(acc[3][m][0] * rstd * gv[12], acc[3][m][1] * rstd * gv[13]); o1.w = pk2(acc[3][m][2] * rstd * gv[14], acc[3][m][3] * rstd * gv[15]);
                bf16_t* p = dst + ((size_t)(b * AH + head) * SEQ + s) * 64 + 16 * fq;
                *(u32x4*)p = o0; *(u32x4*)(p + 8) = o1;
            }
        } else if (pn < 12) {
            const int head = (pn - 8) * 2 + wc;
#pragma unroll
            for (int m = 0; m < 4; ++m) {
                const int tok = pm * 256 + wr * 64 + m * 16 + fr, b = tok >> 11, s = tok & 2047, sp = swap23(s);
                bf16_t* p = vt + ((size_t)(b * AH + head) * 64) * SEQ + sp;
#pragma unroll
                for (int n = 0; n < 4; ++n)
#pragma unroll
                    for (int r = 0; r < 4; ++r) p[(size_t)(16 * fq + 4 * n + r) * SEQ] = (bf16_t)f2bf(acc[n][m][r]);
            }
        } else if (pn < 28) {
            const int col = (pn - 12) * 128 + wc * 64 + 16 * fq;
#pragma unroll
            for (int m = 0; m < 4; ++m) {
                const int tok = pm * 256 + wr * 64 + m * 16 + fr;
                u32x4 o0, o1;
                o0.x = pk2(acc[0][m][0], acc[0][m][1]); o0.y = pk2(acc[0][m][2], acc[0][m][3]); o0.z = pk2(acc[1][m][0], acc[1][m][1]); o0.w = pk2(acc[1][m][2], acc[1][m][3]);
                o1.x = pk2(acc[2][m][0], acc[2][m][1]); o1.y = pk2(acc[2][m][2], acc[2][m][3]); o1.z = pk2(acc[3][m][0], acc[3][m][1]); o1.w = pk2(acc[3][m][2], acc[3][m][3]);
                bf16_t* p = pb + (size_t)tok * PBW + col;
                *(u32x4*)p = o0; *(u32x4*)(p + 8) = o1;
            }
        } else {
            if (wc == 0 && fq == 0) {
#pragma unroll
                for (int m = 0; m < 4; ++m) {
                    const int tok = pm * 256 + wr * 64 + m * 16 + fr;
                    f32x4 bo, go;
#pragma unroll
                    for (int r = 0; r < 4; ++r) {
                        bo[r] = 1.0f / (1.0f + __expf(-acc[0][m][r]));
                        const float xx = acc[1][m][r] + dt_bias[r];
                        const float sp = xx > 20.f ? xx : log1pf(__expf(xx));
                        go[r] = -__expf(a_log[r]) * sp;
                    }
                    *(f32x4*)(beta + (size_t)tok * 4) = bo; *(f32x4*)(g + (size_t)tok * 4) = go;
                }
            }
        }
    }
};

struct EpiOut {
    const float* x; const float* mod; float* out;
    __device__ __forceinline__ void operator()(const f32x4 (&acc)[4][4], int pm, int pn, int wr, int wc, int fr, int fq) const {
        const int col = pn * 128 + wc * 64 + 16 * fq;
#pragma unroll
        for (int m = 0; m < 4; ++m) {
            const int tok = pm * 256 + wr * 64 + m * 16 + fr, b = tok >> 11;
#pragma unroll
            for (int n = 0; n < 4; ++n) {
                const f32x4 xv = *(const f32x4*)(x + (size_t)tok * DM + col + 4 * n), gt = *(const f32x4*)(mod + b * 6144 + 2048 + col + 4 * n);
                f32x4 o; o[0] = xv[0] + gt[0] * acc[n][m][0]; o[1] = xv[1] + gt[1] * acc[n][m][1]; o[2] = xv[2] + gt[2] * acc[n][m][2]; o[3] = xv[3] + gt[3] * acc[n][m][3];
                *(f32x4*)(out + (size_t)tok * DM + col + 4 * n) = o;
            }
        }
    }
};

struct EpiBf {
    bf16_t* dst; int ld;
    __device__ __forceinline__ void operator()(const f32x4 (&acc)[4][4], int pm, int pn, int wr, int wc, int fr, int fq) const {
        const int col = pn * 128 + wc * 64 + 16 * fq;
#pragma unroll
        for (int m = 0; m < 4; ++m) {
            const int tok = pm * 256 + wr * 64 + m * 16 + fr;
            u32x4 o0, o1;
            o0.x = pk2(acc[0][m][0], acc[0][m][1]); o0.y = pk2(acc[0][m][2], acc[0][m][3]); o0.z = pk2(acc[1][m][0], acc[1][m][1]); o0.w = pk2(acc[1][m][2], acc[1][m][3]);
            o1.x = pk2(acc[2][m][0], acc[2][m][1]); o1.y = pk2(acc[2][m][2], acc[2][m][3]); o1.z = pk2(acc[3][m][0], acc[3][m][1]); o1.w = pk2(acc[3][m][2], acc[3][m][3]);
            bf16_t* p = dst + (size_t)tok * ld + col;
            *(u32x4*)p = o0; *(u32x4*)(p + 8) = o1;
        }
    }
};

__device__ void attn_phase(const Params& P, unsigned char* lds, int bid, int nblk) {
    const int tid = threadIdx.x, head = tid >> 6, lane = tid & 63, l31 = lane & 31, hh = lane >> 5;
    float* biasL = (float*)lds + head * 260;
    float* ssq = (float*)(lds + 8 * 260 * 4);
    for (int i = lane; i < 257; i += 64) biasL[i] = P.rel_bias[head * 257 + i];
    const bf16_t* qa = (const bf16_t*)(P.ws + WS_QA); const bf16_t* ka = (const bf16_t*)(P.ws + WS_KA); const bf16_t* vt = (const bf16_t*)(P.ws + WS_VT);
    bf16_t* mix = (bf16_t*)(P.ws + WS_H);
    for (int it = bid; it < 512; it += nblk) {
        const int it2 = it & 255, b = it2 & 15, pp = it2 >> 4, n = (it < 256) ? pp : 31 - pp;
        const size_t hb = (size_t)(b * AH + head);
        const bf16_t* qbase = qa + (hb * SEQ + (size_t)n * 64) * 64;
        const int cstart = (n >= 8) ? 0 : 8 - n;
        f32x16 oq[2][2]; float ssv[2];
#pragma unroll
        for (int qt = 0; qt < 2; ++qt) {
            const int qi = 32 * qt + l31;
            bf16x8 bq[4];
#pragma unroll
            for (int ks = 0; ks < 4; ++ks) bq[ks] = *(const bf16x8*)(qbase + qi * 64 + 16 * ks + 8 * hh);
            f32x16 o0, o1;
#pragma unroll
            for (int r = 0; r < 16; ++r) { o0[r] = 0.f; o1[r] = 0.f; }
            float mrun = -1e30f, lrun = 0.f;
            for (int c = cstart; c <= 8; ++c) {
                const int kc = n + c - 8;
                const bf16_t* kb = ka + (hb * SEQ + (size_t)kc * 64) * 64;
                const bf16_t* vb = vt + hb * 64 * SEQ + kc * 64;
                f32x16 s0, s1;
#pragma unroll
                for (int r = 0; r < 16; ++r) { s0[r] = 0.f; s1[r] = 0.f; }
#pragma unroll
                for (int ks = 0; ks < 4; ++ks) {
                    const bf16x8 a0 = *(const bf16x8*)(kb + l31 * 64 + 16 * ks + 8 * hh);
                    const bf16x8 a1 = *(const bf16x8*)(kb + (32 + l31) * 64 + 16 * ks + 8 * hh);
                    s0 = mfma32(a0, bq[ks], s0); s1 = mfma32(a1, bq[ks], s1);
                }
                if (c <= 5) {
                    const float bc = biasL[256];
#pragma unroll
                    for (int r = 0; r < 16; ++r) { s0[r] += bc; s1[r] += bc; }
                } else {
                    const int base = qi + 64 * (8 - c) + 128 - 4 * hh;
#pragma unroll
                    for (int r = 0; r < 16; ++r) {
                        const int j0 = (r & 3) + 8 * (r >> 2);
                        int i0 = base - j0; i0 = i0 > 256 ? 256 : i0;
                        int i1 = base - 32 - j0; i1 = i1 > 256 ? 256 : i1;
                        s0[r] += biasL[i0]; s1[r] += biasL[i1];
                    }
                }
                float mx = s0[0];
#pragma unroll
                for (int r = 1; r < 16; ++r) mx = fmaxf(mx, s0[r]);
#pragma unroll
                for (int r = 0; r < 16; ++r) mx = fmaxf(mx, s1[r]);
                mx = fmaxf(mx, __shfl_xor(mx, 32));
                const float mnew = fmaxf(mrun, mx), alpha = __expf(mrun - mnew);
                mrun = mnew;
                float psum = 0.f;
#pragma unroll
                for (int r = 0; r < 16; ++r) { s0[r] = __expf(s0[r] - mnew); s1[r] = __expf(s1[r] - mnew); psum += s0[r] + s1[r]; }
                lrun = lrun * alpha + psum;
#pragma unroll
                for (int r = 0; r < 16; ++r) { o0[r] *= alpha; o1[r] *= alpha; }
                bf16x8 pf[2][2];
                pf[0][0] = pack8(s0[0], s0[1], s0[2], s0[3], s0[4], s0[5], s0[6], s0[7]);
                pf[0][1] = pack8(s0[8], s0[9], s0[10], s0[11], s0[12], s0[13], s0[14], s0[15]);
                pf[1][0] = pack8(s1[0], s1[1], s1[2], s1[3], s1[4], s1[5], s1[6], s1[7]);
                pf[1][1] = pack8(s1[8], s1[9], s1[10], s1[11], s1[12], s1[13], s1[14], s1[15]);
#pragma unroll
                for (int kt = 0; kt < 2; ++kt)
#pragma unroll
                    for (int sp = 0; sp < 2; ++sp) {
                        const bf16x8 v0 = *(const bf16x8*)(vb + (size_t)l31 * SEQ + 32 * kt + 16 * sp + 8 * hh);
                        const bf16x8 v1 = *(const bf16x8*)(vb + (size_t)(32 + l31) * SEQ + 32 * kt + 16 * sp + 8 * hh);
                        o0 = mfma32(v0, pf[kt][sp], o0); o1 = mfma32(v1, pf[kt][sp], o1);
                    }
            }
            const float ltot = lrun + __shfl_xor(lrun, 32), inv = 1.0f / ltot;
            float ss = 0.f;
#pragma unroll
            for (int r = 0; r < 16; ++r) { o0[r] *= inv; o1[r] *= inv; ss += o0[r] * o0[r] + o1[r] * o1[r]; }
            ss += __shfl_xor(ss, 32);
            oq[qt][0] = o0; oq[qt][1] = o1; ssv[qt] = ss;
        }
        if (hh == 0) { ssq[head * 64 + l31] = ssv[0]; ssq[head * 64 + 32 + l31] = ssv[1]; }
        __syncthreads();
#pragma unroll
        for (int qt = 0; qt < 2; ++qt) {
            const int qi = 32 * qt + l31;
            float tot = 0.f;
#pragma unroll
            for (int h2 = 0; h2 < 8; ++h2) tot += ssq[h2 * 64 + qi];
            const float rstd = rsqrtf(tot * (1.0f / 512.0f) + EPS);
            const size_t tok = (size_t)b * SEQ + n * 64 + qi;
#pragma unroll
            for (int dt = 0; dt < 2; ++dt)
#pragma unroll
                for (int g4 = 0; g4 < 4; ++g4) {
                    const int dim = 32 * dt + 8 * g4 + 4 * hh;
                    const f32x4 gn = *(const f32x4*)(P.attn_out_gain + head * 64 + dim);
                    const f32x16& o = oq[qt][dt];
                    u32x2 w; w.x = pk2(o[4 * g4] * rstd * gn[0], o[4 * g4 + 1] * rstd * gn[1]); w.y = pk2(o[4 * g4 + 2] * rstd * gn[2], o[4 * g4 + 3] * rstd * gn[3]);
                    *(u32x2*)(mix + tok * DM + head * 64 + dim) = w;
                }
        }
        __syncthreads();
    }
}

constexpr int RP = 136, TP = 72, LP = 68, AP = 72;
constexpr int L_KB = 0, L_KK = 17408, L_QS = 34816, L_UT = 0, L_WT = 18432, L_QG = 52224, L_VBT = 69632, L_KBGT = 88064, L_KDT = 106496, L_L = 124928,
              L_AM = 142336, L_GC = 151552;
static_assert(L_GC + 1024 <= LDS_BYTES, "lds");

__device__ void dn1_phase(const Params& P, unsigned char* lds, int bid, int nblk) {
    const int tid = threadIdx.x, wid = tid >> 6, lane = tid & 63, fr = lane & 15, fq = lane >> 4;
    bf16_t* KB = (bf16_t*)(lds + L_KB); bf16_t* KK = (bf16_t*)(lds + L_KK); bf16_t* QS = (bf16_t*)(lds + L_QS);
    bf16_t* UT = (bf16_t*)(lds + L_UT); bf16_t* WT = (bf16_t*)(lds + L_WT); bf16_t* QG = (bf16_t*)(lds + L_QG);
    bf16_t* VBT = (bf16_t*)(lds + L_VBT); bf16_t* KBGT = (bf16_t*)(lds + L_KBGT); bf16_t* KDT = (bf16_t*)(lds + L_KDT);
    float* Lm = (float*)(lds + L_L); bf16_t* AM = (bf16_t*)(lds + L_AM);
    float* gcs = (float*)(lds + L_GC); float* bts = gcs + 64;
    const bf16_t* pb = (const bf16_t*)(P.ws + WS_PB);
    const float* betaG = (const float*)(P.ws + WS_BETA); const float* gG = (const float*)(P.ws + WS_G);
    bf16_t* negM = (bf16_t*)(P.ws + WS_NEGM); bf16_t* BmT = (bf16_t*)P.out; bf16_t* Qp = (bf16_t*)(P.ws + WS_QP); bf16_t* Ol = (bf16_t*)(P.ws + WS_OL);
    float* egl = (float*)(P.ws + WS_EGL);
    for (int item = bid; item < 2048; item += nblk) {
        const int n = item & 31, bh = item >> 5, h = bh & 3, b = bh >> 2;
        const int t0 = b * SEQ + n * 64;
        if (wid == 0) {
            float gv = gG[(size_t)(t0 + lane) * 4 + h];
#pragma unroll
            for (int o = 1; o < 64; o <<= 1) { const float t = __shfl_up(gv, o); if (lane >= o) gv += t; }
            gcs[lane] = gv; bts[lane] = betaG[(size_t)(t0 + lane) * 4 + h];
        }
        __syncthreads();
        {
            const int r = tid >> 3, cg = tid & 7;
            const float gc = gcs[r], bt = bts[r], gl = gcs[63];
            const float eg = __expf(gc), edk = __expf(gl - gc);
            if (tid == 0) egl[item] = __expf(gl);
#pragma unroll 1
            for (int mat = 0; mat < 3; ++mat) {
                const int col = mat * 512 + h * 128 + 16 * cg;
                float a[16];
#pragma unroll
                for (int i = 0; i < 16; ++i) a[i] = 0.f;
#pragma unroll
                for (int tap = 0; tap < 4; ++tap) {
                    const int srow = n * 64 + r - 3 + tap;
                    if (srow >= 0) {
                        const bf16_t* src = pb + (size_t)(b * SEQ + srow) * PBW + col;
                        const u32x4 x0 = *(const u32x4*)src, x1 = *(const u32x4*)(src + 8);
                        const float* wp = P.conv_w + tap * 1536 + col;
                        const f32x4 w0 = *(const f32x4*)wp, w1 = *(const f32x4*)(wp + 4), w2 = *(const f32x4*)(wp + 8), w3 = *(const f32x4*)(wp + 12);
                        a[0] += bflo(x0.x) * w0[0]; a[1] += bfhi(x0.x) * w0[1]; a[2] += bflo(x0.y) * w0[2]; a[3] += bfhi(x0.y) * w0[3];
                        a[4] += bflo(x0.z) * w1[0]; a[5] += bfhi(x0.z) * w1[1]; a[6] += bflo(x0.w) * w1[2]; a[7] += bfhi(x0.w) * w1[3];
                        a[8] += bflo(x1.x) * w2[0]; a[9] += bfhi(x1.x) * w2[1]; a[10] += bflo(x1.y) * w2[2]; a[11] += bfhi(x1.y) * w2[3];
                        a[12] += bflo(x1.z) * w3[0]; a[13] += bfhi(x1.z) * w3[1]; a[14] += bflo(x1.w) * w3[2]; a[15] += bfhi(x1.w) * w3[3];
                    }
                }
                float ss = 0.f;
#pragma unroll
                for (int i = 0; i < 16; ++i) { a[i] = silu_f(a[i]); ss += a[i] * a[i]; }
                ss += __shfl_xor(ss, 1); ss += __shfl_xor(ss, 2); ss += __shfl_xor(ss, 4);
                u32x4 o0, o1;
#define STORE_ROW(ARR, F)                                                                                                                \
    {                                                                                                                                    \
        o0.x = pk2(a[0] * (F), a[1] * (F)); o0.y = pk2(a[2] * (F), a[3] * (F)); o0.z = pk2(a[4] * (F), a[5] * (F)); o0.w = pk2(a[6] * (F), a[7] * (F));       \
        o1.x = pk2(a[8] * (F), a[9] * (F)); o1.y = pk2(a[10] * (F), a[11] * (F)); o1.z = pk2(a[12] * (F), a[13] * (F)); o1.w = pk2(a[14] * (F), a[15] * (F)); \
        *(u32x4*)(ARR + r * RP + 16 * cg) = o0; *(u32x4*)(ARR + r * RP + 16 * cg + 8) = o1;                                              \
    }
                if (mat == 0) {
                    const float rq = rsqrtf(ss + EPS) * 0.08838834764831845f;
                    STORE_ROW(QS, rq)
                    const float rqe = rq * eg;
                    STORE_ROW(QG, rqe)
                } else if (mat == 1) {
                    const float rk = rsqrtf(ss + EPS);
                    STORE_ROW(KK, rk)
                    const float rkb = rk * bt;
                    STORE_ROW(KB, rkb)
                    const float f1 = rk * bt * eg, f2 = rk * edk;
#pragma unroll
                    for (int i = 0; i < 16; ++i) {
                        const int c = 16 * cg + i;
                        KBGT[c * TP + r] = (bf16_t)f2bf(a[i] * f1);
                        KDT[c * TP + r] = (bf16_t)f2bf(a[i] * f2);
                    }
                } else {
#pragma unroll
                    for (int i = 0; i < 16; ++i) VBT[(16 * cg + i) * TP + r] = (bf16_t)f2bf(a[i] * bt);
                }
#undef STORE_ROW
            }
        }
        __syncthreads();
        {
            const int mat = wid >> 2, ti = wid & 3;
            const bf16_t* Asrc = mat ? QS : KB;
            bf16x8 af[4];
#pragma unroll
            for (int ks = 0; ks < 4; ++ks) af[ks] = *(const bf16x8*)(Asrc + (16 * ti + fr) * RP + 32 * ks + 8 * fq);
            for (int tj = 0; tj < 4; ++tj) {
                const int j = 16 * tj + fr;
                if (tj > ti) {
                    if (mat) {
#pragma unroll
                        for (int rr = 0; rr < 4; ++rr) AM[(16 * ti + 4 * fq + rr) * AP + j] = 0;
                    }
                    continue;
                }
                f32x4 acc = (f32x4){0.f, 0.f, 0.f, 0.f};
#pragma unroll
                for (int ks = 0; ks < 4; ++ks) { const bf16x8 bf = *(const bf16x8*)(KK + j * RP + 32 * ks + 8 * fq); acc = mfma16(af[ks], bf, acc); }
                const float gj = gcs[j];
#pragma unroll
                for (int rr = 0; rr < 4; ++rr) {
                    const int i = 16 * ti + 4 * fq + rr;
                    const float dec = __expf(gcs[i] - gj);
                    if (mat == 0) Lm[i * LP + j] = (i > j) ? acc[rr] * dec : 0.f;
                    else AM[i * AP + j] = (bf16_t)f2bf((i >= j) ? acc[rr] * dec : 0.f);
                }
            }
        }
        __syncthreads();
        {
            float Lrow[64];
#pragma unroll
            for (int q = 0; q < 16; ++q) {
                const f32x4 t = *(const f32x4*)(Lm + lane * LP + 4 * q);
                Lrow[4 * q] = (4 * q < lane) ? t[0] : 0.f; Lrow[4 * q + 1] = (4 * q + 1 < lane) ? t[1] : 0.f;
                Lrow[4 * q + 2] = (4 * q + 2 < lane) ? t[2] : 0.f; Lrow[4 * q + 3] = (4 * q + 3 < lane) ? t[3] : 0.f;
            }
            const bf16_t* src = (wid < 4) ? (VBT + (wid * 32) * TP) : (KBGT + ((wid - 4) * 32) * TP);
            bf16_t* dst = (wid < 4) ? (UT + (wid * 32) * TP) : (WT + ((wid - 4) * 32) * TP);
#pragma unroll 1
            for (int c4 = 0; c4 < 8; ++c4) {
                float r0 = bf2f(src[(4 * c4 + 0) * TP + lane]), r1 = bf2f(src[(4 * c4 + 1) * TP + lane]);
                float r2 = bf2f(src[(4 * c4 + 2) * TP + lane]), r3 = bf2f(src[(4 * c4 + 3) * TP + lane]);
#pragma unroll
                for (int j = 0; j < 63; ++j) {
                    const float x0 = __builtin_bit_cast(float, __builtin_amdgcn_readlane(__builtin_bit_cast(int, r0), j));
                    const float x1 = __builtin_bit_cast(float, __builtin_amdgcn_readlane(__builtin_bit_cast(int, r1), j));
                    const float x2 = __builtin_bit_cast(float, __builtin_amdgcn_readlane(__builtin_bit_cast(int, r2), j));
                    const float x3 = __builtin_bit_cast(float, __builtin_amdgcn_readlane(__builtin_bit_cast(int, r3), j));
                    r0 -= Lrow[j] * x0; r1 -= Lrow[j] * x1; r2 -= Lrow[j] * x2; r3 -= Lrow[j] * x3;
                }
                dst[(4 * c4 + 0) * TP + lane] = (bf16_t)f2bf(r0); dst[(4 * c4 + 1) * TP + lane] = (bf16_t)f2bf(r1);
                dst[(4 * c4 + 2) * TP + lane] = (bf16_t)f2bf(r2); dst[(4 * c4 + 3) * TP + lane] = (bf16_t)f2bf(r3);
            }
        }
        __syncthreads();
        {
            const size_t ib = (size_t)item * 16384;
            const int fqs = ((fq & 1) << 1) | (fq >> 1);
            {
                bf16x8 a0 = *(const bf16x8*)(WT + (16 * wid + fr) * TP + 8 * fq), a1 = *(const bf16x8*)(WT + (16 * wid + fr) * TP + 32 + 8 * fq);
                for (int itile = 0; itile < 8; ++itile) {
                    const int i = 16 * itile + fr;
                    const bf16x8 b0 = *(const bf16x8*)(KDT + i * TP + 8 * fq), b1 = *(const bf16x8*)(KDT + i * TP + 32 + 8 * fq);
                    f32x4 acc = (f32x4){0.f, 0.f, 0.f, 0.f};
                    acc = mfma16(a0, b0, acc); acc = mfma16(a1, b1, acc);
                    u32x2 o; o.x = pk2(-acc[0], -acc[1]); o.y = pk2(-acc[2], -acc[3]);
                    *(u32x2*)(negM + ib + (size_t)i * 128 + 16 * wid + 4 * fqs) = o;
                }
                for (int itile = 0; itile < 4; ++itile) {
                    const int i = 16 * itile + fr;
                    const bf16x8 b0 = *(const bf16x8*)(AM + i * AP + 8 * fq), b1 = *(const bf16x8*)(AM + i * AP + 32 + 8 * fq);
                    f32x4 acc = (f32x4){0.f, 0.f, 0.f, 0.f};
                    acc = mfma16(a0, b0, acc); acc = mfma16(a1, b1, acc);
                    const u32x2 qg = *(const u32x2*)(QG + i * RP + 16 * wid + 4 * fq);
                    u32x2 o; o.x = pk2(bflo(qg.x) - acc[0], bfhi(qg.x) - acc[1]); o.y = pk2(bflo(qg.y) - acc[2], bfhi(qg.y) - acc[3]);
                    *(u32x2*)(Qp + (size_t)item * 8192 + (size_t)i * 128 + 16 * wid + 4 * fq) = o;
                }
            }
            {
                const bf16x8 a0 = *(const bf16x8*)(KDT + (16 * wid + fr) * TP + 8 * fq), a1 = *(const bf16x8*)(KDT + (16 * wid + fr) * TP + 32 + 8 * fq);
                for (int dt = 0; dt < 8; ++dt) {
                    const int dv = 16 * dt + fr;
                    const bf16x8 b0 = *(const bf16x8*)(UT + dv * TP + 8 * fq), b1 = *(const bf16x8*)(UT + dv * TP + 32 + 8 * fq);
                    f32x4 acc = (f32x4){0.f, 0.f, 0.f, 0.f};
                    acc = mfma16(a0, b0, acc); acc = mfma16(a1, b1, acc);
                    u32x2 o; o.x = pk2(acc[0], acc[1]); o.y = pk2(acc[2], acc[3]);
                    *(u32x2*)(BmT + ib + (size_t)dv * 128 + 16 * wid + 4 * fq) = o;
                }
            }
            {
                const bf16x8 a0 = *(const bf16x8*)(UT + (16 * wid + fr) * TP + 8 * fq), a1 = *(const bf16x8*)(UT + (16 * wid + fr) * TP + 32 + 8 * fq);
                for (int itile = 0; itile < 4; ++itile) {
                    const int i = 16 * itile + fr;
                    const bf16x8 b0 = *(const bf16x8*)(AM + i * AP + 8 * fq), b1 = *(const bf16x8*)(AM + i * AP + 32 + 8 * fq);
                    f32x4 acc = (f32x4){0.f, 0.f, 0.f, 0.f};
                    acc = mfma16(a0, b0, acc); acc = mfma16(a1, b1, acc);
                    u32x2 o; o.x = pk2(acc[0], acc[1]); o.y = pk2(acc[2], acc[3]);
                    *(u32x2*)(Ol + (size_t)item * 8192 + (size_t)i * 128 + 16 * wid + 4 * fq) = o;
                }
            }
        }
        __syncthreads();
    }
}

__device__ void dn2_phase(const Params& P, int bid, int nblk) {
    const int tid = threadIdx.x, wid = tid >> 6, lane = tid & 63, l31 = lane & 31, hh = lane >> 5;
    if (wid != 0) return;
    const bf16_t* negM = (const bf16_t*)(P.ws + WS_NEGM); const bf16_t* BmT = (const bf16_t*)P.out;
    const float* egl = (const float*)(P.ws + WS_EGL); bf16_t* SnT = (bf16_t*)(P.ws + WS_SNT);
    for (int sid = bid; sid < 256; sid += nblk) {
        const int bh = sid >> 2, sl = sid & 3, dv = 32 * sl + l31;
        f32x16 acc[4];
#pragma unroll
        for (int t = 0; t < 4; ++t)
#pragma unroll
            for (int r = 0; r < 16; ++r) acc[t][r] = 0.f;
        for (int n = 0; n < 32; ++n) {
            const size_t ib = ((size_t)bh * 32 + n) * 16384;
            bf16_t* sp = SnT + ib + (size_t)dv * 128;
            bf16x8 bfr[4][2];
#pragma unroll
            for (int rt = 0; rt < 4; ++rt) {
#pragma unroll
                for (int g4 = 0; g4 < 4; ++g4) {
                    u32x2 o; o.x = pk2(acc[rt][4 * g4], acc[rt][4 * g4 + 1]); o.y = pk2(acc[rt][4 * g4 + 2], acc[rt][4 * g4 + 3]);
                    *(u32x2*)(sp + 32 * rt + 8 * g4 + 4 * hh) = o;
                }
                bfr[rt][0] = pack8(acc[rt][0], acc[rt][1], acc[rt][2], acc[rt][3], acc[rt][4], acc[rt][5], acc[rt][6], acc[rt][7]);
                bfr[rt][1] = pack8(acc[rt][8], acc[rt][9], acc[rt][10], acc[rt][11], acc[rt][12], acc[rt][13], acc[rt][14], acc[rt][15]);
            }
            if (n == 31) break;
            const float eg = egl[bh * 32 + n];
            const bf16_t* bp = BmT + ib + (size_t)dv * 128;
#pragma unroll
            for (int ro = 0; ro < 4; ++ro)
#pragma unroll
                for (int g4 = 0; g4 < 4; ++g4) {
                    const u32x2 t = *(const u32x2*)(bp + 32 * ro + 8 * g4 + 4 * hh);
                    acc[ro][4 * g4] = eg * acc[ro][4 * g4] + bflo(t.x); acc[ro][4 * g4 + 1] = eg * acc[ro][4 * g4 + 1] + bfhi(t.x);
                    acc[ro][4 * g4 + 2] = eg * acc[ro][4 * g4 + 2] + bflo(t.y); acc[ro][4 * g4 + 3] = eg * acc[ro][4 * g4 + 3] + bfhi(t.y);
                }
            const bf16_t* mp = negM + ib;
#pragma unroll
            for (int ro = 0; ro < 4; ++ro)
#pragma unroll
                for (int rt = 0; rt < 4; ++rt)
#pragma unroll
                    for (int sp2 = 0; sp2 < 2; ++sp2) {
                        const bf16x8 a = *(const bf16x8*)(mp + (size_t)(32 * ro + l31) * 128 + 32 * rt + 16 * sp2 + 8 * hh);
                        acc[ro] = mfma32(a, bfr[rt][sp2], acc[ro]);
                    }
        }
    }
}

__device__ void dn3_phase(const Params& P, int bid, int nblk) {
    const int tid = threadIdx.x, wid = tid >> 6, lane = tid & 63, fr = lane & 15, fq = lane >> 4;
    const bf16_t* SnT = (const bf16_t*)(P.ws + WS_SNT); const bf16_t* Qp = (const bf16_t*)(P.ws + WS_QP); const bf16_t* Ol = (const bf16_t*)(P.ws + WS_OL);
    const bf16_t* pb = (const bf16_t*)(P.ws + WS_PB); bf16_t* mix = (bf16_t*)(P.ws + WS_H);
    for (int it2 = bid; it2 < 1024; it2 += nblk) {
        const int item = it2 * 2 + (wid >> 2), q4 = wid & 3;
        const int n = item & 31, bh = item >> 5, h = bh & 3, b = bh >> 2;
        const int i = 16 * q4 + fr;
        const bf16_t* qrow = Qp + (size_t)item * 8192 + (size_t)i * 128;
        bf16x8 bq[4];
#pragma unroll
        for (int ks = 0; ks < 4; ++ks) bq[ks] = *(const bf16x8*)(qrow + 32 * ks + 8 * fq);
        const bf16_t* sb = SnT + (size_t)item * 16384;
        f32x4 acc[8];
#pragma unroll
        for (int dt = 0; dt < 8; ++dt) {
            acc[dt] = (f32x4){0.f, 0.f, 0.f, 0.f};
#pragma unroll
            for (int ks = 0; ks < 4; ++ks) { const bf16x8 a = *(const bf16x8*)(sb + (size_t)(16 * dt + fr) * 128 + 32 * ks + 8 * fq); acc[dt] = mfma16(a, bq[ks], acc[dt]); }
        }
        const bf16_t* olr = Ol + (size_t)item * 8192 + (size_t)i * 128;
        float ss = 0.f;
#pragma unroll
        for (int dt = 0; dt < 8; ++dt) {
            const u32x2 t = *(const u32x2*)(olr + 16 * dt + 4 * fq);
            acc[dt][0] += bflo(t.x); acc[dt][1] += bfhi(t.x); acc[dt][2] += bflo(t.y); acc[dt][3] += bfhi(t.y);
            ss += acc[dt][0] * acc[dt][0] + acc[dt][1] * acc[dt][1] + acc[dt][2] * acc[dt][2] + acc[dt][3] * acc[dt][3];
        }
        ss += __shfl_xor(ss, 16); ss += __shfl_xor(ss, 32);
        const float rstd = rsqrtf(ss * (1.0f / 128.0f) + EPS);
        const size_t tok = (size_t)b * SEQ + n * 64 + i;
#pragma unroll
        for (int dt = 0; dt < 8; ++dt) {
            const int dv = 16 * dt + 4 * fq;
            const u32x2 z = *(const u32x2*)(pb + tok * PBW + 1536 + h * 128 + dv);
            const f32x4 gn = *(const f32x4*)(P.dn_out_gain + dv);
            u32x2 o;
            o.x = pk2(acc[dt][0] * rstd * gn[0] * silu_f(bflo(z.x)), acc[dt][1] * rstd * gn[1] * silu_f(bfhi(z.x)));
            o.y = pk2(acc[dt][2] * rstd * gn[2] * silu_f(bflo(z.y)), acc[dt][3] * rstd * gn[3] * silu_f(bfhi(z.y)));
            *(u32x2*)(mix + tok * DM + 512 + h * 128 + dv) = o;
        }
    }
}

__device__ __forceinline__ void sort16_desc(float (&v)[16]) {
#pragma unroll
    for (int k = 2; k <= 16; k <<= 1) {
#pragma unroll
        for (int j = k >> 1; j > 0; j >>= 1) {
#pragma unroll
            for (int i = 0; i < 16; ++i) {
                const int l = i ^ j;
                if (l > i) {
                    const bool desc = ((i & k) == 0);
                    const float hi = fmaxf(v[i], v[l]), lo = fminf(v[i], v[l]);
                    v[i] = desc ? hi : lo; v[l] = desc ? lo : hi;
                }
            }
        }
    }
}
__device__ __forceinline__ void merge_top16(float (&a)[16], const float (&b)[16]) {
#pragma unroll
    for (int i = 0; i < 16; ++i) a[i] = fmaxf(a[i], b[15 - i]);
#pragma unroll
    for (int j = 8; j > 0; j >>= 1) {
#pragma unroll
        for (int i = 0; i < 16; ++i) {
            const int l = i ^ j;
            if (l > i) { const float hi = fmaxf(a[i], a[l]), lo = fminf(a[i], a[l]); a[i] = hi; a[l] = lo; }
        }
    }
}
__device__ __forceinline__ unsigned lut16(unsigned long long lo, unsigned long long hi, unsigned idx) {
    const unsigned long long w = (idx & 8u) ? hi : lo;
    return (unsigned)(w >> ((idx & 7u) * 8u)) & 127u;
}

__device__ void route_phase(const Params& P, int bid, int nblk) {
    const int tid = threadIdx.x, wid = tid >> 6, lane = tid & 63, l31 = lane & 31, hh = lane >> 5;
    const bf16_t* qry = (const bf16_t*)(P.ws + WS_PB); const bf16_t* skp = (const bf16_t*)(P.ws + WS_SK);
    int* ids = (int*)(P.ws + WS_IDS); float* gates = (float*)(P.ws + WS_GATES);
    for (int wi = bid * 8 + wid; wi < 1024 * 8; wi += nblk * 8) {
        const int tg = wi >> 3, hd = wi & 7;
        const int tok = tg * 32 + l31;
        const bf16_t* qrow = qry + (size_t)tok * 2048 + hd * 256;
        float top[2][16];
        float ssq = 0.f;
        bf16x8 bq[2][8];
#pragma unroll
        for (int p = 0; p < 2; ++p)
#pragma unroll
            for (int ks = 0; ks < 8; ++ks) {
                bq[p][ks] = *(const bf16x8*)(qrow + 128 * p + 16 * ks + 8 * hh);
                const u32x4 u = __builtin_bit_cast(u32x4, bq[p][ks]);
                ssq += bflo(u.x) * bflo(u.x) + bfhi(u.x) * bfhi(u.x) + bflo(u.y) * bflo(u.y) + bfhi(u.y) * bfhi(u.y) + bflo(u.z) * bflo(u.z) + bfhi(u.z) * bfhi(u.z) +
                       bflo(u.w) * bflo(u.w) + bfhi(u.w) * bfhi(u.w);
            }
        ssq += __shfl_xor(ssq, 32);
        const float rstd = rsqrtf(ssq * (1.0f / 256.0f) + EPS);
#pragma unroll
        for (int p = 0; p < 2; ++p) {
            const bf16_t* sk = skp + p * 16384;
            float run[16];
#pragma unroll
            for (int kt = 0; kt < 4; ++kt) {
                f32x16 s;
#pragma unroll
                for (int r = 0; r < 16; ++r) s[r] = 0.f;
#pragma unroll
                for (int ks = 0; ks < 8; ++ks) { const bf16x8 a = *(const bf16x8*)(sk + (32 * kt + l31) * 128 + 16 * ks + 8 * hh); s = mfma32(a, bq[p][ks], s); }
                float cur[16];
#pragma unroll
                for (int r = 0; r < 16; ++r) {
                    const unsigned key = 32 * kt + (r & 3) + 8 * (r >> 2) + 4 * hh;
                    cur[r] = __uint_as_float((__float_as_uint(s[r] * rstd) & ~127u) | key);
                }
                sort16_desc(cur);
                if (kt == 0) {
#pragma unroll
                    for (int r = 0; r < 16; ++r) run[r] = cur[r];
                } else merge_top16(run, cur);
            }
            float oth[16];
#pragma unroll
            for (int r = 0; r < 16; ++r) oth[r] = __shfl_xor(run[r], 32);
            merge_top16(run, oth);
#pragma unroll
            for (int r = 0; r < 16; ++r) top[p][r] = run[r];
        }
        float v1[16], v2[16];
        unsigned long long p1lo = 0ull, p1hi = 0ull, p2lo = 0ull, p2hi = 0ull;
#pragma unroll
        for (int r = 0; r < 16; ++r) {
            const unsigned u1 = __float_as_uint(top[0][r]), u2 = __float_as_uint(top[1][r]);
            v1[r] = __uint_as_float(u1 & ~127u); v2[r] = __uint_as_float(u2 & ~127u);
            if (r < 8) { p1lo |= (unsigned long long)(u1 & 127u) << (8 * r); p2lo |= (unsigned long long)(u2 & 127u) << (8 * r); }
            else { p1hi |= (unsigned long long)(u1 & 127u) << (8 * (r - 8)); p2hi |= (unsigned long long)(u2 & 127u) << (8 * (r - 8)); }
        }
#define CAND(a, b) __uint_as_float((__float_as_uint(v1[a] + v2[b]) & ~255u) | (unsigned)((a) * 16 + (b)))
        const float NEG = -3.0e38f;
        float g0[16], g1[16], g2[16], g3[16];
#pragma unroll
        for (int r = 0; r < 16; ++r) g0[r] = CAND(0, r);
        g1[0] = CAND(1, 0); g1[1] = CAND(1, 1); g1[2] = CAND(1, 2); g1[3] = CAND(1, 3); g1[4] = CAND(1, 4); g1[5] = CAND(1, 5); g1[6] = CAND(1, 6); g1[7] = CAND(1, 7);
        g1[8] = CAND(2, 0); g1[9] = CAND(2, 1); g1[10] = CAND(2, 2); g1[11] = CAND(2, 3); g1[12] = CAND(2, 4); g1[13] = CAND(4, 0); g1[14] = CAND(4, 1); g1[15] = CAND(4, 2);
        g2[0] = CAND(3, 0); g2[1] = CAND(3, 1); g2[2] = CAND(3, 2); g2[3] = CAND(3, 3); g2[4] = CAND(5, 0); g2[5] = CAND(5, 1); g2[6] = CAND(6, 0); g2[7] = CAND(6, 1);
        g2[8] = CAND(7, 0); g2[9] = CAND(7, 1); g2[10] = CAND(8, 0); g2[11] = CAND(9, 0); g2[12] = CAND(10, 0); g2[13] = CAND(11, 0); g2[14] = CAND(12, 0); g2[15] = CAND(13, 0);
        g3[0] = CAND(14, 0); g3[1] = CAND(15, 0);
#pragma unroll
        for (int r = 2; r < 16; ++r) g3[r] = NEG;
#undef CAND
        sort16_desc(g1); sort16_desc(g2); sort16_desc(g3);
        merge_top16(g0, g1); merge_top16(g2, g3); merge_top16(g0, g2);
        float e[16], es = 0.f; int eid[16];
        const float m0 = __uint_as_float(__float_as_uint(g0[0]) & ~255u);
#pragma unroll
        for (int r = 0; r < 16; ++r) {
            const unsigned u = __float_as_uint(g0[r]);
            const float sv = __uint_as_float(u & ~255u);
            e[r] = __expf(sv - m0); es += e[r];
            const unsigned a = (u >> 4) & 15u, bb = u & 15u;
            eid[r] = (int)(lut16(p1lo, p1hi, a) * 128u + lut16(p2lo, p2hi, bb));
        }
        const float inv = 1.0f / es;
        if (hh == 0) {
            int* ip = ids + ((size_t)tok * 8 + hd) * 16; float* gp = gates + ((size_t)tok * 8 + hd) * 16;
#pragma unroll
            for (int q = 0; q < 4; ++q) {
                *(int4*)(ip + 4 * q) = make_int4(eid[4 * q], eid[4 * q + 1], eid[4 * q + 2], eid[4 * q + 3]);
                *(f32x4*)(gp + 4 * q) = (f32x4){e[4 * q] * inv, e[4 * q + 1] * inv, e[4 * q + 2] * inv, e[4 * q + 3] * inv};
            }
        }
    }
}

__device__ void gather_phase(const Params& P, int bid, int nblk) {
    const int tid = threadIdx.x, wid = tid >> 6, lane = tid & 63;
    const bf16_t* h2 = (const bf16_t*)(P.ws + WS_H); const bf16_t* ed = (const bf16_t*)(P.ws + WS_ED); const bf16_t* eu = (const bf16_t*)(P.ws + WS_EU);
    const int* ids = (const int*)(P.ws + WS_IDS); const float* gates = (const float*)(P.ws + WS_GATES); const float* mod = (const float*)(P.ws + WS_MOD);
    for (int tok = bid * 8 + wid; tok < NTOK; tok += nblk * 8) {
        const u32x4 h0 = *(const u32x4*)(h2 + (size_t)tok * DM + 8 * lane), h1 = *(const u32x4*)(h2 + (size_t)tok * DM + 512 + 8 * lane);
        float y[16];
#pragma unroll
        for (int i = 0; i < 16; ++i) y[i] = 0.f;
        for (int half = 0; half < 2; ++half) {
            const int idv = ids[(size_t)tok * 128 + half * 64 + lane];
            const float gt = gates[(size_t)tok * 128 + half * 64 + lane];
            float part[64];
#pragma unroll
            for (int k = 0; k < 64; ++k) {
                const int id = __builtin_amdgcn_readlane(idv, k);
                const bf16_t* row = ed + (size_t)id * DM;
                const u32x4 a = *(const u32x4*)(row + 8 * lane), b2 = *(const u32x4*)(row + 512 + 8 * lane);
                float d = 0.f;
                d = dot2bf(a.x, h0.x, d); d = dot2bf(a.y, h0.y, d); d = dot2bf(a.z, h0.z, d); d = dot2bf(a.w, h0.w, d);
                d = dot2bf(b2.x, h1.x, d); d = dot2bf(b2.y, h1.y, d); d = dot2bf(b2.z, h1.z, d); d = dot2bf(b2.w, h1.w, d);
                part[k] = d;
            }
#pragma unroll
            for (int o = 32; o > 0; o >>= 1) {
                const bool up = (lane & o) != 0;
#pragma unroll
                for (int i = 0; i < o; ++i) {
                    const float keep = up ? part[i + o] : part[i];
                    const float send = up ? part[i] : part[i + o];
                    part[i] = keep + __shfl_xor(send, o);
                }
            }
            const float dt = part[0];
            const float act = 0.5f * dt * (1.0f + erff(dt * 0.70710678118654752f));
            const float wgt = gt * act;
#pragma unroll
            for (int k = 0; k < 64; ++k) {
                const int id = __builtin_amdgcn_readlane(idv, k);
                const float wk = __builtin_bit_cast(float, __builtin_amdgcn_readlane(__builtin_bit_cast(int, wgt), k));
                const bf16_t* row = eu + (size_t)id * DM;
                const u32x4 a = *(const u32x4*)(row + 8 * lane), b2 = *(const u32x4*)(row + 512 + 8 * lane);
                y[0] += wk * bflo(a.x); y[1] += wk * bfhi(a.x); y[2] += wk * bflo(a.y); y[3] += wk * bfhi(a.y);
                y[4] += wk * bflo(a.z); y[5] += wk * bfhi(a.z); y[6] += wk * bflo(a.w); y[7] += wk * bfhi(a.w);
                y[8] += wk * bflo(b2.x); y[9] += wk * bfhi(b2.x); y[10] += wk * bflo(b2.y); y[11] += wk * bfhi(b2.y);
                y[12] += wk * bflo(b2.z); y[13] += wk * bfhi(b2.z); y[14] += wk * bflo(b2.w); y[15] += wk * bfhi(b2.w);
            }
        }
        const int b = tok >> 11;
        float* op = P.out + (size_t)tok * DM;
        const float* g2 = mod + b * 6144 + 5120;
#pragma unroll
        for (int hsel = 0; hsel < 2; ++hsel)
#pragma unroll
            for (int q = 0; q < 2; ++q) {
                const int c = 512 * hsel + 8 * lane + 4 * q;
                const f32x4 xv = *(const f32x4*)(op + c), gv = *(const f32x4*)(g2 + c);
                f32x4 o;
#pragma unroll
                for (int j = 0; j < 4; ++j) o[j] = xv[j] + gv[j] * y[8 * hsel + 4 * q + j];
                *(f32x4*)(op + c) = o;
            }
    }
}

constexpr int NPHASES = 11;
__device__ __forceinline__ void run_phase(const Params& P, int ph, unsigned char* lds, int bid, int nblk) {
    const float* mod = (const float*)(P.ws + WS_MOD);
    switch (ph) {
        case 0: phase0(P, lds, bid, nblk); break;
        case 1: norm_mod_phase(P.x, P.norm1_gain, mod, 0, 1024, (bf16_t*)(P.ws + WS_H), bid, nblk); break;
        case 2: {
            EpiIn e{P.q_gain, P.k_gain, P.a_log, P.dt_bias, (bf16_t*)(P.ws + WS_QA), (bf16_t*)(P.ws + WS_KA), (bf16_t*)(P.ws + WS_VT), (bf16_t*)(P.ws + WS_PB),
                    (float*)(P.ws + WS_BETA), (float*)(P.ws + WS_G)};
            gemm_phase(( const bf16_t*)(P.ws + WS_H), (const bf16_t*)(P.ws + WS_WINT), NTOK, NPAD, DM, e, lds, bid, nblk);
        } break;
        case 3: attn_phase(P, lds, bid, nblk); __syncthreads(); dn1_phase(P, lds, bid, nblk); break;
        case 4: dn2_phase(P, bid, nblk); break;
        case 5: dn3_phase(P, bid, nblk); break;
        case 6: {
            EpiOut e{P.x, mod, P.out};
            gemm_phase((const bf16_t*)(P.ws + WS_H), (const bf16_t*)(P.ws + WS_WOUTT), NTOK, DM, DM, e, lds, bid, nblk);
        } break;
        case 7: norm_mod_phase(P.out, P.norm2_gain, mod, 3072, 4096, (bf16_t*)(P.ws + WS_H), bid, nblk); break;
        case 8: {
            EpiBf e{(bf16_t*)(P.ws + WS_PB), 2048};
            gemm_phase((const bf16_t*)(P.ws + WS_H), (const bf16_t*)(P.ws + WS_WQT), NTOK, 2048, DM, e, lds, bid, nblk);
        } break;
        case 9: route_phase(P, bid, nblk); break;
        case 10: gather_phase(P, bid, nblk); break;
        default: break;
    }
}

#if MULTI_LAUNCH
template <int PH>
__global__ void __launch_bounds__(NTHREADS) k_phase(Params P) {
    __shared__ __attribute__((aligned(16))) unsigned char lds[LDS_BYTES];
    run_phase(P, PH, lds, blockIdx.x, gridDim.x);
}
#else
__global__ void __launch_bounds__(NTHREADS) k_mega(Params P) {
    __shared__ __attribute__((aligned(16))) unsigned char lds[LDS_BYTES];
    cg::grid_group grid = cg::this_grid();
    for (int ph = 0; ph < NPHASES; ++ph) {
        run_phase(P, ph, lds, blockIdx.x, gridDim.x);
        if (ph + 1 < NPHASES) grid.sync();
    }
}
#endif

extern "C" void kernel_launch(void* const* d_in, const int* in_sizes, int n_in, void* d_out, int out_size, void* d_ws, size_t ws_size, hipStream_t stream) {
    static int grid = 0;
    if (grid == 0) {
        if (n_in != 22 || out_size != NTOK * DM || ws_size < WS_END) { fprintf(stderr, "kernel_launch: unexpected shapes (n_in %d out %d ws %zu)\n", n_in, out_size, ws_size); grid = -1; return; }
        int dev = 0, cus = 0, per_cu = 0;
        (void)hipGetDevice(&dev);
        (void)hipDeviceGetAttribute(&cus, hipDeviceAttributeMultiprocessorCount, dev);
#if MULTI_LAUNCH
        (void)hipOccupancyMaxActiveBlocksPerMultiprocessor(&per_cu, k_phase<3>, NTHREADS, 0);
#else
        (void)hipOccupancyMaxActiveBlocksPerMultiprocessor(&per_cu, k_mega, NTHREADS, 0);
#endif
        if (per_cu < 1) { fprintf(stderr, "kernel_launch: occupancy query says %d blocks per CU\n", per_cu); per_cu = 1; }
        grid = cus;
        (void)hipGetLastError();
    }
    if (grid < 0) return;
    Params p{};
    const float** pp = (const float**)&p;
    for (int i = 0; i < 22; ++i) pp[i] = (const float*)d_in[i];
    p.out = (float*)d_out; p.ws = (unsigned char*)d_ws;
#if MULTI_LAUNCH
#define LP_(PH) hipLaunchKernelGGL(k_phase<PH>, dim3(grid), dim3(NTHREADS), 0, stream, p)
    LP_(0); LP_(1); LP_(2); LP_(3); LP_(4); LP_(5); LP_(6); LP_(7); LP_(8); LP_(9); LP_(10);
#undef LP_
#else
    void* args[] = {&p};
    hipError_t e = hipLaunchCooperativeKernel((void*)k_mega, dim3(grid), dim3(NTHREADS), args, 0, stream);
    if (e != hipSuccess) fprintf(stderr, "cooperative launch failed: %s (grid %d)\n", hipGetErrorString(e), grid);
#endif
}
```

```cpp
#include <hip/hip_runtime.h>
#include <hip/hip_cooperative_groups.h>
#include <cstdio>
#include <cstdint>
#include <type_traits>
namespace cg = cooperative_groups;

#ifndef MULTI_LAUNCH
#define MULTI_LAUNCH 0
#endif

typedef unsigned short bf16_t;
typedef short bf16x8 __attribute__((ext_vector_type(8)));
typedef float f32x4 __attribute__((ext_vector_type(4)));
typedef float f32x16 __attribute__((ext_vector_type(16)));
typedef unsigned u32x4 __attribute__((ext_vector_type(4)));
typedef unsigned u32x2 __attribute__((ext_vector_type(2)));
typedef __bf16 bf16x2_t __attribute__((ext_vector_type(2)));

constexpr int NB = 16, SEQ = 2048, DM = 1024, NTOK = NB * SEQ;
constexpr int CH = 64, NCH = SEQ / CH;
constexpr int AH = 8, AHD = 64;
constexpr int DH = 4, DHD = 128;
constexpr int IPW = 3592, NPAD = 3712;
constexpr int PBW = 2048;
constexpr int NEXP = 16384;
constexpr float EPS = 1e-6f;
constexpr int NTHREADS = 512;

constexpr size_t MiB = 1u << 20;
constexpr size_t WS_MOD = 1 * MiB;
constexpr size_t WS_SK = 2 * MiB;
constexpr size_t WS_WINT = 3 * MiB;
constexpr size_t WS_WOUTT = 11 * MiB;
constexpr size_t WS_WQT = 13 * MiB;
constexpr size_t WS_ED8 = 17 * MiB;
constexpr size_t WS_PART = 145 * MiB;
constexpr size_t WS_EU8 = 33 * MiB;
constexpr size_t WS_H8 = 49 * MiB;
constexpr size_t WS_SD = 2 * MiB + 128 * 1024;
constexpr size_t WS_SU = 2 * MiB + 192 * 1024;
constexpr size_t WS_HS = 2 * MiB + 256 * 1024;
constexpr size_t WS_H = 81 * MiB;
constexpr size_t WS_PB = 145 * MiB;
constexpr size_t WS_QA = 273 * MiB;
constexpr size_t WS_KA = 305 * MiB;
constexpr size_t WS_VT = 337 * MiB;
constexpr size_t WS_QP = 369 * MiB;
constexpr size_t WS_OL = 401 * MiB;
constexpr size_t WS_BETA = 433 * MiB;
constexpr size_t WS_G = 433 * MiB + 512 * 1024;
constexpr size_t WS_EGL = 434 * MiB;
constexpr size_t WS_NEGM = 435 * MiB;
constexpr size_t WS_END = 499 * MiB;
constexpr size_t WS_SNT = WS_QA;
constexpr size_t WS_WQ8 = WS_KA;
constexpr size_t WS_WSC = WS_KA + 4 * MiB;
constexpr size_t WS_IDS16 = WS_KA + 8 * MiB;
constexpr size_t WS_DLT = WS_QP;
constexpr size_t WS_GATES16 = WS_KA + 16 * MiB;

struct Params {
    const float *x, *c, *w_ada, *b_ada, *norm1_gain, *w_in, *q_gain, *k_gain, *rel_bias, *attn_out_gain, *conv_w, *a_log, *dt_bias,
        *dn_out_gain, *w_out, *norm2_gain, *w_query, *query_gain, *sk1, *sk2, *e_down, *e_up;
    float* out;
    unsigned char* ws;
};

typedef float f32x2h __attribute__((ext_vector_type(2)));
typedef __bf16 bf16x2h __attribute__((ext_vector_type(2)));
__device__ __forceinline__ unsigned f2bf(float f) { return (unsigned)__builtin_bit_cast(unsigned short, (__bf16)f); }
__device__ __forceinline__ unsigned pk2(float lo, float hi) { const f32x2h v = {lo, hi}; return __builtin_bit_cast(unsigned, __builtin_convertvector(v, bf16x2h)); }
__device__ __forceinline__ float bflo(unsigned u) { return __uint_as_float(u << 16); }
__device__ __forceinline__ float bfhi(unsigned u) { return __uint_as_float(u & 0xffff0000u); }
__device__ __forceinline__ float bf2f(bf16_t v) { return __uint_as_float(((unsigned)v) << 16); }
__device__ __forceinline__ float silu_f(float v) { return v * __builtin_amdgcn_rcpf(1.0f + __expf(-v)); }
__device__ __forceinline__ float dot2bf(unsigned a, unsigned b, float acc) {
    return __builtin_amdgcn_fdot2_f32_bf16(__builtin_bit_cast(bf16x2_t, a), __builtin_bit_cast(bf16x2_t, b), acc, false);
}
__device__ __forceinline__ f32x4 mfma16(bf16x8 a, bf16x8 b, f32x4 c) { return __builtin_amdgcn_mfma_f32_16x16x32_bf16(a, b, c, 0, 0, 0); }
__device__ __forceinline__ f32x16 mfma32(bf16x8 a, bf16x8 b, f32x16 c) { return __builtin_amdgcn_mfma_f32_32x32x16_bf16(a, b, c, 0, 0, 0); }
__device__ __forceinline__ bf16x8 pack8(float a0, float a1, float a2, float a3, float a4, float a5, float a6, float a7) {
    u32x4 u; u.x = pk2(a0, a1); u.y = pk2(a2, a3); u.z = pk2(a4, a5); u.w = pk2(a6, a7); return __builtin_bit_cast(bf16x8, u);
}
__device__ __forceinline__ int opaque_tid() { int t = threadIdx.x; asm volatile("" : "+v"(t)); return t; }
__device__ __forceinline__ int swap23(int v) { return (v & ~12) | ((v & 4) << 1) | ((v & 8) >> 1); }

constexpr int LDS_BYTES = 153600;

__device__ void phase0(const Params& P, unsigned char* lds, int bid, int nblk) {
    const int tid = opaque_tid();
    float* sc = (float*)lds;
    float* red = (float*)(lds + 65536);
    float* tile = (float*)(lds + 98304);
    float* mod = (float*)(P.ws + WS_MOD);
    if (bid < 384) {
        for (int e = tid; e < 16384; e += NTHREADS) { int b = e >> 10, k = e & 1023; float v = P.c[e]; sc[k * 16 + b] = silu_f(v); }
        __syncthreads();
        for (int it = bid; it < 384; it += nblk) {
            const int j0 = it * 16, cl = tid & 15, kg = tid >> 4;
            float acc[16];
#pragma unroll
            for (int b = 0; b < 16; ++b) acc[b] = 0.f;
            for (int i = 0; i < 32; ++i) {
                const int k = kg + 32 * i;
                const float w = P.w_ada[(size_t)k * 6144 + j0 + cl];
                const f32x4* sp = (const f32x4*)(sc + k * 16);
#pragma unroll
                for (int q = 0; q < 4; ++q) { f32x4 s4 = sp[q]; acc[4 * q] += s4[0] * w; acc[4 * q + 1] += s4[1] * w; acc[4 * q + 2] += s4[2] * w; acc[4 * q + 3] += s4[3] * w; }
            }
#pragma unroll
            for (int b = 0; b < 16; ++b) red[(kg * 16 + b) * 16 + cl] = acc[b];
            __syncthreads();
            if (tid < 256) {
                const int b = tid >> 4, c2 = tid & 15; float s = 0.f;
                for (int g = 0; g < 32; ++g) s += red[(g * 16 + b) * 16 + c2];
                mod[b * 6144 + j0 + c2] = s + P.b_ada[j0 + c2];
            }
            __syncthreads();
        }
    }
    for (int it = bid; it < 928 + 256 + 512; it += nblk) {
        const float* src; bf16_t* dst; int N, nt, kt;
        if (it < 928) { src = P.w_in; dst = (bf16_t*)(P.ws + WS_WINT); N = IPW; nt = it % 58; kt = it / 58; }
        else if (it < 928 + 256) { const int r = it - 928; src = P.w_out; dst = (bf16_t*)(P.ws + WS_WOUTT); N = 1024; nt = r % 16; kt = r / 16; }
        else { const int r = it - 1184; src = P.w_query; dst = (bf16_t*)(P.ws + WS_WQT); N = 2048; nt = r % 32; kt = r / 32; }
        const int n0 = nt * 64, k0 = kt * 64;
        {
            const int nl = tid & 63, kb = tid >> 6;
#pragma unroll
            for (int i = 0; i < 8; ++i) { const int kk = kb + 8 * i; const int n = n0 + nl; tile[kk * 65 + nl] = (n < N) ? src[(size_t)(k0 + kk) * N + n] : 0.f; }
        }
        __syncthreads();
        {
            const int kl = (tid & 7) * 8, nl = tid >> 3;
            u32x4 o;
            o.x = pk2(tile[(kl + 0) * 65 + nl], tile[(kl + 1) * 65 + nl]); o.y = pk2(tile[(kl + 2) * 65 + nl], tile[(kl + 3) * 65 + nl]);
            o.z = pk2(tile[(kl + 4) * 65 + nl], tile[(kl + 5) * 65 + nl]); o.w = pk2(tile[(kl + 6) * 65 + nl], tile[(kl + 7) * 65 + nl]);
            *(u32x4*)(dst + (size_t)(n0 + nl) * 1024 + k0 + kl) = o;
        }
        __syncthreads();
    }
    {
        const int lane = tid & 63, wv = tid >> 6;
        for (int row = bid * 8 + wv; row < 2 * NEXP; row += nblk * 8) {
            const bool up = row >= NEXP; const int er = up ? row - NEXP : row;
            const float* src = (up ? P.e_up : P.e_down) + (size_t)er * 1024 + 16 * lane;
            f32x4 v[4]; float am = 0.f;
#pragma unroll
            for (int q = 0; q < 4; ++q) { v[q] = *(const f32x4*)(src + 4 * q); am = fmaxf(am, fmaxf(fmaxf(fabsf(v[q][0]), fabsf(v[q][1])), fmaxf(fabsf(v[q][2]), fabsf(v[q][3])))); }
#pragma unroll
            for (int o = 32; o > 0; o >>= 1) am = fmaxf(am, __shfl_xor(am, o));
            am = am > 0.f ? am : 1.0f;
            u32x4 o4;
            {
                const float sc = am * (1.0f / 127.0f), inv = 127.0f / am;
#pragma unroll
                for (int q = 0; q < 4; ++q) {
                    const int b0 = (int)rintf(v[q][0] * inv), b1 = (int)rintf(v[q][1] * inv), b2 = (int)rintf(v[q][2] * inv), b3 = (int)rintf(v[q][3] * inv);
                    o4[q] = (unsigned)(b0 & 255) | ((unsigned)(b1 & 255) << 8) | ((unsigned)(b2 & 255) << 16) | ((unsigned)(b3 & 255) << 24);
                }
                *(u32x4*)((signed char*)(P.ws + (up ? WS_EU8 : WS_ED8)) + ((size_t)(lane >> 3) * NEXP + er) * 128 + 16 * (lane & 7)) = o4;
                if (lane == 0) ((float*)(P.ws + (up ? WS_SU : WS_SD)))[er] = sc;
            }
        }
    }
    {
        const int gid = bid * NTHREADS + tid;
        if (gid < 32768) {
            const int p = gid >> 14, rem = gid & 16383, d = rem & 127;
            const float v = (p ? P.sk2 : P.sk1)[rem] * P.query_gain[128 * p + d];
            ((bf16_t*)(P.ws + WS_SK))[gid] = (bf16_t)f2bf(v);
        }
    }
}

template <bool WITH_BG, bool WITH_Q8>
__device__ void norm_mod_phase(const Params& P, const float* __restrict__ src, const bf16_t* __restrict__ dlt, float* __restrict__ x1out, const float* __restrict__ gain, const float* __restrict__ mod, int shift_off, int scale_off,
                               bf16_t* __restrict__ dst, int bid, int nblk) {
    const int tid_ = opaque_tid(); const int lane = tid_ & 63, wid = tid_ >> 6;
    float wreg[WITH_BG ? 16 : 1][8];
    if (WITH_BG) {
#pragma unroll
        for (int i = 0; i < 4; ++i)
#pragma unroll
            for (int jj = 0; jj < 4; ++jj) {
                const float* wp = P.w_in + (size_t)(256 * i + 4 * lane + jj) * IPW + 3584;
                const f32x4 w0 = *(const f32x4*)wp, w1 = *(const f32x4*)(wp + 4);
                wreg[4 * i + jj][0] = w0[0]; wreg[4 * i + jj][1] = w0[1]; wreg[4 * i + jj][2] = w0[2]; wreg[4 * i + jj][3] = w0[3];
                wreg[4 * i + jj][4] = w1[0]; wreg[4 * i + jj][5] = w1[1]; wreg[4 * i + jj][6] = w1[2]; wreg[4 * i + jj][7] = w1[3];
            }
    }
    for (int row = bid * 8 + wid; row < NTOK; row += nblk * 8) {
        const int b = row >> 11;
        f32x4 v[4]; float ss = 0.f;
#pragma unroll
        for (int i = 0; i < 4; ++i) {
            v[i] = *(const f32x4*)(src + (size_t)row * DM + 256 * i + 4 * lane);
            if (WITH_Q8) {
                const u32x2 d2 = *(const u32x2*)(dlt + (size_t)row * DM + 256 * i + 4 * lane);
                v[i][0] += bflo(d2.x); v[i][1] += bfhi(d2.x); v[i][2] += bflo(d2.y); v[i][3] += bfhi(d2.y);
            }
            ss += v[i][0] * v[i][0] + v[i][1] * v[i][1] + v[i][2] * v[i][2] + v[i][3] * v[i][3];
        }
#pragma unroll
        for (int o = 32; o > 0; o >>= 1) ss += __shfl_xor(ss, o);
        const float rstd = rsqrtf(ss * (1.0f / DM) + EPS);
        float a8[8];
        float yq[WITH_Q8 ? 4 : 1][4];
#pragma unroll
        for (int q = 0; q < 8; ++q) a8[q] = 0.f;
#pragma unroll
        for (int i = 0; i < 4; ++i) {
            const int c = 256 * i + 4 * lane;
            const f32x4 g = *(const f32x4*)(gain + c), sh = *(const f32x4*)(mod + b * 6144 + shift_off + c), sc = *(const f32x4*)(mod + b * 6144 + scale_off + c);
            float y[4];
#pragma unroll
            for (int jj = 0; jj < 4; ++jj) {
                y[jj] = v[i][jj] * rstd * g[jj] * (1.0f + sc[jj]) + sh[jj];
                if (WITH_BG) {
#pragma unroll
                    for (int q = 0; q < 8; ++q) a8[q] += y[jj] * wreg[4 * i + jj][q];
                }
            }
            u32x2 o; o.x = pk2(y[0], y[1]); o.y = pk2(y[2], y[3]);
            *(u32x2*)(dst + (size_t)row * DM + c) = o;
            if (WITH_Q8) { yq[i][0] = y[0]; yq[i][1] = y[1]; yq[i][2] = y[2]; yq[i][3] = y[3]; }
        }
        if (WITH_Q8) {
            float am = 0.f;
#pragma unroll
            for (int i = 0; i < 4; ++i) am = fmaxf(am, fmaxf(fmaxf(fabsf(yq[i][0]), fabsf(yq[i][1])), fmaxf(fabsf(yq[i][2]), fabsf(yq[i][3]))));
#pragma unroll
            for (int o = 32; o > 0; o >>= 1) am = fmaxf(am, __shfl_xor(am, o));
            am = am > 0.f ? am : 1.0f;
            const float inv = 127.0f / am;
#pragma unroll
            for (int i = 0; i < 4; ++i) {
                const int b0 = (int)rintf(yq[i][0] * inv), b1 = (int)rintf(yq[i][1] * inv), b2 = (int)rintf(yq[i][2] * inv), b3 = (int)rintf(yq[i][3] * inv);
                *(unsigned*)((signed char*)(P.ws + WS_H8) + (size_t)row * DM + 256 * i + 4 * lane) = (unsigned)(b0 & 255) | ((unsigned)(b1 & 255) << 8) | ((unsigned)(b2 & 255) << 16) | ((unsigned)(b3 & 255) << 24);
            }
            if (lane == 0) ((float*)(P.ws + WS_HS))[row] = am * (1.0f / 127.0f);
        }
        if (WITH_BG) {
            const bool u1 = (lane & 1) != 0, u2 = (lane & 2) != 0, u4 = (lane & 4) != 0;
            float z4[4];
#pragma unroll
            for (int q = 0; q < 4; ++q) { const float keep = u1 ? a8[2 * q + 1] : a8[2 * q], send = u1 ? a8[2 * q] : a8[2 * q + 1]; z4[q] = keep + __shfl_xor(send, 1); }
            float z2[2];
#pragma unroll
            for (int q = 0; q < 2; ++q) { const float keep = u2 ? z4[2 * q + 1] : z4[2 * q], send = u2 ? z4[2 * q] : z4[2 * q + 1]; z2[q] = keep + __shfl_xor(send, 2); }
            const float keep = u4 ? z2[1] : z2[0], send = u4 ? z2[0] : z2[1];
            float t = keep + __shfl_xor(send, 4);
            t += __shfl_xor(t, 8); t += __shfl_xor(t, 16); t += __shfl_xor(t, 32);
            if (lane < 4) ((float*)(P.ws + WS_BETA))[(size_t)row * 4 + lane] = 1.0f / (1.0f + __expf(-t));
            else if (lane < 8) {
                const int hq = lane - 4; const float xx = t + P.dt_bias[hq];
                const float sp = xx > 20.f ? xx : log1pf(__expf(xx));
                ((float*)(P.ws + WS_G))[(size_t)row * 4 + hq] = -__expf(P.a_log[hq]) * sp;
            }
        }
    }
}

namespace pg8 {
#define PG8_LAS __attribute__((address_space(3)))
constexpr int BM = 256, BK = 64, HALF = 128, HTB = HALF * BK * 2, NXCD = 8, WGM = 8;
__host__ __device__ __forceinline__ int lds_byte(int r, int c) { const int st = (r >> 4) * 2 + (c >> 5), rr = r & 15, cc = c & 31, ob = rr * 64 + cc * 2; return st * 1024 + (ob ^ (((ob >> 9) & 1) << 5)); }
__host__ __device__ __forceinline__ void stage_rc(int b, int& R, int& C) { const int st = b / 1024, sb = b % 1024, swz = sb ^ (((sb >> 9) & 1) << 5); R = (st >> 1) * 16 + swz / 64; C = (st & 1) * 32 + (swz % 64) / 2; }
__host__ __device__ __forceinline__ int perm32(int rho) { const int n = rho >> 4, i = rho & 15; return 8 * (i >> 2) + 4 * n + (i & 3); }
struct Unit { int pm, pn; };
struct Gemm { const bf16_t* A; const bf16_t* Bt; int M, N, K; };
struct StaticOrder {
    int nM, nN, nwg, G, c;
    __host__ __device__ void init(int M, int N, int G_, int c_) { nM = M / BM; nN = N / BM; nwg = nM * nN; G = G_; c = c_; }
    __host__ __device__ bool next(int i, Unit& u) const {
        const long L = (long)i * G + c; if (L >= nwg) return false;
        int wgid = (int)L; { const int q = nwg / NXCD, r = nwg % NXCD, xcd = wgid % NXCD, off = wgid / NXCD; wgid = (xcd < r ? xcd * (q + 1) : r * (q + 1) + (xcd - r) * q) + off; }
        const int nig = WGM * nN, gid = wgid / nig, fm = gid * WGM, gsz = (nM - fm) < WGM ? (nM - fm) : WGM;
        u.pm = fm + ((wgid % nig) % gsz); u.pn = (wgid % nig) / gsz; return true;
    }
};

template <class Epi>
__device__ __forceinline__ void gemm_phase(PG8_LAS unsigned char* lds, const Gemm g, const StaticOrder& S, const Epi& E) {
    const int tid = opaque_tid(), wid = __builtin_amdgcn_readfirstlane(tid >> 6), lane = tid & 63, wr = wid >> 2, wc = wid & 3, fr = lane & 15, fq = lane >> 4;
    const int K = g.K, nt = K / BK;
    unsigned voffA[2], voffB[2];
#pragma unroll
    for (int i = 0; i < 2; ++i) { int R, C; stage_rc(tid * 16 + i * 8192, R, C); const int Rb = 64 * (R >> 5) + perm32(R & 31);
        voffA[i] = (unsigned)(R * K + C) * 2u; voffB[i] = (unsigned)(Rb * K + C) * 2u; }
    const size_t kstep = (size_t)(BK * 2);
    const size_t hstep = (size_t)HALF * K * 2;
    const size_t hstepB = (size_t)32 * K * 2;
    const size_t tstep = 2 * hstep;
    const unsigned ldsw = (unsigned)wid * 1024u;
    const int aoff = lds_byte(wr * 64 + fr, fq * 8), boff = lds_byte(wc * 32 + fr, fq * 8);
#define PG8_SA(b, h) (((b) * 2 + (h)) * HTB)
#define PG8_SB(b, h) ((4 + (b) * 2 + (h)) * HTB)
#define PG8_STAGE(bufoff, gbase, voff) do { _Pragma("unroll") for (int _i = 0; _i < 2; ++_i) \
        __builtin_amdgcn_global_load_lds((const unsigned*)((const char*)(gbase) + (voff)[_i]), (PG8_LAS unsigned*)(lds + (bufoff) + ldsw + _i * 8192), 16, 0, 0); } while (0)
#define PG8_LDA(dst, b, h) do { _Pragma("unroll") for (int m = 0; m < 4; ++m) _Pragma("unroll") for (int k = 0; k < 2; ++k) dst[m][k] = *(const PG8_LAS bf16x8*)(lds + PG8_SA(b, h) + aoff + m * 2048 + k * 1024); } while (0)
#define PG8_LDB(dst, b, h) do { _Pragma("unroll") for (int n = 0; n < 2; ++n) _Pragma("unroll") for (int k = 0; k < 2; ++k) dst[n][k] = *(const PG8_LAS bf16x8*)(lds + PG8_SB(b, h) + boff + n * 2048 + k * 1024); } while (0)
#define PG8_MMA(ai, bj, At, Bt) do { __builtin_amdgcn_s_setprio(1); _Pragma("unroll") for (int m = 0; m < 4; ++m) _Pragma("unroll") for (int n = 0; n < 2; ++n) _Pragma("unroll") for (int k = 0; k < 2; ++k) \
        acc[ai][bj][m][n] = __builtin_amdgcn_mfma_f32_16x16x32_bf16(Bt[n][k], At[m][k], acc[ai][bj][m][n], 0, 0, 0); __builtin_amdgcn_s_setprio(0); } while (0)
#define PG8_WAIT_V(n) asm volatile("s_waitcnt vmcnt(" #n ")" ::: "memory")
#define PG8_WAIT_L(n) asm volatile("s_waitcnt lgkmcnt(" #n ")" ::: "memory")
#define PG8_BAR __builtin_amdgcn_s_barrier()
#define PG8_SCHED __builtin_amdgcn_sched_barrier(0)
    Unit cur, nxt; int ui = 0;
    if (!S.next(0, cur)) return;
    f32x4 acc[2][2][4][2];
#pragma unroll
    for (int a = 0; a < 2; ++a)
#pragma unroll
        for (int b = 0; b < 2; ++b)
#pragma unroll
            for (int m = 0; m < 4; ++m)
#pragma unroll
                for (int n = 0; n < 2; ++n) acc[a][b][m][n] = (f32x4){0.f, 0.f, 0.f, 0.f};
    bf16x8 At[4][2], B0[2][2], B1[2][2];
    const char* cA = (const char*)g.A + (size_t)cur.pm * tstep; const char* cB = (const char*)g.Bt + (size_t)cur.pn * tstep;
    PG8_STAGE(PG8_SB(0, 0), cB, voffB); PG8_STAGE(PG8_SB(0, 1), cB + hstepB, voffB); PG8_STAGE(PG8_SA(0, 0), cA, voffA); PG8_STAGE(PG8_SA(0, 1), cA + hstep, voffA);
    if (wr == 1) PG8_BAR;
    PG8_WAIT_V(2); PG8_BAR;
    PG8_STAGE(PG8_SB(1, 0), cB + kstep, voffB); PG8_STAGE(PG8_SA(1, 0), cA + kstep, voffA); PG8_STAGE(PG8_SB(1, 1), cB + hstepB + kstep, voffB);
    PG8_WAIT_V(6); PG8_BAR;
    for (;;) {
        const bool has_next = S.next(ui + 1, nxt);
        const char* nA = has_next ? (const char*)g.A + (size_t)nxt.pm * tstep : cA; const char* nB = has_next ? (const char*)g.Bt + (size_t)nxt.pn * tstep : cB;
        for (int t = 0; t < nt; t += 2) {
            const bool last = (t == nt - 2);
            const char* a1 = cA + (size_t)(t + 1) * kstep;
            const char* a2 = last ? nA : cA + (size_t)(t + 2) * kstep; const char* b2 = last ? nB : cB + (size_t)(t + 2) * kstep;
            const char* a3 = a2 + kstep; const char* b3 = b2 + kstep;
            PG8_LDB(B0, 0, 0); PG8_LDB(B1, 0, 1); PG8_SCHED; PG8_LDA(At, 0, 0); PG8_STAGE(PG8_SA(1, 1), a1 + hstep, voffA);
            PG8_WAIT_V(8); PG8_WAIT_L(0); PG8_BAR; PG8_MMA(0, 0, At, B0); PG8_MMA(0, 1, At, B1); PG8_BAR; PG8_SCHED;
            PG8_LDA(At, 0, 1); PG8_STAGE(PG8_SB(0, 0), b2, voffB); PG8_STAGE(PG8_SB(0, 1), b2 + hstepB, voffB); PG8_STAGE(PG8_SA(0, 0), a2, voffA);
            PG8_WAIT_V(8); PG8_WAIT_L(0); PG8_BAR; PG8_MMA(1, 0, At, B0); PG8_MMA(1, 1, At, B1); PG8_BAR; PG8_SCHED;
            PG8_LDB(B0, 1, 0); PG8_LDB(B1, 1, 1); PG8_SCHED; PG8_LDA(At, 1, 0); PG8_STAGE(PG8_SA(0, 1), a2 + hstep, voffA);
            PG8_WAIT_V(8); PG8_WAIT_L(0); PG8_BAR; PG8_MMA(0, 0, At, B0); PG8_MMA(0, 1, At, B1); PG8_BAR; PG8_SCHED;
            PG8_LDA(At, 1, 1); PG8_STAGE(PG8_SB(1, 0), b3, voffB); PG8_STAGE(PG8_SB(1, 1), b3 + hstepB, voffB); PG8_STAGE(PG8_SA(1, 0), a3, voffA);
            PG8_WAIT_V(8); PG8_WAIT_L(0); PG8_BAR; PG8_MMA(1, 0, At, B0); PG8_MMA(1, 1, At, B1); PG8_BAR; PG8_SCHED;
        }
        if (wr == 0) PG8_BAR;
        E(acc, cur, wr, wc, fr, fq);
        if (!has_next) break;
#pragma unroll
        for (int a = 0; a < 2; ++a)
#pragma unroll
            for (int b = 0; b < 2; ++b)
#pragma unroll
                for (int m = 0; m < 4; ++m)
#pragma unroll
                    for (int n = 0; n < 2; ++n) acc[a][b][m][n] = (f32x4){0.f, 0.f, 0.f, 0.f};
        cur = nxt; cA = nA; cB = nB; ++ui;
        if (wr == 1) PG8_BAR;
    }
    PG8_WAIT_V(0);
    PG8_BAR;
#undef PG8_SA
#undef PG8_SB
#undef PG8_STAGE
#undef PG8_LDA
#undef PG8_LDB
#undef PG8_MMA
#undef PG8_WAIT_V
#undef PG8_WAIT_L
#undef PG8_BAR
#undef PG8_SCHED
}
}

#define ACC_T const f32x4 (&acc)[2][2][4][2]
__device__ __forceinline__ u32x4 pack_acc8(const f32x4& a, const f32x4& b, float s) {
    u32x4 o; o.x = pk2(a[0] * s, a[1] * s); o.y = pk2(a[2] * s, a[3] * s); o.z = pk2(b[0] * s, b[1] * s); o.w = pk2(b[2] * s, b[3] * s); return o;
}
struct EpiQK {
    const float *q_gain, *k_gain;
    bf16_t *qa, *ka;
    __device__ __forceinline__ void operator()(ACC_T, const pg8::Unit& u, int wr, int wc, int fr, int fq) const {
        const int pn = u.pn, bb = u.pm >> 3, s0 = (u.pm & 7) * 256 + wr * 64;
        {
            const bool isq = pn < 2; const int head = (pn & 1) * 4 + wc;
            const float* gn = isq ? q_gain : k_gain; const float sc = isq ? 0.125f * 1.4426950408889634f : 1.0f;
            bf16_t* ub = (isq ? qa : ka) + ((size_t)(bb * AH + head) * SEQ + s0) * 64;
            const unsigned lo = isq ? (unsigned)(fr * 64 + 8 * fq) : (unsigned)(fq * 256 + fr * 8);
            const float* gl = gn + 8 * fq;
#pragma unroll
            for (int ai = 0; ai < 2; ++ai)
#pragma unroll
                for (int m = 0; m < 4; ++m) {
                    float ss = 0.f;
#pragma unroll
                    for (int bj = 0; bj < 2; ++bj)
#pragma unroll
                        for (int n = 0; n < 2; ++n)
#pragma unroll
                            for (int r = 0; r < 4; ++r) ss += acc[ai][bj][m][n][r] * acc[ai][bj][m][n][r];
                    ss += __shfl_xor(ss, 16); ss += __shfl_xor(ss, 32);
                    const float rstd = rsqrtf(ss * (1.0f / 64.0f) + EPS) * sc;
                    bf16_t* p = isq ? (ub + (ai * 128 + m * 16) * 64) : (ub + (ai * 4 + (m >> 1)) * 2048 + (m & 1) * 128);
#pragma unroll
                    for (int bj = 0; bj < 2; ++bj) {
                        const f32x4 g0 = *(const f32x4*)(gl + 32 * bj), g1 = *(const f32x4*)(gl + 32 * bj + 4);
                        u32x4 o;
                        o.x = pk2(acc[ai][bj][m][0][0] * rstd * g0[0], acc[ai][bj][m][0][1] * rstd * g0[1]); o.y = pk2(acc[ai][bj][m][0][2] * rstd * g0[2], acc[ai][bj][m][0][3] * rstd * g0[3]);
                        o.z = pk2(acc[ai][bj][m][1][0] * rstd * g1[0], acc[ai][bj][m][1][1] * rstd * g1[1]); o.w = pk2(acc[ai][bj][m][1][2] * rstd * g1[2], acc[ai][bj][m][1][3] * rstd * g1[3]);
                        *(u32x4*)(p + (isq ? 32 * bj : 1024 * bj) + lo) = o;
                    }
                }
        }
    }
};
struct EpiV {
    bf16_t* vt;
    __device__ __forceinline__ void operator()(ACC_T, const pg8::Unit& u, int wr, int wc, int fr, int fq) const {
        const int pn = u.pn, bb = u.pm >> 3, s0 = (u.pm & 7) * 256 + wr * 64;
        {
            const int head = (pn & 1) * 4 + wc;
            bf16_t* ub = vt + ((size_t)(bb * AH + head) * SEQ + s0) * 64;
            const int pp = swap23(fr);
            const unsigned lo = (unsigned)((pp >> 3) * 256 + 8 * fq * 8 + (pp & 7));
#pragma unroll
            for (int ai = 0; ai < 2; ++ai)
#pragma unroll
                for (int m = 0; m < 4; ++m)
#pragma unroll
                    for (int bj = 0; bj < 2; ++bj)
#pragma unroll
                        for (int n = 0; n < 2; ++n)
#pragma unroll
                            for (int r = 0; r < 4; ++r)
                                (ub + (ai * 2 + (m >> 2)) * 4096 + ((bj * 2 + ((m >> 1) & 1)) * 2 + (m & 1)) * 512 + (4 * n + r) * 8)[lo] = (bf16_t)f2bf(acc[ai][bj][m][n][r]);
        }
    }
};
struct EpiOut {
    const float* mod; bf16_t* dlt;
    __device__ __forceinline__ void operator()(ACC_T, const pg8::Unit& u, int wr, int wc, int fr, int fq) const {
        bf16_t* ub = dlt + (size_t)(u.pm * 256 + wr * 64) * DM + u.pn * 256 + wc * 64;
        const float* ug = mod + (u.pm >> 3) * 6144 + 2048 + u.pn * 256 + wc * 64;
        const unsigned lo = (unsigned)(fr * DM + 8 * fq), lg = (unsigned)(8 * fq);
#pragma unroll
        for (int bj = 0; bj < 2; ++bj) {
            const f32x4 g0 = *(const f32x4*)(ug + 32 * bj + lg), g1 = *(const f32x4*)(ug + 32 * bj + 4 + lg);
#pragma unroll
            for (int ai = 0; ai < 2; ++ai)
#pragma unroll
                for (int m = 0; m < 4; ++m) {
                    const f32x4& a0 = acc[ai][bj][m][0]; const f32x4& a1 = acc[ai][bj][m][1];
                    u32x4 o; o.x = pk2(a0[0] * g0[0], a0[1] * g0[1]); o.y = pk2(a0[2] * g0[2], a0[3] * g0[3]); o.z = pk2(a1[0] * g1[0], a1[1] * g1[1]); o.w = pk2(a1[2] * g1[2], a1[3] * g1[3]);
                    *(u32x4*)(ub + (ai * 128 + m * 16) * DM + 32 * bj + lo) = o;
                }
        }
    }
};
struct EpiBf {
    bf16_t* dst; int ld;
    __device__ __forceinline__ void operator()(ACC_T, const pg8::Unit& u, int wr, int wc, int fr, int fq) const {
        bf16_t* ub = dst + (size_t)(u.pm * 256 + wr * 64) * ld + u.pn * 256 + wc * 64;
        const unsigned lo = (unsigned)(fr * ld + 8 * fq);
#pragma unroll
        for (int ai = 0; ai < 2; ++ai)
#pragma unroll
            for (int m = 0; m < 4; ++m)
#pragma unroll
                for (int bj = 0; bj < 2; ++bj) *(u32x4*)(ub + (ai * 128 + m * 16) * ld + 32 * bj + lo) = pack_acc8(acc[ai][bj][m][0], acc[ai][bj][m][1], 1.0f);
    }
};
struct EpiInAll {
    EpiQK qk; EpiV v; EpiBf pbf;
    __device__ __forceinline__ void operator()(ACC_T, const pg8::Unit& u, int wr, int wc, int fr, int fq) const {
        if (u.pn < 4) qk(acc, u, wr, wc, fr, fq);
        else if (u.pn < 6) { pg8::Unit u2 = u; u2.pn = u.pn - 4; v(acc, u2, wr, wc, fr, fq); }
        else { pg8::Unit u2 = u; u2.pn = u.pn - 6; pbf(acc, u2, wr, wc, fr, fq); }
    }
};
#undef ACC_T
template <class Epi>
__device__ __forceinline__ void gemm_run(const bf16_t* A, const bf16_t* Bt, int M, int N, int K, const Epi& e, unsigned char* lds, int bid, int nblk) {
    pg8::Gemm g{A, Bt, M, N, K}; pg8::StaticOrder S; S.init(M, N, nblk, bid);
    pg8::gemm_phase<Epi>((PG8_LAS unsigned char*)lds, g, S, e);
}

__device__ void attn_phase(const Params& P, unsigned char* lds, int bid, int nblk) {
    const int tid0 = opaque_tid();
    {
        const int head = tid0 >> 6, lane = tid0 & 63;
        float* biasL = (float*)lds + head * 260;
        for (int i = lane; i < 257; i += 64) biasL[i] = (P.rel_bias[head * 257 + i] - P.rel_bias[head * 257 + 256]) * 1.4426950408889634f;
    }
    const bf16_t* qa = (const bf16_t*)(P.ws + WS_QA); const bf16_t* ka = (const bf16_t*)(P.ws + WS_KA); const bf16_t* vt = (const bf16_t*)(P.ws + WS_VT);
    bf16_t* mix = (bf16_t*)(P.ws + WS_H);
    for (int it = bid; it < 512; it += nblk) {
        int tid = tid0; asm volatile("" : "+v"(tid));
        const int head = tid >> 6, lane = tid & 63, l31 = lane & 31, hh = lane >> 5;
        const float* biasL = (const float*)lds + head * 260;
        float* ssq = (float*)(lds + 8 * 260 * 4);
        float* park = (float*)(lds + 16384) + head * 4096;
        const int it2 = it & 255, b = it2 & 15, pp = it2 >> 4, n = (it < 256) ? pp : 31 - pp;
        const size_t hb = (size_t)(b * AH + head);
        const bf16_t* qbase = qa + (hb * SEQ + (size_t)n * 64) * 64;
        const int cstart = (n >= 8) ? 0 : 8 - n;
        float ssv[2];
#pragma unroll
        for (int qt = 0; qt < 2; ++qt) {
            const int qi = 32 * qt + l31;
            bf16x8 bq[4];
#pragma unroll
            for (int ks = 0; ks < 4; ++ks) bq[ks] = *(const bf16x8*)(qbase + qi * 64 + 16 * ks + 8 * hh);
            f32x16 o0, o1;
#pragma unroll
            for (int r = 0; r < 16; ++r) { o0[r] = 0.f; o1[r] = 0.f; }
            float mrun = -1e30f, lrun = 0.f;
            bf16x8 kc0[4], kc1[4];
            {
                const bf16_t* kb = ka + (hb * SEQ + (size_t)(n + cstart - 8) * 64) * 64;
#pragma unroll
                for (int ks = 0; ks < 4; ++ks) { kc0[ks] = *(const bf16x8*)(kb + (2 * ks + hh) * 256 + l31 * 8); kc1[ks] = *(const bf16x8*)(kb + 2048 + (2 * ks + hh) * 256 + l31 * 8); }
            }
            for (int c = cstart; c <= 8; ++c) {
                const int kc = n + c - 8;
                const bf16_t* vb = vt + (hb * SEQ + (size_t)kc * 64) * 64;
                bf16x8 v0[4], v1[4], kn0[4], kn1[4];
#pragma unroll
                for (int kt = 0; kt < 2; ++kt)
#pragma unroll
                    for (int sp = 0; sp < 2; ++sp) {
                        v0[2 * kt + sp] = *(const bf16x8*)(vb + ((kt * 2 + sp) * 2 + hh) * 256 + l31 * 8);
                        v1[2 * kt + sp] = *(const bf16x8*)(vb + 2048 + ((kt * 2 + sp) * 2 + hh) * 256 + l31 * 8);
                    }
                {
                    const int kcn = (c < 8) ? kc + 1 : kc;
                    const bf16_t* kb = ka + (hb * SEQ + (size_t)kcn * 64) * 64;
#pragma unroll
                    for (int ks = 0; ks < 4; ++ks) { kn0[ks] = *(const bf16x8*)(kb + (2 * ks + hh) * 256 + l31 * 8); kn1[ks] = *(const bf16x8*)(kb + 2048 + (2 * ks + hh) * 256 + l31 * 8); }
                }
                f32x16 s0, s1;
#pragma unroll
                for (int r = 0; r < 16; ++r) { s0[r] = 0.f; s1[r] = 0.f; }
#pragma unroll
                for (int ks = 0; ks < 4; ++ks) { s0 = mfma32(kc0[ks], bq[ks], s0); s1 = mfma32(kc1[ks], bq[ks], s1); }
                if (c > 5) {
                    const int base = qi + 64 * (8 - c) + 128 - 4 * hh;
#pragma unroll
                    for (int r = 0; r < 16; ++r) {
                        const int j0 = (r & 3) + 8 * (r >> 2);
                        int i0 = base - j0; i0 = i0 > 256 ? 256 : i0;
                        int i1 = base - 32 - j0; i1 = i1 > 256 ? 256 : i1;
                        s0[r] += biasL[i0]; s1[r] += biasL[i1];
                    }
                }
                float mx = s0[0];
#pragma unroll
                for (int r = 1; r < 16; ++r) mx = fmaxf(mx, s0[r]);
#pragma unroll
                for (int r = 0; r < 16; ++r) mx = fmaxf(mx, s1[r]);
                mx = fmaxf(mx, __shfl_xor(mx, 32));
                const float mnew = fmaxf(mrun, mx);
                const bool grew = mnew > mrun;
                const float alpha = __builtin_amdgcn_exp2f(mrun - mnew);
                mrun = mnew;
                float psum = 0.f;
#pragma unroll
                for (int r = 0; r < 16; ++r) { s0[r] = __builtin_amdgcn_exp2f(s0[r] - mnew); s1[r] = __builtin_amdgcn_exp2f(s1[r] - mnew); psum += s0[r] + s1[r]; }
                lrun = lrun * alpha + psum;
                if (__any(grew)) {
#pragma unroll
                    for (int r = 0; r < 16; ++r) { o0[r] *= alpha; o1[r] *= alpha; }
                }
                bf16x8 pf[4];
                pf[0] = pack8(s0[0], s0[1], s0[2], s0[3], s0[4], s0[5], s0[6], s0[7]);
                pf[1] = pack8(s0[8], s0[9], s0[10], s0[11], s0[12], s0[13], s0[14], s0[15]);
                pf[2] = pack8(s1[0], s1[1], s1[2], s1[3], s1[4], s1[5], s1[6], s1[7]);
                pf[3] = pack8(s1[8], s1[9], s1[10], s1[11], s1[12], s1[13], s1[14], s1[15]);
#pragma unroll
                for (int q4 = 0; q4 < 4; ++q4) { o0 = mfma32(v0[q4], pf[q4], o0); o1 = mfma32(v1[q4], pf[q4], o1); }
#pragma unroll
                for (int ks = 0; ks < 4; ++ks) { kc0[ks] = kn0[ks]; kc1[ks] = kn1[ks]; }
            }
            const float ltot = lrun + __shfl_xor(lrun, 32), inv = 1.0f / ltot;
            float ss = 0.f;
#pragma unroll
            for (int r = 0; r < 16; ++r) { o0[r] *= inv; o1[r] *= inv; ss += o0[r] * o0[r] + o1[r] * o1[r]; }
            ss += __shfl_xor(ss, 32);
            ssv[qt] = ss;
#pragma unroll
            for (int r = 0; r < 16; ++r) { park[(qt * 32 + r) * 64 + lane] = o0[r]; park[(qt * 32 + 16 + r) * 64 + lane] = o1[r]; }
        }
        if (hh == 0) { ssq[head * 64 + l31] = ssv[0]; ssq[head * 64 + 32 + l31] = ssv[1]; }
        __syncthreads();
#pragma unroll
        for (int qt = 0; qt < 2; ++qt) {
            const int qi = 32 * qt + l31;
            float tot = 0.f;
#pragma unroll
            for (int h2 = 0; h2 < 8; ++h2) tot += ssq[h2 * 64 + qi];
            const float rstd = rsqrtf(tot * (1.0f / 512.0f) + EPS);
            const size_t tok = (size_t)b * SEQ + n * 64 + qi;
#pragma unroll
            for (int dt = 0; dt < 2; ++dt)
#pragma unroll
                for (int g4 = 0; g4 < 4; ++g4) {
                    const int dim = 32 * dt + 8 * g4 + 4 * hh;
                    const f32x4 gn = *(const f32x4*)(P.attn_out_gain + head * 64 + dim);
                    const float* pk = park + (qt * 32 + dt * 16 + 4 * g4) * 64 + lane;
                    u32x2 w; w.x = pk2(pk[0] * rstd * gn[0], pk[64] * rstd * gn[1]); w.y = pk2(pk[128] * rstd * gn[2], pk[192] * rstd * gn[3]);
                    *(u32x2*)(mix + tok * DM + head * 64 + dim) = w;
                }
        }
        __syncthreads();
    }
}

constexpr int RP = 136, TP = 72, AP = 72, AIP = 24, LDB = 273, RAWP = 784  , STGP = 136  ;
constexpr int L_KB = 0, L_KK = 17408, L_QS = 34816, L_UT = 0, L_WT = 18432, L_AINV = 36864, L_QG = 52224, L_VBT = 69632, L_KBGT = 88064, L_KDT = 106496,
              L_NL = 124928, L_LD = 134144, L_AM = 138752, L_GC = 147968, L_RED = 148480;
static_assert(L_AINV + 4 * 16 * AIP * 2 <= L_QG && L_LD + 4 * LDB * 4 <= L_AM && L_RED + 4096 <= LDS_BYTES - 16, "lds map");

__device__ void dn1_phase(const Params& P, unsigned char* lds, int bid, int nblk) {
    const int tid0 = opaque_tid();
    bf16_t* KB = (bf16_t*)(lds + L_KB); bf16_t* KK = (bf16_t*)(lds + L_KK); bf16_t* QS = (bf16_t*)(lds + L_QS);
    bf16_t* UT = (bf16_t*)(lds + L_UT); bf16_t* WT = (bf16_t*)(lds + L_WT); bf16_t* AINV = (bf16_t*)(lds + L_AINV); bf16_t* QG = (bf16_t*)(lds + L_QG);
    bf16_t* VBT = (bf16_t*)(lds + L_VBT); bf16_t* KBGT = (bf16_t*)(lds + L_KBGT); bf16_t* KDT = (bf16_t*)(lds + L_KDT);
    bf16_t* NL = (bf16_t*)(lds + L_NL); float* LD = (float*)(lds + L_LD); bf16_t* AM = (bf16_t*)(lds + L_AM);
    float* gcs = (float*)(lds + L_GC); float* bts = gcs + 64; float* red = (float*)(lds + L_RED);
    const bf16_t* pb = (const bf16_t*)(P.ws + WS_PB);
    const float* betaG = (const float*)(P.ws + WS_BETA); const float* gG = (const float*)(P.ws + WS_G);
    bf16_t* negM = (bf16_t*)(P.ws + WS_NEGM); bf16_t* BmT = (bf16_t*)P.out; bf16_t* Qp = (bf16_t*)(P.ws + WS_QP); bf16_t* Ol = (bf16_t*)(P.ws + WS_OL);
    float* egl = (float*)(P.ws + WS_EGL);
    u32x4 rv[7]; float gpre = 0.f, bpre = 0.f;
#define DN1_PREFETCH(IT)                                                                                                   \
    {                                                                                                                      \
        const int tidp_ = tid0, n_ = (IT) & 31, bh_ = (IT) >> 5, h_ = bh_ & 3, b_ = bh_ >> 2;                               \
        _Pragma("unroll") for (int q = 0; q < 7; ++q) {                                                                    \
            const int ci = tidp_ + 512 * q, row = ci / 48, c16 = ci - row * 48, mat = c16 >> 4, cc = c16 & 15;             \
            const int srow = n_ * 64 - 3 + row;                                                                            \
            const bool ok = (ci < 67 * 48) && (srow >= 0);                                                                 \
            const bf16_t* src = pb + (size_t)(b_ * SEQ + (ok ? srow : 0)) * PBW + mat * 512 + h_ * 128 + cc * 8;           \
            rv[q] = *(const u32x4*)src;                                                                                    \
            if (!ok) rv[q] = (u32x4){0u, 0u, 0u, 0u};                                                                      \
        }                                                                                                                  \
        if (tidp_ < 64) { const size_t tg_ = (size_t)(b_ * SEQ + n_ * 64 + tidp_) * 4 + h_; gpre = gG[tg_]; bpre = betaG[tg_]; } \
    }
    unsigned* qctr = (unsigned*)P.ws + 4000;
    volatile int* qnext = (volatile int*)(lds + LDS_BYTES - 32);
    if (bid < 2048) { DN1_PREFETCH(bid) }
    int item = bid;
    while (item < 2048) {
        if (tid0 == 0) *qnext = nblk + (int)__hip_atomic_fetch_add(qctr, 1u, __ATOMIC_RELAXED, __HIP_MEMORY_SCOPE_AGENT);
        int tid = tid0; asm volatile("" : "+v"(tid));
        const int wid = tid >> 6, lane = tid & 63, fr = lane & 15, fq = lane >> 4;
        const int n = item & 31, bh = item >> 5, h = bh & 3, b = bh >> 2;
        const int t0 = b * SEQ + n * 64;
        if (wid == 0) {
            float gv = gpre;
#pragma unroll
            for (int o = 1; o < 64; o <<= 1) { const float t = __shfl_up(gv, o); if (lane >= o) gv += t; }
            gcs[lane] = gv; bts[lane] = bpre;
        }
#pragma unroll
        for (int q = 0; q < 7; ++q) {
            const int ci = tid + 512 * q, row = ci / 48, c16 = ci - row * 48;
            if (ci < 67 * 48) *(u32x4*)(lds + row * RAWP + c16 * 16) = rv[q];
        }
        __syncthreads();
        const int r = lane, cg = __builtin_amdgcn_readfirstlane(wid);
        float cv[3][16];
#pragma unroll
        for (int mat = 0; mat < 3; ++mat) {
            const int col = mat * 512 + h * 128 + 16 * cg;
            float* a = cv[mat];
#pragma unroll
            for (int i = 0; i < 16; ++i) a[i] = 0.f;
#pragma unroll
            for (int tap = 0; tap < 4; ++tap) {
                const unsigned char* src = lds + (r + tap) * RAWP + (mat * 128 + 16 * cg) * 2;
                const u32x4 x0 = *(const u32x4*)src, x1 = *(const u32x4*)(src + 16);
                const float* wp = P.conv_w + tap * 1536 + col;
                const f32x4 w0 = *(const f32x4*)wp, w1 = *(const f32x4*)(wp + 4), w2 = *(const f32x4*)(wp + 8), w3 = *(const f32x4*)(wp + 12);
                a[0] += bflo(x0.x) * w0[0]; a[1] += bfhi(x0.x) * w0[1]; a[2] += bflo(x0.y) * w0[2]; a[3] += bfhi(x0.y) * w0[3];
                a[4] += bflo(x0.z) * w1[0]; a[5] += bfhi(x0.z) * w1[1]; a[6] += bflo(x0.w) * w1[2]; a[7] += bfhi(x0.w) * w1[3];
                a[8] += bflo(x1.x) * w2[0]; a[9] += bfhi(x1.x) * w2[1]; a[10] += bflo(x1.y) * w2[2]; a[11] += bfhi(x1.y) * w2[3];
                a[12] += bflo(x1.z) * w3[0]; a[13] += bfhi(x1.z) * w3[1]; a[14] += bflo(x1.w) * w3[2]; a[15] += bfhi(x1.w) * w3[3];
            }
            float ss = 0.f;
#pragma unroll
            for (int i = 0; i < 16; ++i) { a[i] = silu_f(a[i]); ss += a[i] * a[i]; }
            if (mat < 2) red[(mat * 8 + cg) * 64 + r] = ss;
        }
        __syncthreads();
        {
            float sq = 0.f, sk = 0.f;
#pragma unroll
            for (int g8 = 0; g8 < 8; ++g8) { sq += red[g8 * 64 + r]; sk += red[(8 + g8) * 64 + r]; }
            const float gc = gcs[r], bt = bts[r], gl = gcs[63];
            const float eg = __expf(gc), edk = __expf(gl - gc);
            if (tid == 0) egl[item] = __expf(gl);
            const float rq = rsqrtf(sq + EPS) * 0.08838834764831845f, rk = rsqrtf(sk + EPS);
            u32x4 o0, o1;
#define STORE_ROW(ARR, A, F)                                                                                                             \
    {                                                                                                                                    \
        o0.x = pk2(A[0] * (F), A[1] * (F)); o0.y = pk2(A[2] * (F), A[3] * (F)); o0.z = pk2(A[4] * (F), A[5] * (F)); o0.w = pk2(A[6] * (F), A[7] * (F));       \
        o1.x = pk2(A[8] * (F), A[9] * (F)); o1.y = pk2(A[10] * (F), A[11] * (F)); o1.z = pk2(A[12] * (F), A[13] * (F)); o1.w = pk2(A[14] * (F), A[15] * (F)); \
        *(u32x4*)(ARR + r * RP + 16 * cg) = o0; *(u32x4*)(ARR + r * RP + 16 * cg + 8) = o1;                                              \
    }
            const float rqe = rq * eg, rkb = rk * bt, f1 = rk * bt * eg, f2 = rk * edk;
            STORE_ROW(QS, cv[0], rq)
            STORE_ROW(QG, cv[0], rqe)
            STORE_ROW(KK, cv[1], rk)
            STORE_ROW(KB, cv[1], rkb)
#undef STORE_ROW
#pragma unroll
            for (int i = 0; i < 16; ++i) {
                const int c = 16 * cg + i;
                KBGT[c * TP + r] = (bf16_t)f2bf(cv[1][i] * f1);
                KDT[c * TP + r] = (bf16_t)f2bf(cv[1][i] * f2);
                VBT[c * TP + r] = (bf16_t)f2bf(cv[2][i] * bt);
            }
        }
        __syncthreads();
        const int item_next = __builtin_amdgcn_readfirstlane(*qnext);
        if (item_next < 2048) { DN1_PREFETCH(item_next) }
        {
            const int mat = wid >> 2, ti = wid & 3;
            const bf16_t* Asrc = mat ? QS : KB;
            bf16x8 af[4];
#pragma unroll
            for (int ks = 0; ks < 4; ++ks) af[ks] = *(const bf16x8*)(Asrc + (16 * ti + fr) * RP + 32 * ks + 8 * fq);
            for (int tj = 0; tj < 4; ++tj) {
                const int j = 16 * tj + fr;
                if (tj > ti) {
                    if (mat) {
#pragma unroll
                        for (int rr = 0; rr < 4; ++rr) AM[(16 * ti + 4 * fq + rr) * AP + j] = 0;
                    }
                    continue;
                }
                f32x4 acc = (f32x4){0.f, 0.f, 0.f, 0.f};
#pragma unroll
                for (int ks = 0; ks < 4; ++ks) { const bf16x8 bf = *(const bf16x8*)(KK + j * RP + 32 * ks + 8 * fq); acc = mfma16(af[ks], bf, acc); }
                const float gj = gcs[j];
#pragma unroll
                for (int rr = 0; rr < 4; ++rr) {
                    const int i = 16 * ti + 4 * fq + rr;
                    const float dec = __expf(gcs[i] - gj);
                    if (mat == 0) {
                        if (tj < ti) NL[i * AP + j] = (bf16_t)f2bf(-acc[rr] * dec);
                        else LD[ti * LDB + (4 * fq + rr) * 17 + fr] = (i > j) ? acc[rr] * dec : 0.f;
                    } else AM[i * AP + j] = (bf16_t)f2bf((i >= j) ? acc[rr] * dec : 0.f);
                }
            }
        }
        __syncthreads();
        {
            {
                const int blk = lane >> 4, cp = lane & 15;
                float xv[16];
#pragma unroll
                for (int i = 0; i < 16; ++i) {
                    float a = (i == cp) ? 1.0f : 0.0f;
#pragma unroll
                    for (int jj = 0; jj < i; ++jj) a -= LD[blk * LDB + i * 17 + jj] * xv[jj];
                    xv[i] = a;
                }
#pragma unroll
                for (int i = 0; i < 16; ++i) AINV[(blk * 16 + i) * AIP + cp] = (bf16_t)f2bf(xv[i]);
            }
#pragma unroll 1
            for (int cti = 0; cti < 2; ++cti) {
                const int ct = 2 * wid + cti;
                const bf16_t* RT = (ct < 8) ? (VBT + (16 * ct) * TP) : (KBGT + (16 * (ct - 8)) * TP);
                bf16_t* XT = (ct < 8) ? (UT + (16 * ct) * TP) : (WT + (16 * (ct - 8)) * TP);
#pragma unroll
                for (int bq = 0; bq < 4; ++bq) {
                    const u32x2 r2 = *(const u32x2*)(RT + fr * TP + 16 * bq + 4 * fq);
                    f32x4 acc = (f32x4){bflo(r2.x), bfhi(r2.x), bflo(r2.y), bfhi(r2.y)};
                    if (bq > 0) {
#pragma unroll
                        for (int ks = 0; ks < (16 * bq + 31) / 32; ++ks) {
                            bf16x8 a = *(const bf16x8*)(NL + (16 * bq + fr) * AP + 32 * ks + 8 * fq);
                            bf16x8 xb = *(const bf16x8*)(XT + fr * TP + 32 * ks + 8 * fq);
                            if (32 * ks + 8 * fq >= 16 * bq) { a = (bf16x8){0, 0, 0, 0, 0, 0, 0, 0}; xb = (bf16x8){0, 0, 0, 0, 0, 0, 0, 0}; }
                            acc = mfma16(a, xb, acc);
                        }
                    }
                    u32x4 uf; uf.x = pk2(acc[0], acc[1]); uf.y = pk2(acc[2], acc[3]); uf.z = 0u; uf.w = 0u;
                    const u32x2 ai2 = *(const u32x2*)(AINV + (bq * 16 + fr) * AIP + 4 * fq);
                    u32x4 af; af.x = ai2.x; af.y = ai2.y; af.z = 0u; af.w = 0u;
                    f32x4 xo = (f32x4){0.f, 0.f, 0.f, 0.f};
                    xo = mfma16(__builtin_bit_cast(bf16x8, af), __builtin_bit_cast(bf16x8, uf), xo);
                    u32x2 o; o.x = pk2(xo[0], xo[1]); o.y = pk2(xo[2], xo[3]);
                    *(u32x2*)(XT + fr * TP + 16 * bq + 4 * fq) = o;
                }
            }
        }
        __syncthreads();
        {
            const size_t ib = (size_t)item * 16384;
            bf16_t* stg = (bf16_t*)(lds + L_VBT) + wid * (16 * STGP);
            {
                const bf16x8 b0 = *(const bf16x8*)(KDT + (16 * wid + fr) * TP + 8 * fq), b1 = *(const bf16x8*)(KDT + (16 * wid + fr) * TP + 32 + 8 * fq);
#pragma unroll
                for (int t = 0; t < 8; ++t) {
                    const bf16x8 a0 = *(const bf16x8*)(WT + (16 * t + fr) * TP + 8 * fq), a1 = *(const bf16x8*)(WT + (16 * t + fr) * TP + 32 + 8 * fq);
                    f32x4 acc = (f32x4){0.f, 0.f, 0.f, 0.f};
                    acc = mfma16(a0, b0, acc); acc = mfma16(a1, b1, acc);
                    u32x2 o; o.x = pk2(-acc[0], -acc[1]); o.y = pk2(-acc[2], -acc[3]);
                    *(u32x2*)(stg + fr * STGP + 16 * t + 4 * fq) = o;
                }
#pragma unroll
                for (int q = 0; q < 4; ++q) {
                    const int row = (lane >> 4) + 4 * q;
                    const u32x4 v = *(const u32x4*)(stg + row * STGP + (lane & 15) * 8);
                    *(u32x4*)(negM + ib + (size_t)(16 * wid + row) * 128 + (lane & 15) * 8) = v;
                }
            }
            {
                const bf16x8 b0 = *(const bf16x8*)(UT + (16 * wid + fr) * TP + 8 * fq), b1 = *(const bf16x8*)(UT + (16 * wid + fr) * TP + 32 + 8 * fq);
#pragma unroll
                for (int t = 0; t < 8; ++t) {
                    const bf16x8 a0 = *(const bf16x8*)(KDT + (16 * t + fr) * TP + 8 * fq), a1 = *(const bf16x8*)(KDT + (16 * t + fr) * TP + 32 + 8 * fq);
                    f32x4 acc = (f32x4){0.f, 0.f, 0.f, 0.f};
                    acc = mfma16(a0, b0, acc); acc = mfma16(a1, b1, acc);
                    u32x2 o; o.x = pk2(acc[0], acc[1]); o.y = pk2(acc[2], acc[3]);
                    *(u32x2*)(stg + fr * STGP + 16 * t + 4 * fq) = o;
                }
#pragma unroll
                for (int q = 0; q < 4; ++q) {
                    const int row = (lane >> 4) + 4 * q;
                    const u32x4 v = *(const u32x4*)(stg + row * STGP + (lane & 15) * 8);
                    *(u32x4*)(BmT + ib + (size_t)(16 * wid + row) * 128 + (lane & 15) * 8) = v;
                }
            }
            {
                const int it4 = wid & 3, hf = wid >> 2;
                const bf16x8 b0 = *(const bf16x8*)(AM + (16 * it4 + fr) * AP + 8 * fq), b1 = *(const bf16x8*)(AM + (16 * it4 + fr) * AP + 32 + 8 * fq);
#pragma unroll
                for (int tt = 0; tt < 4; ++tt) {
                    const int t = 4 * hf + tt;
                    const bf16x8 a0 = *(const bf16x8*)(WT + (16 * t + fr) * TP + 8 * fq), a1 = *(const bf16x8*)(WT + (16 * t + fr) * TP + 32 + 8 * fq);
                    f32x4 acc = (f32x4){0.f, 0.f, 0.f, 0.f};
                    acc = mfma16(a0, b0, acc); acc = mfma16(a1, b1, acc);
                    const u32x2 qg = *(const u32x2*)(QG + (16 * it4 + fr) * RP + 16 * t + 4 * fq);
                    u32x2 o; o.x = pk2(bflo(qg.x) - acc[0], bfhi(qg.x) - acc[1]); o.y = pk2(bflo(qg.y) - acc[2], bfhi(qg.y) - acc[3]);
                    *(u32x2*)(stg + fr * STGP + 16 * tt + 4 * fq) = o;
                }
#pragma unroll
                for (int q = 0; q < 2; ++q) {
                    const int row = (lane >> 3) + 8 * q;
                    const u32x4 v = *(const u32x4*)(stg + row * STGP + (lane & 7) * 8);
                    *(u32x4*)(Qp + (size_t)item * 8192 + (size_t)(16 * it4 + row) * 128 + 64 * hf + (lane & 7) * 8) = v;
                }
#pragma unroll
                for (int tt = 0; tt < 4; ++tt) {
                    const int t = 4 * hf + tt;
                    const bf16x8 a0 = *(const bf16x8*)(UT + (16 * t + fr) * TP + 8 * fq), a1 = *(const bf16x8*)(UT + (16 * t + fr) * TP + 32 + 8 * fq);
                    f32x4 acc = (f32x4){0.f, 0.f, 0.f, 0.f};
                    acc = mfma16(a0, b0, acc); acc = mfma16(a1, b1, acc);
                    u32x2 o; o.x = pk2(acc[0], acc[1]); o.y = pk2(acc[2], acc[3]);
                    *(u32x2*)(stg + fr * STGP + 16 * tt + 4 * fq) = o;
                }
#pragma unroll
                for (int q = 0; q < 2; ++q) {
                    const int row = (lane >> 3) + 8 * q;
                    const u32x4 v = *(const u32x4*)(stg + row * STGP + (lane & 7) * 8);
                    *(u32x4*)(Ol + (size_t)item * 8192 + (size_t)(16 * it4 + row) * 128 + 64 * hf + (lane & 7) * 8) = v;
                }
            }
        }
        __syncthreads();
        item = item_next;
    }
}
#undef DN1_PREFETCH

__device__ void dn2_phase(const Params& P, unsigned char* lds, int bid, int nblk) {
    const int tid = opaque_tid(), wid = tid >> 6, lane = tid & 63, fr = lane & 15, fq = lane >> 4;
    const bf16_t* negM = (const bf16_t*)(P.ws + WS_NEGM); const bf16_t* BmT = (const bf16_t*)P.out;
    const float* egl = (const float*)(P.ws + WS_EGL); bf16_t* SnT = (bf16_t*)(P.ws + WS_SNT);
    constexpr int SP = 136;
    bf16_t* ST = (bf16_t*)lds;
    for (int sid = bid; sid < 256; sid += nblk) {
        const int bh = sid >> 2, sl = sid & 3;
        f32x4 acc[2];
        acc[0] = (f32x4){0.f, 0.f, 0.f, 0.f}; acc[1] = (f32x4){0.f, 0.f, 0.f, 0.f};
        bf16x8 an[4]; u32x2 bmn[2]; float egn;
        {
            const size_t ib = ((size_t)bh * 32) * 16384;
#pragma unroll
            for (int ks = 0; ks < 4; ++ks) an[ks] = *(const bf16x8*)(negM + ib + (size_t)(16 * wid + fr) * 128 + 32 * ks + 8 * fq);
#pragma unroll
            for (int nn = 0; nn < 2; ++nn) bmn[nn] = *(const u32x2*)(BmT + ib + (size_t)(32 * sl + 16 * nn + fr) * 128 + 16 * wid + 4 * fq);
            egn = egl[bh * 32];
        }
        __syncthreads();
#pragma unroll
        for (int nn = 0; nn < 2; ++nn) *(u32x2*)(ST + (16 * nn + fr) * SP + 16 * wid + 4 * fq) = (u32x2){0u, 0u};
        __syncthreads();
        for (int n = 0; n < 32; ++n) {
            const bf16_t* cur = ST + (n & 1) * 32 * SP; bf16_t* nxt = ST + ((n & 1) ^ 1) * 32 * SP;
            const size_t ib = ((size_t)bh * 32 + n) * 16384;
            {
                const int col = tid >> 4, chn = tid & 15;
                *(u32x4*)(SnT + ib + (size_t)(32 * sl + col) * 128 + 8 * chn) = *(const u32x4*)(cur + col * SP + 8 * chn);
            }
            if (n == 31) break;
            bf16x8 a[4]; u32x2 bm[2];
#pragma unroll
            for (int ks = 0; ks < 4; ++ks) a[ks] = an[ks];
            bm[0] = bmn[0]; bm[1] = bmn[1];
            const float eg = egn;
            if (n + 1 < 31) {
                const size_t ib2 = ib + 16384;
#pragma unroll
                for (int ks = 0; ks < 4; ++ks) an[ks] = *(const bf16x8*)(negM + ib2 + (size_t)(16 * wid + fr) * 128 + 32 * ks + 8 * fq);
#pragma unroll
                for (int nn = 0; nn < 2; ++nn) bmn[nn] = *(const u32x2*)(BmT + ib2 + (size_t)(32 * sl + 16 * nn + fr) * 128 + 16 * wid + 4 * fq);
                egn = egl[bh * 32 + n + 1];
            }
#pragma unroll
            for (int nn = 0; nn < 2; ++nn) {
                acc[nn][0] = eg * acc[nn][0] + bflo(bm[nn].x); acc[nn][1] = eg * acc[nn][1] + bfhi(bm[nn].x);
                acc[nn][2] = eg * acc[nn][2] + bflo(bm[nn].y); acc[nn][3] = eg * acc[nn][3] + bfhi(bm[nn].y);
#pragma unroll
                for (int ks = 0; ks < 4; ++ks) {
                    const bf16x8 sb = *(const bf16x8*)(cur + (16 * nn + fr) * SP + 32 * ks + 8 * fq);
                    acc[nn] = mfma16(a[ks], sb, acc[nn]);
                }
                u32x2 o; o.x = pk2(acc[nn][0], acc[nn][1]); o.y = pk2(acc[nn][2], acc[nn][3]);
                *(u32x2*)(nxt + (16 * nn + fr) * SP + 16 * wid + 4 * fq) = o;
            }
            __syncthreads();
        }
    }
}

__device__ void dn3_phase(const Params& P, unsigned char* lds, int bid, int nblk) {
    const int tid = opaque_tid(), wid = tid >> 6, lane = tid & 63, fr = lane & 15, fq = lane >> 4;
    const bf16_t* SnT = (const bf16_t*)(P.ws + WS_SNT); const bf16_t* Qp = (const bf16_t*)(P.ws + WS_QP); const bf16_t* Ol = (const bf16_t*)(P.ws + WS_OL);
    const bf16_t* pb = (const bf16_t*)(P.ws + WS_PB); bf16_t* mix = (bf16_t*)(P.ws + WS_H);
    constexpr int SP3 = 136, SBUF = 128 * SP3 * 2;
    static_assert(4 * SBUF <= LDS_BYTES - 32, "dn3 staging");
    const int half = wid >> 2, q4 = wid & 3, th = tid & 255;
    struct Ops { u32x4 sv[8]; bf16x8 bq[4]; u32x2 olv[8], zv[8]; };
    auto loadOps = [&](int it2, Ops& o) {
        const int item = it2 * 2 + half;
        const int n = item & 31, bh = item >> 5, h = bh & 3, b = bh >> 2;
        const int i = 16 * q4 + fr;
        const bf16_t* sb = SnT + (size_t)item * 16384;
#pragma unroll
        for (int k = 0; k < 8; ++k) o.sv[k] = *(const u32x4*)(sb + (size_t)(th + 256 * k) * 8);
        const bf16_t* qrow = Qp + (size_t)item * 8192 + (size_t)i * 128;
#pragma unroll
        for (int ks = 0; ks < 4; ++ks) o.bq[ks] = *(const bf16x8*)(qrow + 32 * ks + 8 * fq);
        const bf16_t* olr = Ol + (size_t)item * 8192 + (size_t)i * 128;
        const size_t tok = (size_t)b * SEQ + n * 64 + i;
#pragma unroll
        for (int dt = 0; dt < 8; ++dt) { o.olv[dt] = *(const u32x2*)(olr + 16 * dt + 4 * fq); o.zv[dt] = *(const u32x2*)(pb + tok * PBW + 1536 + h * 128 + 16 * dt + 4 * fq); }
    };
    Ops cur;
    if (bid < 1024) loadOps(bid, cur);
    int par = 0;
    for (int it2 = bid; it2 < 1024; it2 += nblk, par ^= 1) {
        const int item = it2 * 2 + half;
        const int n = item & 31, bh = item >> 5, h = bh & 3, b = bh >> 2;
        const int i = 16 * q4 + fr;
        const size_t tok = (size_t)b * SEQ + n * 64 + i;
        unsigned char* SB = lds + (par * 2 + half) * SBUF;
#pragma unroll
        for (int k = 0; k < 8; ++k) { const int piece = th + 256 * k; *(u32x4*)(SB + (piece >> 4) * (SP3 * 2) + (piece & 15) * 16) = cur.sv[k]; }
        bf16x8 bq[4]; u32x2 olv[8], zv[8];
#pragma unroll
        for (int ks = 0; ks < 4; ++ks) bq[ks] = cur.bq[ks];
#pragma unroll
        for (int dt = 0; dt < 8; ++dt) { olv[dt] = cur.olv[dt]; zv[dt] = cur.zv[dt]; }
        __syncthreads();
        if (it2 + nblk < 1024) loadOps(it2 + nblk, cur);
        __builtin_amdgcn_sched_barrier(0);
        f32x4 acc[8];
#pragma unroll
        for (int dt = 0; dt < 8; ++dt) {
            acc[dt] = (f32x4){bflo(olv[dt].x), bfhi(olv[dt].x), bflo(olv[dt].y), bfhi(olv[dt].y)};
#pragma unroll
            for (int ks = 0; ks < 4; ++ks) { const bf16x8 a = *(const bf16x8*)(SB + (16 * dt + fr) * (SP3 * 2) + (32 * ks + 8 * fq) * 2); acc[dt] = mfma16(a, bq[ks], acc[dt]); }
        }
        float ss = 0.f;
#pragma unroll
        for (int dt = 0; dt < 8; ++dt) ss += acc[dt][0] * acc[dt][0] + acc[dt][1] * acc[dt][1] + acc[dt][2] * acc[dt][2] + acc[dt][3] * acc[dt][3];
        ss += __shfl_xor(ss, 16); ss += __shfl_xor(ss, 32);
        const float rstd = rsqrtf(ss * (1.0f / 128.0f) + EPS);
#pragma unroll
        for (int dt = 0; dt < 8; ++dt) {
            const int dv = 16 * dt + 4 * fq;
            const u32x2 z = zv[dt];
            const f32x4 gn = *(const f32x4*)(P.dn_out_gain + dv);
            u32x2 o;
            o.x = pk2(acc[dt][0] * rstd * gn[0] * silu_f(bflo(z.x)), acc[dt][1] * rstd * gn[1] * silu_f(bfhi(z.x)));
            o.y = pk2(acc[dt][2] * rstd * gn[2] * silu_f(bflo(z.y)), acc[dt][3] * rstd * gn[3] * silu_f(bfhi(z.y)));
            *(u32x2*)(mix + tok * DM + 512 + h * 128 + dv) = o;
        }
    }
}

__device__ __forceinline__ void sort16_desc(float (&v)[16]) {
#define CE_(A, B) { const float hi_ = fmaxf(v[A], v[B]), lo_ = fminf(v[A], v[B]); v[A] = hi_; v[B] = lo_; }
    CE_(0,13) CE_(1,12) CE_(2,15) CE_(3,14) CE_(4,8) CE_(5,6) CE_(7,11) CE_(9,10)
    CE_(0,5) CE_(1,7) CE_(2,9) CE_(3,4) CE_(6,13) CE_(8,14) CE_(10,15) CE_(11,12)
    CE_(0,1) CE_(2,3) CE_(4,5) CE_(6,8) CE_(7,9) CE_(10,11) CE_(12,13) CE_(14,15)
    CE_(0,2) CE_(1,3) CE_(4,10) CE_(5,11) CE_(6,7) CE_(8,9) CE_(12,14) CE_(13,15)
    CE_(1,2) CE_(3,12) CE_(4,6) CE_(5,7) CE_(8,10) CE_(9,11) CE_(13,14)
    CE_(1,4) CE_(2,6) CE_(5,8) CE_(7,10) CE_(9,13) CE_(11,14)
    CE_(2,4) CE_(3,6) CE_(9,12) CE_(11,13)
    CE_(3,5) CE_(6,8) CE_(7,9) CE_(10,12)
    CE_(3,4) CE_(5,6) CE_(7,8) CE_(9,10) CE_(11,12)
    CE_(6,7) CE_(8,9)
#undef CE_
}
__device__ __forceinline__ void merge_top16(float (&a)[16], const float (&b)[16]) {
#pragma unroll
    for (int i = 0; i < 16; ++i) a[i] = fmaxf(a[i], b[15 - i]);
#pragma unroll
    for (int j = 8; j > 0; j >>= 1) {
#pragma unroll
        for (int i = 0; i < 16; ++i) {
            const int l = i ^ j;
            if (l > i) { const float hi = fmaxf(a[i], a[l]), lo = fminf(a[i], a[l]); a[i] = hi; a[l] = lo; }
        }
    }
}
__device__ __forceinline__ unsigned lut16(unsigned long long lo, unsigned long long hi, unsigned idx) {
    const unsigned long long w = (idx & 8u) ? hi : lo;
    return (unsigned)(w >> ((idx & 7u) * 8u)) & 127u;
}

__device__ void route_phase(const Params& P, unsigned char* lds, int bid, int nblk) {
    const int tid = opaque_tid(), wid = tid >> 6, lane = tid & 63, l31 = lane & 31, hh = lane >> 5;
    const bf16_t* qry = (const bf16_t*)(P.ws + WS_PB); const bf16_t* skp = (const bf16_t*)(P.ws + WS_SK);
    {
#pragma unroll
        for (int i = 0; i < 8; ++i) {
            const int f = wid * 8 + i, p = f >> 5, kt = (f >> 3) & 3, ks = f & 7;
            const u32x4 v = *(const u32x4*)(skp + p * 16384 + (32 * kt + l31) * 128 + 16 * ks + 8 * hh);
            *(u32x4*)(lds + f * 1024 + lane * 16) = v;
        }
        __syncthreads();
    }
    for (int wi = bid * 8 + wid; wi < 1024 * 8; wi += nblk * 8) {
        const int tg = wi >> 3, hd = wi & 7;
        const int tok = tg * 32 + l31;
        const bf16_t* qrow = qry + (size_t)tok * 2048 + hd * 256;
        float top[2][16];
        float ssq = 0.f;
        bf16x8 bq[2][8];
#pragma unroll
        for (int p = 0; p < 2; ++p)
#pragma unroll
            for (int ks = 0; ks < 8; ++ks) {
                bq[p][ks] = *(const bf16x8*)(qrow + 128 * p + 16 * ks + 8 * hh);
                const u32x4 u = __builtin_bit_cast(u32x4, bq[p][ks]);
                ssq += bflo(u.x) * bflo(u.x) + bfhi(u.x) * bfhi(u.x) + bflo(u.y) * bflo(u.y) + bfhi(u.y) * bfhi(u.y) + bflo(u.z) * bflo(u.z) + bfhi(u.z) * bfhi(u.z) +
                       bflo(u.w) * bflo(u.w) + bfhi(u.w) * bfhi(u.w);
            }
        ssq += __shfl_xor(ssq, 32);
        const float rstd = rsqrtf(ssq * (1.0f / 256.0f) + EPS);
#pragma unroll
        for (int p = 0; p < 2; ++p) {
            float run[16];
#pragma unroll
            for (int kt = 0; kt < 4; ++kt) {
                __builtin_amdgcn_sched_barrier(0);
                f32x16 s;
#pragma unroll
                for (int r = 0; r < 16; ++r) s[r] = 0.f;
#pragma unroll
                for (int ks = 0; ks < 8; ++ks) { const bf16x8 a = *(const bf16x8*)(lds + ((p * 4 + kt) * 8 + ks) * 1024 + lane * 16); s = mfma32(a, bq[p][ks], s); }
                float cur[16];
#pragma unroll
                for (int r = 0; r < 16; ++r) {
                    const unsigned key = 32 * kt + (r & 3) + 8 * (r >> 2) + 4 * hh;
                    cur[r] = __uint_as_float((__float_as_uint(s[r] * rstd) & ~127u) | key);
                }
                sort16_desc(cur);
                if (kt == 0) {
#pragma unroll
                    for (int r = 0; r < 16; ++r) run[r] = cur[r];
                } else merge_top16(run, cur);
            }
            float oth[16];
#pragma unroll
            for (int r = 0; r < 16; ++r) oth[r] = __shfl_xor(run[r], 32);
            merge_top16(run, oth);
#pragma unroll
            for (int r = 0; r < 16; ++r) top[p][r] = run[r];
        }
        float v1[16], v2[16];
        unsigned long long p1lo = 0ull, p1hi = 0ull, p2lo = 0ull, p2hi = 0ull;
#pragma unroll
        for (int r = 0; r < 16; ++r) {
            const unsigned u1 = __float_as_uint(top[0][r]), u2 = __float_as_uint(top[1][r]);
            v1[r] = __uint_as_float(u1 & ~127u); v2[r] = __uint_as_float(u2 & ~127u);
            if (r < 8) { p1lo |= (unsigned long long)(u1 & 127u) << (8 * r); p2lo |= (unsigned long long)(u2 & 127u) << (8 * r); }
            else { p1hi |= (unsigned long long)(u1 & 127u) << (8 * (r - 8)); p2hi |= (unsigned long long)(u2 & 127u) << (8 * (r - 8)); }
        }
#define CAND(a, b) __uint_as_float((__float_as_uint(v1[a] + v2[b]) & ~255u) | (unsigned)((a) * 16 + (b)))
        const float NEG = -3.0e38f;
        float g0[16], g1[16], g2[16], g3[16];
#pragma unroll
        for (int r = 0; r < 16; ++r) g0[r] = CAND(0, r);
        g1[0] = CAND(1, 0); g1[1] = CAND(1, 1); g1[2] = CAND(1, 2); g1[3] = CAND(1, 3); g1[4] = CAND(1, 4); g1[5] = CAND(1, 5); g1[6] = CAND(1, 6); g1[7] = CAND(1, 7);
        g1[8] = CAND(2, 0); g1[9] = CAND(2, 1); g1[10] = CAND(2, 2); g1[11] = CAND(2, 3); g1[12] = CAND(2, 4); g1[13] = CAND(4, 0); g1[14] = CAND(4, 1); g1[15] = CAND(4, 2);
        g2[0] = CAND(3, 0); g2[1] = CAND(3, 1); g2[2] = CAND(3, 2); g2[3] = CAND(3, 3); g2[4] = CAND(5, 0); g2[5] = CAND(5, 1); g2[6] = CAND(6, 0); g2[7] = CAND(6, 1);
        g2[8] = CAND(7, 0); g2[9] = CAND(7, 1); g2[10] = CAND(8, 0); g2[11] = CAND(9, 0); g2[12] = CAND(10, 0); g2[13] = CAND(11, 0); g2[14] = CAND(12, 0); g2[15] = CAND(13, 0);
        g3[0] = CAND(14, 0); g3[1] = CAND(15, 0);
#pragma unroll
        for (int r = 2; r < 16; ++r) g3[r] = NEG;
#undef CAND
        sort16_desc(g1); sort16_desc(g2); sort16_desc(g3);
        merge_top16(g0, g1); merge_top16(g2, g3); merge_top16(g0, g2);
        float e[16], es = 0.f; int eid[16];
        const float m0 = __uint_as_float(__float_as_uint(g0[0]) & ~255u);
#pragma unroll
        for (int r = 0; r < 16; ++r) {
            const unsigned u = __float_as_uint(g0[r]);
            const float sv = __uint_as_float(u & ~255u);
            e[r] = __expf(sv - m0); es += e[r];
            const unsigned a = (u >> 4) & 15u, bb = u & 15u;
            eid[r] = (int)(lut16(p1lo, p1hi, a) * 128u + lut16(p2lo, p2hi, bb));
        }
        const float inv = 1.0f / es;
        if (hh == 0) {
            {
                bf16_t* i16 = (bf16_t*)(P.ws + WS_IDS16) + ((size_t)tok * 8 + hd) * 16;
                u32x4 a0, a1;
                a0.x = (unsigned)eid[0] | ((unsigned)eid[1] << 16); a0.y = (unsigned)eid[2] | ((unsigned)eid[3] << 16); a0.z = (unsigned)eid[4] | ((unsigned)eid[5] << 16); a0.w = (unsigned)eid[6] | ((unsigned)eid[7] << 16);
                a1.x = (unsigned)eid[8] | ((unsigned)eid[9] << 16); a1.y = (unsigned)eid[10] | ((unsigned)eid[11] << 16); a1.z = (unsigned)eid[12] | ((unsigned)eid[13] << 16); a1.w = (unsigned)eid[14] | ((unsigned)eid[15] << 16);
                *(u32x4*)i16 = a0; *(u32x4*)(i16 + 8) = a1;
                bf16_t* g16 = (bf16_t*)(P.ws + WS_GATES16) + ((size_t)tok * 8 + hd) * 16;
                u32x4 c0, c1;
                c0.x = pk2(e[0] * inv, e[1] * inv); c0.y = pk2(e[2] * inv, e[3] * inv); c0.z = pk2(e[4] * inv, e[5] * inv); c0.w = pk2(e[6] * inv, e[7] * inv);
                c1.x = pk2(e[8] * inv, e[9] * inv); c1.y = pk2(e[10] * inv, e[11] * inv); c1.z = pk2(e[12] * inv, e[13] * inv); c1.w = pk2(e[14] * inv, e[15] * inv);
                *(u32x4*)g16 = c0; *(u32x4*)(g16 + 8) = c1;
            }
        }
    }
}


#define XL_RANK(j) (3520 + 64 * (j))
struct XLabel { int NL, x, j, nloc; };
__device__ __forceinline__ XLabel xcd_label(const Params& P, const unsigned char* lds, int bid, int nblk) {
    XLabel L;
    L.NL = nblk < 8 ? nblk : 8; L.x = bid % L.NL; L.j = bid / L.NL; L.nloc = (nblk - L.x + L.NL - 1) / L.NL;
    const volatile unsigned* st = (const volatile unsigned*)(lds + LDS_BYTES - 16);
    const unsigned myx = st[2], myr = st[3];
    unsigned* bar = (unsigned*)P.ws;
    unsigned sum = 0u, mine = 0u; bool ok = true;
#pragma unroll
    for (unsigned k = 0; k < 8; ++k) { const unsigned c = __hip_atomic_load(&bar[256 + 64 * k], __ATOMIC_RELAXED, __HIP_MEMORY_SCOPE_AGENT); sum += c; ok = ok && (c > 0u); mine = (k == myx) ? c : mine; }
    if (ok && sum == (unsigned)nblk && myx < 8u && myr < mine) { L.NL = 8; L.x = (int)myx; L.j = (int)myr; L.nloc = (int)mine; }
    L.NL = __builtin_amdgcn_readfirstlane(L.NL); L.x = __builtin_amdgcn_readfirstlane(L.x); L.j = __builtin_amdgcn_readfirstlane(L.j); L.nloc = __builtin_amdgcn_readfirstlane(L.nloc);
    return L;
}

typedef int i32x2 __attribute__((ext_vector_type(2)));
typedef _Float16 f16x2h __attribute__((ext_vector_type(2)));
struct DnIds { u32x4 i0, i1; };
constexpr int DTB = 32;
constexpr int DR_IDS = 0, DR_H = 8192, DN_REGION = 12288;
static_assert(8 * DN_REGION <= LDS_BYTES - 32, "down-pass staging regions");
__device__ void peer_down_phase(const Params& P, unsigned char* lds, int bid, int nblk) {
    const int tid0 = opaque_tid(), wid = __builtin_amdgcn_readfirstlane(tid0 >> 6);
    int lane_v = tid0 & 63;
    const signed char* ed8 = (const signed char*)(P.ws + WS_ED8); const signed char* h8 = (const signed char*)(P.ws + WS_H8);
    const bf16_t* ids16 = (const bf16_t*)(P.ws + WS_IDS16); int* part = (int*)(P.ws + WS_PART);
    const XLabel XL = xcd_label(P, lds, bid, nblk);
    const int NL = XL.NL, x = XL.x, j = XL.j, nloc = XL.nloc;
    const int nw = nloc * 8, widx = j * 8 + wid;
    const int per = (((NTOK + nw - 1) / nw) + DTB - 1) / DTB * DTB;
    const int t0 = widx * per, t1 = (t0 + per) < NTOK ? (t0 + per) : NTOK;
    if (t0 >= t1) return;
    unsigned char* R = lds + wid * DN_REGION;
    for (int s = x; s < 8; s += NL) {
        asm volatile("" : "+v"(lane_v));
        const int lane = lane_v, e = lane >> 3, ch = lane & 7;
        const bool c0 = (lane & 1) != 0, c1 = (lane & 2) != 0, c2 = (lane & 4) != 0;
        auto issueH = [&](u32x4 (&S)[8], const DnIds& c, const int hf) {
            const signed char* base = ed8 + (size_t)s * NEXP * 128 + 16 * ch;
#pragma unroll
            for (int b = 0; b < 8; ++b) {
                const unsigned word = hf ? c.i1[b >> 1] : c.i0[b >> 1];
                const unsigned id = (b & 1) ? (word >> 16) : (word & 0xffffu);
                S[b] = *(const u32x4*)(base + (size_t)id * 128);
            }
        };
        auto computeH = [&](const u32x4 (&S)[8], const u32x4& h, int (&d)[16], const int hf) {
#pragma unroll
            for (int b = 0; b < 8; ++b) {
                int t = 0;
                t = __builtin_amdgcn_sdot4((int)S[b].x, (int)h.x, t, false); t = __builtin_amdgcn_sdot4((int)S[b].y, (int)h.y, t, false);
                t = __builtin_amdgcn_sdot4((int)S[b].z, (int)h.z, t, false); t = __builtin_amdgcn_sdot4((int)S[b].w, (int)h.w, t, false);
                const int bb = 8 * hf + b;
                d[(bb >> 1) + 8 * (bb & 1)] = t;
            }
        };
        int nbn = DTB - 4 * wid;
        for (int blk = t0, nb; blk < t1; blk += nb, nbn = DTB) {
            nb = nbn;
            nb = (t1 - blk) < nb ? (t1 - blk) : nb;
            {
                u32x4 st[12];
                const char* gi = (const char*)ids16 + (size_t)blk * 256 + lane * 16;
#pragma unroll
                for (int k = 0; k < 8; ++k) st[k] = *(const u32x4*)(gi + k * 1024);
                const char* gh = (const char*)h8 + ((size_t)(blk + (lane >> 3)) * DM + 128 * s) + (lane & 7) * 16;
#pragma unroll
                for (int k = 0; k < 4; ++k) st[8 + k] = *(const u32x4*)(gh + (size_t)k * 8 * DM);
                unsigned char* Rl = R + lane * 16;
#pragma unroll
                for (int k = 0; k < 8; ++k) *(u32x4*)(Rl + DR_IDS + k * 1024) = st[k];
#pragma unroll
                for (int k = 0; k < 4; ++k) *(u32x4*)(Rl + DR_H + k * 1024) = st[8 + k];
            }
            auto ldsIds = [&](int tt) -> DnIds { const u32x4* p = (const u32x4*)(R + DR_IDS + tt * 256 + 32 * e); DnIds c; c.i0 = p[0]; c.i1 = p[1]; return c; };
            u32x4 HA[8], HB[8];
            {
                const DnIds ic = ldsIds(0);
                issueH(HA, ic, 0); __builtin_amdgcn_sched_barrier(0); issueH(HB, ic, 1);
                __builtin_amdgcn_sched_barrier(0);
            }
            auto iter = [&](const int tt, auto moreTag) {
                constexpr bool more = decltype(moreTag)::value;
                const DnIds inx = ldsIds(more ? tt + 1 : tt);
                const u32x4 hreg = *(const u32x4*)(R + DR_H + tt * 128 + 16 * ch);
                int d[16];
                computeH(HA, hreg, d, 0); __builtin_amdgcn_sched_barrier(0); if constexpr (more) issueH(HA, inx, 0); __builtin_amdgcn_sched_barrier(0);
                computeH(HB, hreg, d, 1); __builtin_amdgcn_sched_barrier(0); if constexpr (more) issueH(HB, inx, 1); __builtin_amdgcn_sched_barrier(0);
                int e8[8], f4[4], g2[2];
#pragma unroll
                for (int q = 0; q < 8; ++q) { const int keep = c0 ? d[2 * q + 1] : d[2 * q], send = c0 ? d[2 * q] : d[2 * q + 1]; e8[q] = keep + __shfl_xor(send, 1); }
#pragma unroll
                for (int q = 0; q < 4; ++q) { const int keep = c1 ? e8[2 * q + 1] : e8[2 * q], send = c1 ? e8[2 * q] : e8[2 * q + 1]; f4[q] = keep + __shfl_xor(send, 2); }
#pragma unroll
                for (int q = 0; q < 2; ++q) { const int keep = c2 ? f4[2 * q + 1] : f4[2 * q], send = c2 ? f4[2 * q] : f4[2 * q + 1]; g2[q] = keep + __shfl_xor(send, 4); }
                const auto pk = __builtin_amdgcn_cvt_pkrtz((float)g2[0] * 0.015625f, (float)g2[1] * 0.015625f);
                *(unsigned*)(part + ((size_t)s * NTOK + (size_t)(blk + tt)) * 64 + 8 * e + ch) = __builtin_bit_cast(unsigned, pk);
            };
            for (int tt = 0; tt + 1 < nb; ++tt) iter(tt, std::true_type{});
            iter(nb - 1, std::false_type{});
        }
    }
}

__device__ __forceinline__ float gelu_erf(float v) {
    const float av = fabsf(v), t = __builtin_amdgcn_rcpf(av * 0.2316418882f + 1.0f);
    float q = t * 0.5307027145f + (-0.7265760135f); q = q * t + 0.7107068705f; q = q * t + (-0.142248368f); q = q * t + 0.127414796f; q = q * t;
    const float ex = __builtin_amdgcn_exp2f(v * v * (-0.72134752044f));
    const float m = v * (q * ex);
    return v < 0.f ? m : v - m;
}
__device__ void peer_combine_phase(const Params& P, unsigned char* lds, int bid, int nblk) {
    const int tid = opaque_tid(), wid = tid >> 6, lane = tid & 63;
    const int* part = (const int*)(P.ws + WS_PART);
    const float* SD = (const float*)(P.ws + WS_SD); const float* SU = (const float*)(P.ws + WS_SU); const float* HS = (const float*)(P.ws + WS_HS);
    const unsigned* ids16 = (const unsigned*)(P.ws + WS_IDS16); const unsigned* gates16 = (const unsigned*)(P.ws + WS_GATES16);
    unsigned short* wq = (unsigned short*)(P.ws + WS_WQ8); float* wsc = (float*)(P.ws + WS_WSC);
    static_assert(2 * NEXP * 4 <= LDS_BYTES - 32, "combine tables");
    float* sdL = (float*)lds; float* suL = sdL + NEXP;
    {
#pragma unroll
        for (int k = 0; k < 8; ++k) { const int o = (tid + 512 * k) * 4; *(f32x4*)(sdL + o) = *(const f32x4*)(SD + o); *(f32x4*)(suL + o) = *(const f32x4*)(SU + o); }
        __syncthreads();
    }
    constexpr int CU_ = 8;
    const int tstep = nblk * 8;
    for (int tok0 = bid * 8 + wid; tok0 < NTOK; tok0 += CU_ * tstep) {
        unsigned pv[CU_][8]; unsigned idp[CU_], gtp[CU_]; float hs[CU_]; int tk[CU_];
#pragma unroll
        for (int u = 0; u < CU_; ++u) {
            const int t = tok0 + u * tstep; tk[u] = t < NTOK ? t : tok0;
#pragma unroll
            for (int s = 0; s < 8; ++s) pv[u][s] = *(const unsigned*)(part + ((size_t)s * NTOK + tk[u]) * 64 + lane);
            idp[u] = ids16[(size_t)tk[u] * 64 + lane]; gtp[u] = gates16[(size_t)tk[u] * 64 + lane]; hs[u] = HS[tk[u]];
        }
        __builtin_amdgcn_sched_barrier(0);
        float sd0[CU_], sd1[CU_], su0[CU_], su1[CU_];
#pragma unroll
        for (int u = 0; u < CU_; ++u) { const unsigned id0 = idp[u] & 0xffffu, id1 = idp[u] >> 16; sd0[u] = sdL[id0]; sd1[u] = sdL[id1]; su0[u] = suL[id0]; su1[u] = suL[id1]; }
        __builtin_amdgcn_sched_barrier(0);
#pragma unroll
        for (int u = 0; u < CU_; ++u) {
            float a0 = 0.f, a1 = 0.f;
#pragma unroll
            for (int s = 0; s < 8; ++s) { const f16x2h hv = __builtin_bit_cast(f16x2h, pv[u][s]); a0 += (float)hv[0]; a1 += (float)hv[1]; }
            const float f0 = a0 * 64.0f * sd0[u] * hs[u], f1 = a1 * 64.0f * sd1[u] * hs[u];
            const float w0 = bflo(gtp[u]) * gelu_erf(f0) * su0[u], w1 = bfhi(gtp[u]) * gelu_erf(f1) * su1[u];
            float am = fmaxf(fabsf(w0), fabsf(w1));
            am = fmaxf(am, __shfl_xor(am, 1)); am = fmaxf(am, __shfl_xor(am, 2)); am = fmaxf(am, __shfl_xor(am, 4)); am = fmaxf(am, __shfl_xor(am, 16)); am = fmaxf(am, __shfl_xor(am, 32));
            am = am > 0.f ? am : 1.0f;
            const float inv = 127.0f / am;
            const int q0 = (int)rintf(w0 * inv), q1 = (int)rintf(w1 * inv);
            wq[(size_t)tk[u] * 64 + lane] = (unsigned short)((unsigned)(q0 & 255) | ((unsigned)(q1 & 255) << 8));
            if ((lane & 0x37) == 0) wsc[(size_t)tk[u] * 2 + (lane >> 3)] = am * (1.0f / 127.0f);
        }
    }
}

typedef float f32x2 __attribute__((ext_vector_type(2)));
typedef int i32x4 __attribute__((ext_vector_type(4)));
struct UpIds { u32x4 i0, i1; };
constexpr int UTB = 16;
constexpr int UR_IDS = 0, UR_WQ = 4096, UR_X = 6144, UR_DL = 14336, UR_SC = 18432, UP_REGION = 18560;
static_assert(8 * UP_REGION <= LDS_BYTES - 32, "up-pass staging regions");
__device__ void peer_up_phase(const Params& P, unsigned char* lds, int bid, int nblk) {
    const int tid0 = opaque_tid(), wid = __builtin_amdgcn_readfirstlane(tid0 >> 6);
    int lane_v = tid0 & 63;
    const signed char* eu8 = (const signed char*)(P.ws + WS_EU8);
    const bf16_t* dlt = (const bf16_t*)(P.ws + WS_DLT);
    const bf16_t* ids16 = (const bf16_t*)(P.ws + WS_IDS16); const signed char* wq8 = (const signed char*)(P.ws + WS_WQ8); const float* wsc = (const float*)(P.ws + WS_WSC);
    const float* mod = (const float*)(P.ws + WS_MOD);
    const XLabel XL = xcd_label(P, lds, bid, nblk);
    const int NL = XL.NL, x = XL.x, j = XL.j, nloc = XL.nloc;
    const int nw = nloc * 8, widx = j * 8 + wid;
    const int per = (((NTOK + nw - 1) / nw) + UTB - 1) / UTB * UTB;
    const int t0 = widx * per, t1 = (t0 + per) < NTOK ? (t0 + per) : NTOK;
    if (t0 >= t1) return;
    unsigned char* R = lds + wid * UP_REGION;
    for (int s = x; s < 8; s += NL) {
        asm volatile("" : "+v"(lane_v));
        const int lane = lane_v, e = lane >> 3, ch = lane & 7;
        const bool hi = (lane & 8) != 0;
        const int colp = 16 * ch + 4 * (lane >> 4) + (hi ? 2 : 0), col = 128 * s + colp;
        unsigned mk[4];
#pragma unroll
        for (int r = 0; r < 4; ++r) mk[r] = (((lane & 15) >> 2) == r) ? (0xFFu << (8 * (lane & 3))) : 0u;
        auto issueH = [&](u32x4 (&S)[8], const UpIds& c, const int hf) {
            const signed char* base = eu8 + (size_t)s * NEXP * 128 + 16 * ch;
#pragma unroll
            for (int b = 0; b < 8; ++b) {
                const unsigned word = hf ? c.i1[b >> 1] : c.i0[b >> 1];
                const unsigned id = (b & 1) ? (word >> 16) : (word & 0xffffu);
                S[b] = *(const u32x4*)(base + (size_t)id * 128);
            }
        };
        auto computeH = [&](const u32x4 (&S)[8], const u32x4& wa, const u32x4& wb, i32x4& acc0, i32x4& acc1, const int hf) {
#pragma unroll
            for (int b = 0; b < 8; ++b) {
                const int bb = 8 * hf + b;
                const unsigned sel = 0x01010101u * (unsigned)(bb & 3);
                const unsigned r0 = __builtin_amdgcn_perm(wa[bb >> 2], wa[bb >> 2], sel), r1 = __builtin_amdgcn_perm(wb[bb >> 2], wb[bb >> 2], sel);
                const i32x4 A0 = {(int)(r0 & mk[0]), (int)(r0 & mk[1]), (int)(r0 & mk[2]), (int)(r0 & mk[3])};
                const i32x4 A1 = {(int)(r1 & mk[0]), (int)(r1 & mk[1]), (int)(r1 & mk[2]), (int)(r1 & mk[3])};
                const i32x4 Bv = {(int)S[b].x, (int)S[b].y, (int)S[b].z, (int)S[b].w};
                acc0 = __builtin_amdgcn_mfma_i32_16x16x64_i8(A0, Bv, acc0, 0, 0, 0);
                acc1 = __builtin_amdgcn_mfma_i32_16x16x64_i8(A1, Bv, acc1, 0, 0, 0);
            }
        };
        int nbn = UTB - 2 * wid;
        for (int blk = t0, nb; blk < t1; blk += nb, nbn = UTB) {
            nb = nbn;
            nb = (t1 - blk) < nb ? (t1 - blk) : nb;
            nb = (2048 - (blk & 2047)) < nb ? (2048 - (blk & 2047)) : nb;
            {
                u32x4 st[18];
                const u32x4 stsc = *(const u32x4*)((const char*)wsc + (size_t)blk * 8 + (lane & 7) * 16);
                const char* gi = (const char*)ids16 + (size_t)blk * 256 + lane * 16;
#pragma unroll
                for (int k = 0; k < 4; ++k) st[k] = *(const u32x4*)(gi + k * 1024);
                const char* gw = (const char*)wq8 + (size_t)blk * 128 + lane * 16;
#pragma unroll
                for (int k = 0; k < 2; ++k) st[4 + k] = *(const u32x4*)(gw + k * 1024);
                const char* gx = (const char*)P.x + (size_t)(128 * s) * 4 + (lane & 31) * 16;
#pragma unroll
                for (int k = 0; k < 8; ++k) { int tx = blk + 2 * k + (lane >> 5); tx = tx < NTOK ? tx : NTOK - 1; st[6 + k] = *(const u32x4*)(gx + (size_t)tx * DM * 4); }
                const char* gd = (const char*)dlt + ((size_t)(blk + (lane >> 4)) * DM + 128 * s) * 2 + (lane & 15) * 16;
#pragma unroll
                for (int k = 0; k < 4; ++k) st[14 + k] = *(const u32x4*)(gd + (size_t)k * 4 * DM * 2);
                unsigned char* Rl = R + lane * 16;
#pragma unroll
                for (int k = 0; k < 4; ++k) *(u32x4*)(Rl + UR_IDS + k * 1024) = st[k];
#pragma unroll
                for (int k = 0; k < 2; ++k) *(u32x4*)(Rl + UR_WQ + k * 1024) = st[4 + k];
#pragma unroll
                for (int k = 0; k < 8; ++k) *(u32x4*)(Rl + UR_X + k * 1024) = st[6 + k];
#pragma unroll
                for (int k = 0; k < 4; ++k) *(u32x4*)(Rl + UR_DL + k * 1024) = st[14 + k];
                if (lane < 8) *(u32x4*)(Rl + UR_SC) = stsc;
            }
            const f32x2 g2 = *(const f32x2*)(mod + (blk >> 11) * 6144 + 5120 + col);
            auto ldsIds = [&](int tt) -> UpIds { const u32x4* p = (const u32x4*)(R + UR_IDS + tt * 256 + 32 * e); UpIds c; c.i0 = p[0]; c.i1 = p[1]; return c; };
            u32x4 HA[8], HB[8];
            {
                const UpIds ic = ldsIds(0);
                issueH(HA, ic, 0); __builtin_amdgcn_sched_barrier(0); issueH(HB, ic, 1);
                __builtin_amdgcn_sched_barrier(0);
            }
            auto iter = [&](const int tt, auto moreTag) {
                constexpr bool more = decltype(moreTag)::value;
                const UpIds inx = ldsIds(more ? tt + 1 : tt);
                const u32x4* wp = (const u32x4*)(R + UR_WQ + tt * 128 + 32 * (lane >> 4));
                const u32x4 w0 = wp[0], w1 = wp[1];
                const f32x2 xv = *(const f32x2*)(R + UR_X + tt * 512 + 4 * colp); const unsigned dv = *(const unsigned*)(R + UR_DL + tt * 256 + 2 * colp);
                const float scl = *(const float*)(R + UR_SC + tt * 8 + (hi ? 4 : 0));
                i32x4 acc0 = {0, 0, 0, 0}, acc1 = {0, 0, 0, 0};
                computeH(HA, w0, w1, acc0, acc1, 0); __builtin_amdgcn_sched_barrier(0); if constexpr (more) issueH(HA, inx, 0); __builtin_amdgcn_sched_barrier(0);
                computeH(HB, w0, w1, acc0, acc1, 1); __builtin_amdgcn_sched_barrier(0); if constexpr (more) issueH(HB, inx, 1); __builtin_amdgcn_sched_barrier(0);
                {
                    float v[4];
#pragma unroll
                    for (int r = 0; r < 4; ++r) v[r] = (float)(hi ? acc1[r] : acc0[r]) * scl;
                    const float k0 = hi ? v[2] : v[0], k1 = hi ? v[3] : v[1], s0 = hi ? v[0] : v[2], s1 = hi ? v[1] : v[3];
                    const float y0 = k0 + __shfl_xor(s0, 8), y1 = k1 + __shfl_xor(s1, 8);
                    f32x2 o; o[0] = xv[0] + bflo(dv) + g2[0] * y0; o[1] = xv[1] + bfhi(dv) + g2[1] * y1;
                    *(f32x2*)(P.out + (size_t)(blk + tt) * DM + col) = o;
                }
            };
            for (int tt = 0; tt + 1 < nb; ++tt) iter(tt, std::true_type{});
            iter(nb - 1, std::false_type{});
        }
    }
}

#define XB_TMO      128
#define XB_XCNT(j)  (256  + 64 * (j))
#define XB_XSUB(j)  (1280 + 64 * (j))
#define XB_XGEN(j)  (2304 + 64 * (j))
#define XB_TOP      3328
#define XB_TOPGEN   3392
#define XCD_BAR_WORDS 3456
#define XB_SPIN_CAP (1u << 23)
__device__ __forceinline__ unsigned xb_ld(unsigned* p)              { return __hip_atomic_load(p, __ATOMIC_RELAXED, __HIP_MEMORY_SCOPE_AGENT); }
__device__ __forceinline__ unsigned xb_add(unsigned* p, unsigned v) { return __hip_atomic_fetch_add(p, v, __ATOMIC_RELAXED, __HIP_MEMORY_SCOPE_AGENT); }
__device__ __forceinline__ unsigned xb_xcc_id() { return (unsigned)__builtin_amdgcn_s_getreg((3 << 11) | 20) & 0xFu; }
#define XB_SPIN(cond, bar) do { unsigned _sp = 0; while (cond) { __builtin_amdgcn_s_sleep(1); \
    if ((++_sp & 255u) == 0u) { if (xb_ld(&(bar)[XB_TMO])) break; if (_sp > XB_SPIN_CAP) { atomicAdd(&(bar)[XB_TMO], 1u); break; } } } } while (0)
struct XcdBarrier { unsigned* bar; unsigned x; volatile unsigned* st; };
__device__ __forceinline__ XcdBarrier xcd_barrier_post(unsigned* bar, volatile unsigned* st) {
    XcdBarrier b; b.bar = bar; b.x = xb_xcc_id(); b.st = st;
    if (threadIdx.x == 0) (void)xb_add(&bar[XB_XCNT(b.x)], 1u);
    return b;
}
__device__ __forceinline__ void xcd_barrier_complete(unsigned* bar, unsigned x, unsigned& nloc, unsigned& nx) {
    const unsigned G = gridDim.x * gridDim.y * gridDim.z;
    unsigned sum, cnt, mine, sp = 0u;
    for (;;) {
        sum = 0u; cnt = 0u; mine = 0u;
#pragma unroll
        for (unsigned j = 0; j < 16; ++j) { const unsigned c = xb_ld(&bar[XB_XCNT(j)]); sum += c; cnt += (c > 0u) ? 1u : 0u; mine = (j == x) ? c : mine; }
        if (sum == G) break;
        __builtin_amdgcn_s_sleep(1);
        if ((++sp & 255u) == 0u) { if (xb_ld(&bar[XB_TMO])) break; if (sp > XB_SPIN_CAP) { atomicAdd(&bar[XB_TMO], 1u); break; } }
    }
    nloc = mine > 0u ? mine : 1u; nx = cnt > 0u ? cnt : 1u;
}
__device__ __forceinline__ void xcd_barrier(const XcdBarrier& b) {
    asm volatile("s_waitcnt vmcnt(0)" ::: "memory");
    __syncthreads();
    if (threadIdx.x == 0) {
        unsigned* bar = b.bar;
        __builtin_amdgcn_s_waitcnt(0);
        unsigned nloc = b.st[0], nx = b.st[1];
        if (nloc == 0u) { xcd_barrier_complete(bar, b.x, nloc, nx); b.st[0] = nloc; b.st[1] = nx; }
        const unsigned old = xb_add(&bar[XB_XSUB(b.x)], 1u);
        const unsigned gen = old / nloc;
        if (old + 1u == (gen + 1u) * nloc) {
            __builtin_amdgcn_fence(__ATOMIC_RELEASE, "agent");
            asm volatile("s_waitcnt vmcnt(0)" ::: "memory");
            const unsigned og = xb_add(&bar[XB_TOP], 1u);
            const unsigned tg = og / nx;
            if (og + 1u == (tg + 1u) * nx) xb_add(&bar[XB_TOPGEN], 1u);
            else XB_SPIN(xb_ld(&bar[XB_TOPGEN]) == tg, bar);
            __builtin_amdgcn_fence(__ATOMIC_ACQUIRE, "agent");
            xb_add(&bar[XB_XGEN(b.x)], 1u);
            asm volatile("s_waitcnt vmcnt(0)" ::: "memory");
        } else {
            XB_SPIN(xb_ld(&bar[XB_XGEN(b.x)]) == gen, bar);
            __builtin_amdgcn_fence(__ATOMIC_ACQUIRE, "agent");
            asm volatile("s_waitcnt vmcnt(0)" ::: "memory");
        }
    }
    __syncthreads();
}

constexpr int NPHASES = 11;
__device__ __forceinline__ void run_phase(const Params& P, int ph, unsigned char* lds, int bid, int nblk) {
    const float* mod = (const float*)(P.ws + WS_MOD);
    switch (ph) {
        case 0: phase0(P, lds, bid, nblk); break;
        case 1: norm_mod_phase<true, false>(P, P.x, nullptr, nullptr, P.norm1_gain, mod, 0, 1024, (bf16_t*)(P.ws + WS_H), bid, nblk); break;
        case 2: {
            const bf16_t* h1 = (const bf16_t*)(P.ws + WS_H); const bf16_t* wt = (const bf16_t*)(P.ws + WS_WINT);
            EpiInAll e{EpiQK{P.q_gain, P.k_gain, (bf16_t*)(P.ws + WS_QA), (bf16_t*)(P.ws + WS_KA)}, EpiV{(bf16_t*)(P.ws + WS_VT)}, EpiBf{(bf16_t*)(P.ws + WS_PB), PBW}};
            gemm_run(h1, wt, NTOK, 3584, DM, e, lds, bid, nblk);
        } break;
        case 3: attn_phase(P, lds, bid, nblk); __syncthreads(); dn1_phase(P, lds, bid, nblk); break;
        case 4: dn2_phase(P, lds, bid, nblk); break;
        case 5: dn3_phase(P, lds, bid, nblk); break;
        case 6: {
            EpiOut e{mod, (bf16_t*)(P.ws + WS_DLT)};
            gemm_run((const bf16_t*)(P.ws + WS_H), (const bf16_t*)(P.ws + WS_WOUTT), NTOK, DM, DM, e, lds, bid, nblk);
        } break;
        case 7: norm_mod_phase<false, true>(P, P.x, (const bf16_t*)(P.ws + WS_DLT), P.out, P.norm2_gain, mod, 3072, 4096, (bf16_t*)(P.ws + WS_H), bid, nblk); break;
        case 8: {
            EpiBf e{(bf16_t*)(P.ws + WS_PB), 2048};
            gemm_run((const bf16_t*)(P.ws + WS_H), (const bf16_t*)(P.ws + WS_WQT), NTOK, 2048, DM, e, lds, bid, nblk);
        } break;
        case 9: route_phase(P, lds, bid, nblk); break;
        case 10: peer_down_phase(P, lds, bid, nblk); break;
        case 12: peer_combine_phase(P, lds, bid, nblk); break;
        case 11: peer_up_phase(P, lds, bid, nblk); break;
        default: break;
    }
}

#if MULTI_LAUNCH
template <int PH>
__global__ void __launch_bounds__(NTHREADS) k_phase(Params P) {
    __shared__ __attribute__((aligned(16))) unsigned char lds[LDS_BYTES];
    run_phase(P, PH, lds, blockIdx.x, gridDim.x);
}
#else
__global__ void __launch_bounds__(NTHREADS) k_mega(Params P) {
    __shared__ __attribute__((aligned(16))) unsigned char lds[LDS_BYTES];
    cg::grid_group grid = cg::this_grid();
    const int bid = blockIdx.x, nblk = gridDim.x;
    volatile unsigned* st = (volatile unsigned*)(lds + LDS_BYTES - 16);
    if (threadIdx.x == 0) {
        st[0] = 0u; st[1] = 0u;
        const unsigned xcc = xb_xcc_id();
        st[2] = xcc; st[3] = __hip_atomic_fetch_add((unsigned*)P.ws + XL_RANK(xcc & 7u), 1u, __ATOMIC_RELAXED, __HIP_MEMORY_SCOPE_AGENT);
    }
    __syncthreads();
    const XcdBarrier xb = xcd_barrier_post((unsigned*)P.ws, st);
#define PH_(N) run_phase(P, N, lds, bid, nblk)
#define XBAR() xcd_barrier(xb)
    if (P.ws == nullptr) grid.sync();
    PH_(0); XBAR(); PH_(1); XBAR(); PH_(2); XBAR(); PH_(3); XBAR(); PH_(4); XBAR(); PH_(5); XBAR();
    PH_(6); XBAR(); PH_(7); XBAR(); PH_(8); XBAR(); PH_(9); XBAR(); PH_(10); XBAR(); PH_(12); XBAR(); PH_(11);
#undef PH_
#undef XBAR
}
#endif

extern "C" void kernel_launch(void* const* d_in, const int* in_sizes, int n_in, void* d_out, int out_size, void* d_ws, size_t ws_size, hipStream_t stream) {
    static int grid = 0;
    if (grid == 0) {
        if (n_in != 22 || out_size != NTOK * DM || ws_size < WS_END) { fprintf(stderr, "kernel_launch: unexpected shapes (n_in %d out %d ws %zu)\n", n_in, out_size, ws_size); grid = -1; return; }
        int dev = 0, cus = 0, per_cu = 0;
        (void)hipGetDevice(&dev);
        (void)hipDeviceGetAttribute(&cus, hipDeviceAttributeMultiprocessorCount, dev);
#if MULTI_LAUNCH
        (void)hipOccupancyMaxActiveBlocksPerMultiprocessor(&per_cu, k_phase<3>, NTHREADS, 0);
#else
        (void)hipOccupancyMaxActiveBlocksPerMultiprocessor(&per_cu, k_mega, NTHREADS, 0);
#endif
        if (per_cu < 1) { fprintf(stderr, "kernel_launch: occupancy query says %d blocks per CU\n", per_cu); per_cu = 1; }
        grid = cus;
        (void)hipGetLastError();
    }
    if (grid < 0) return;
    Params p{};
    const float** pp = (const float**)&p;
    for (int i = 0; i < 22; ++i) pp[i] = (const float*)d_in[i];
    p.out = (float*)d_out; p.ws = (unsigned char*)d_ws;
#if MULTI_LAUNCH
    (void)hipMemsetAsync(d_ws, 0, 16384, stream);
#define LP_(PH) hipLaunchKernelGGL(k_phase<PH>, dim3(grid), dim3(NTHREADS), 0, stream, p)
    LP_(0); LP_(1); LP_(2); LP_(3); LP_(4); LP_(5); LP_(6); LP_(7); LP_(8); LP_(9); LP_(10); LP_(12); LP_(11);
#undef LP_
#else
    (void)hipMemsetAsync(d_ws, 0, 16384, stream);
    void* args[] = {&p};
    hipError_t e = hipLaunchCooperativeKernel((void*)k_mega, dim3(grid), dim3(NTHREADS), args, 0, stream);
    if (e != hipSuccess) fprintf(stderr, "cooperative launch failed: %s (grid %d)\n", hipGetErrorString(e), grid);
#endif
}
```

```cpp
#include <hip/hip_runtime.h>
#include <hip/hip_cooperative_groups.h>
#include <cstdio>
#include <cstdint>
#include <type_traits>
namespace cg = cooperative_groups;

#ifndef MULTI_LAUNCH
#define MULTI_LAUNCH 0
#endif

typedef unsigned short bf16_t;
typedef short bf16x8 __attribute__((ext_vector_type(8)));
typedef float f32x4 __attribute__((ext_vector_type(4)));
typedef float f32x16 __attribute__((ext_vector_type(16)));
typedef unsigned u32x4 __attribute__((ext_vector_type(4)));
typedef unsigned u32x2 __attribute__((ext_vector_type(2)));
typedef __bf16 bf16x2_t __attribute__((ext_vector_type(2)));

constexpr int NB = 16, SEQ = 2048, DM = 1024, NTOK = NB * SEQ;
constexpr int CH = 64, NCH = SEQ / CH;
constexpr int AH = 8, AHD = 64;
constexpr int DH = 4, DHD = 128;
constexpr int IPW = 3592, NPAD = 3712;
constexpr int PBW = 2048;
constexpr int NEXP = 16384;
constexpr float EPS = 1e-6f;
constexpr int NTHREADS = 512;

constexpr size_t MiB = 1u << 20;
constexpr size_t WS_MOD = 1 * MiB;
constexpr size_t WS_SK = 2 * MiB;
constexpr size_t WS_WINT = 3 * MiB;
constexpr size_t WS_WOUTT = 11 * MiB;
constexpr size_t WS_WQT = 13 * MiB;
constexpr size_t WS_ED8 = 17 * MiB;
constexpr size_t WS_PART = 145 * MiB;
constexpr size_t WS_EU8 = 33 * MiB;
constexpr size_t WS_H8 = 49 * MiB;
constexpr size_t WS_SD = 2 * MiB + 128 * 1024;
constexpr size_t WS_SU = 2 * MiB + 192 * 1024;
constexpr size_t WS_HS = 2 * MiB + 256 * 1024;
constexpr size_t WS_H = 81 * MiB;
constexpr size_t WS_PB = 145 * MiB;
constexpr size_t WS_QA = 273 * MiB;
constexpr size_t WS_KA = 305 * MiB;
constexpr size_t WS_VT = 337 * MiB;
constexpr size_t WS_QP = 369 * MiB;
constexpr size_t WS_OL = 401 * MiB;
constexpr size_t WS_BETA = 433 * MiB;
constexpr size_t WS_G = 433 * MiB + 512 * 1024;
constexpr size_t WS_EGL = 434 * MiB;
constexpr size_t WS_NEGM = 435 * MiB;
constexpr size_t WS_END = 499 * MiB;
constexpr size_t WS_SNT = WS_QA;
constexpr size_t WS_WQ8 = WS_KA;
constexpr size_t WS_WSC = WS_KA + 4 * MiB;
constexpr size_t WS_IDS16 = WS_KA + 8 * MiB;
constexpr size_t WS_DLT = WS_QP;
constexpr size_t WS_GATES16 = WS_KA + 16 * MiB;

struct Params {
    const float *x, *c, *w_ada, *b_ada, *norm1_gain, *w_in, *q_gain, *k_gain, *rel_bias, *attn_out_gain, *conv_w, *a_log, *dt_bias,
        *dn_out_gain, *w_out, *norm2_gain, *w_query, *query_gain, *sk1, *sk2, *e_down, *e_up;
    float* out;
    unsigned char* ws;
};

typedef float f32x2h __attribute__((ext_vector_type(2)));
typedef __bf16 bf16x2h __attribute__((ext_vector_type(2)));
__device__ __forceinline__ unsigned f2bf(float f) { return (unsigned)__builtin_bit_cast(unsigned short, (__bf16)f); }
__device__ __forceinline__ unsigned pk2(float lo, float hi) { const f32x2h v = {lo, hi}; return __builtin_bit_cast(unsigned, __builtin_convertvector(v, bf16x2h)); }
__device__ __forceinline__ float bflo(unsigned u) { return __uint_as_float(u << 16); }
__device__ __forceinline__ float bfhi(unsigned u) { return __uint_as_float(u & 0xffff0000u); }
__device__ __forceinline__ float bf2f(bf16_t v) { return __uint_as_float(((unsigned)v) << 16); }
__device__ __forceinline__ float silu_f(float v) { return v * __builtin_amdgcn_rcpf(1.0f + __expf(-v)); }
__device__ __forceinline__ float dot2bf(unsigned a, unsigned b, float acc) {
    return __builtin_amdgcn_fdot2_f32_bf16(__builtin_bit_cast(bf16x2_t, a), __builtin_bit_cast(bf16x2_t, b), acc, false);
}
__device__ __forceinline__ f32x4 mfma16(bf16x8 a, bf16x8 b, f32x4 c) { return __builtin_amdgcn_mfma_f32_16x16x32_bf16(a, b, c, 0, 0, 0); }
__device__ __forceinline__ f32x16 mfma32(bf16x8 a, bf16x8 b, f32x16 c) { return __builtin_amdgcn_mfma_f32_32x32x16_bf16(a, b, c, 0, 0, 0); }
__device__ __forceinline__ bf16x8 pack8(float a0, float a1, float a2, float a3, float a4, float a5, float a6, float a7) {
    u32x4 u; u.x = pk2(a0, a1); u.y = pk2(a2, a3); u.z = pk2(a4, a5); u.w = pk2(a6, a7); return __builtin_bit_cast(bf16x8, u);
}
__device__ __forceinline__ int opaque_tid() { int t = threadIdx.x; asm volatile("" : "+v"(t)); return t; }
__device__ __forceinline__ int swap23(int v) { return (v & ~12) | ((v & 4) << 1) | ((v & 8) >> 1); }

constexpr int LDS_BYTES = 153600;

__device__ void phase0(const Params& P, unsigned char* lds, int bid, int nblk) {
    const int tid = opaque_tid();
    float* sc = (float*)lds;
    float* red = (float*)(lds + 65536);
    float* tile = (float*)(lds + 98304);
    float* mod = (float*)(P.ws + WS_MOD);
    if (bid < 384) {
        for (int e = tid; e < 16384; e += NTHREADS) { int b = e >> 10, k = e & 1023; float v = P.c[e]; sc[k * 16 + b] = silu_f(v); }
        __syncthreads();
        for (int it = bid; it < 384; it += nblk) {
            const int j0 = it * 16, cl = tid & 15, kg = tid >> 4;
            float acc[16];
#pragma unroll
            for (int b = 0; b < 16; ++b) acc[b] = 0.f;
            for (int i = 0; i < 32; ++i) {
                const int k = kg + 32 * i;
                const float w = P.w_ada[(size_t)k * 6144 + j0 + cl];
                const f32x4* sp = (const f32x4*)(sc + k * 16);
#pragma unroll
                for (int q = 0; q < 4; ++q) { f32x4 s4 = sp[q]; acc[4 * q] += s4[0] * w; acc[4 * q + 1] += s4[1] * w; acc[4 * q + 2] += s4[2] * w; acc[4 * q + 3] += s4[3] * w; }
            }
#pragma unroll
            for (int b = 0; b < 16; ++b) red[(kg * 16 + b) * 16 + cl] = acc[b];
            __syncthreads();
            if (tid < 256) {
                const int b = tid >> 4, c2 = tid & 15; float s = 0.f;
                for (int g = 0; g < 32; ++g) s += red[(g * 16 + b) * 16 + c2];
                mod[b * 6144 + j0 + c2] = s + P.b_ada[j0 + c2];
            }
            __syncthreads();
        }
    }
    for (int it = bid; it < 928 + 256 + 512; it += nblk) {
        const float* src; bf16_t* dst; int N, nt, kt;
        if (it < 928) { src = P.w_in; dst = (bf16_t*)(P.ws + WS_WINT); N = IPW; nt = it % 58; kt = it / 58; }
        else if (it < 928 + 256) { const int r = it - 928; src = P.w_out; dst = (bf16_t*)(P.ws + WS_WOUTT); N = 1024; nt = r % 16; kt = r / 16; }
        else { const int r = it - 1184; src = P.w_query; dst = (bf16_t*)(P.ws + WS_WQT); N = 2048; nt = r % 32; kt = r / 32; }
        const int n0 = nt * 64, k0 = kt * 64;
        {
            const int nl = tid & 63, kb = tid >> 6;
#pragma unroll
            for (int i = 0; i < 8; ++i) { const int kk = kb + 8 * i; const int n = n0 + nl; tile[kk * 65 + nl] = (n < N) ? src[(size_t)(k0 + kk) * N + n] : 0.f; }
        }
        __syncthreads();
        {
            const int kl = (tid & 7) * 8, nl = tid >> 3;
            u32x4 o;
            o.x = pk2(tile[(kl + 0) * 65 + nl], tile[(kl + 1) * 65 + nl]); o.y = pk2(tile[(kl + 2) * 65 + nl], tile[(kl + 3) * 65 + nl]);
            o.z = pk2(tile[(kl + 4) * 65 + nl], tile[(kl + 5) * 65 + nl]); o.w = pk2(tile[(kl + 6) * 65 + nl], tile[(kl + 7) * 65 + nl]);
            *(u32x4*)(dst + (size_t)(n0 + nl) * 1024 + k0 + kl) = o;
        }
        __syncthreads();
    }
    {
        const int lane = tid & 63, wv = tid >> 6;
        for (int row = bid * 8 + wv; row < 2 * NEXP; row += nblk * 8) {
            const bool up = row >= NEXP; const int er = up ? row - NEXP : row;
            const float* src = (up ? P.e_up : P.e_down) + (size_t)er * 1024 + 16 * lane;
            f32x4 v[4]; float am = 0.f;
#pragma unroll
            for (int q = 0; q < 4; ++q) { v[q] = *(const f32x4*)(src + 4 * q); am = fmaxf(am, fmaxf(fmaxf(fabsf(v[q][0]), fabsf(v[q][1])), fmaxf(fabsf(v[q][2]), fabsf(v[q][3])))); }
#pragma unroll
            for (int o = 32; o > 0; o >>= 1) am = fmaxf(am, __shfl_xor(am, o));
            am = am > 0.f ? am : 1.0f;
            u32x4 o4;
            {
                const float sc = am * (1.0f / 127.0f), inv = 127.0f / am;
#pragma unroll
                for (int q = 0; q < 4; ++q) {
                    const int b0 = (int)rintf(v[q][0] * inv), b1 = (int)rintf(v[q][1] * inv), b2 = (int)rintf(v[q][2] * inv), b3 = (int)rintf(v[q][3] * inv);
                    o4[q] = (unsigned)(b0 & 255) | ((unsigned)(b1 & 255) << 8) | ((unsigned)(b2 & 255) << 16) | ((unsigned)(b3 & 255) << 24);
                }
                *(u32x4*)((signed char*)(P.ws + (up ? WS_EU8 : WS_ED8)) + ((size_t)(lane >> 3) * NEXP + er) * 128 + 16 * (lane & 7)) = o4;
                if (lane == 0) ((float*)(P.ws + (up ? WS_SU : WS_SD)))[er] = sc;
            }
        }
    }
    {
        const int gid = bid * NTHREADS + tid;
        if (gid < 32768) {
            const int p = gid >> 14, rem = gid & 16383, d = rem & 127;
            const float v = (p ? P.sk2 : P.sk1)[rem] * P.query_gain[128 * p + d];
            ((bf16_t*)(P.ws + WS_SK))[gid] = (bf16_t)f2bf(v);
        }
    }
}

template <bool WITH_BG, bool WITH_Q8>
__device__ void norm_mod_phase(const Params& P, const float* __restrict__ src, const bf16_t* __restrict__ dlt, float* __restrict__ x1out, const float* __restrict__ gain, const float* __restrict__ mod, int shift_off, int scale_off,
                               bf16_t* __restrict__ dst, int bid, int nblk) {
    const int tid_ = opaque_tid(); const int lane = tid_ & 63, wid = tid_ >> 6;
    float wreg[WITH_BG ? 16 : 1][8];
    if (WITH_BG) {
#pragma unroll
        for (int i = 0; i < 4; ++i)
#pragma unroll
            for (int jj = 0; jj < 4; ++jj) {
                const float* wp = P.w_in + (size_t)(256 * i + 4 * lane + jj) * IPW + 3584;
                const f32x4 w0 = *(const f32x4*)wp, w1 = *(const f32x4*)(wp + 4);
                wreg[4 * i + jj][0] = w0[0]; wreg[4 * i + jj][1] = w0[1]; wreg[4 * i + jj][2] = w0[2]; wreg[4 * i + jj][3] = w0[3];
                wreg[4 * i + jj][4] = w1[0]; wreg[4 * i + jj][5] = w1[1]; wreg[4 * i + jj][6] = w1[2]; wreg[4 * i + jj][7] = w1[3];
            }
    }
    for (int row = bid * 8 + wid; row < NTOK; row += nblk * 8) {
        const int b = row >> 11;
        f32x4 v[4]; float ss = 0.f;
#pragma unroll
        for (int i = 0; i < 4; ++i) {
            v[i] = *(const f32x4*)(src + (size_t)row * DM + 256 * i + 4 * lane);
            if (WITH_Q8) {
                const u32x2 d2 = *(const u32x2*)(dlt + (size_t)row * DM + 256 * i + 4 * lane);
                v[i][0] += bflo(d2.x); v[i][1] += bfhi(d2.x); v[i][2] += bflo(d2.y); v[i][3] += bfhi(d2.y);
            }
            ss += v[i][0] * v[i][0] + v[i][1] * v[i][1] + v[i][2] * v[i][2] + v[i][3] * v[i][3];
        }
#pragma unroll
        for (int o = 32; o > 0; o >>= 1) ss += __shfl_xor(ss, o);
        const float rstd = rsqrtf(ss * (1.0f / DM) + EPS);
        float a8[8];
        float yq[WITH_Q8 ? 4 : 1][4];
#pragma unroll
        for (int q = 0; q < 8; ++q) a8[q] = 0.f;
#pragma unroll
        for (int i = 0; i < 4; ++i) {
            const int c = 256 * i + 4 * lane;
            const f32x4 g = *(const f32x4*)(gain + c), sh = *(const f32x4*)(mod + b * 6144 + shift_off + c), sc = *(const f32x4*)(mod + b * 6144 + scale_off + c);
            float y[4];
#pragma unroll
            for (int jj = 0; jj < 4; ++jj) {
                y[jj] = v[i][jj] * rstd * g[jj] * (1.0f + sc[jj]) + sh[jj];
                if (WITH_BG) {
#pragma unroll
                    for (int q = 0; q < 8; ++q) a8[q] += y[jj] * wreg[4 * i + jj][q];
                }
            }
            u32x2 o; o.x = pk2(y[0], y[1]); o.y = pk2(y[2], y[3]);
            *(u32x2*)(dst + (size_t)row * DM + c) = o;
            if (WITH_Q8) { yq[i][0] = y[0]; yq[i][1] = y[1]; yq[i][2] = y[2]; yq[i][3] = y[3]; }
        }
        if (WITH_Q8) {
            float am = 0.f;
#pragma unroll
            for (int i = 0; i < 4; ++i) am = fmaxf(am, fmaxf(fmaxf(fabsf(yq[i][0]), fabsf(yq[i][1])), fmaxf(fabsf(yq[i][2]), fabsf(yq[i][3]))));
#pragma unroll
            for (int o = 32; o > 0; o >>= 1) am = fmaxf(am, __shfl_xor(am, o));
            am = am > 0.f ? am : 1.0f;
            const float inv = 127.0f / am;
#pragma unroll
            for (int i = 0; i < 4; ++i) {
                const int b0 = (int)rintf(yq[i][0] * inv), b1 = (int)rintf(yq[i][1] * inv), b2 = (int)rintf(yq[i][2] * inv), b3 = (int)rintf(yq[i][3] * inv);
                *(unsigned*)((signed char*)(P.ws + WS_H8) + (size_t)row * DM + 256 * i + 4 * lane) = (unsigned)(b0 & 255) | ((unsigned)(b1 & 255) << 8) | ((unsigned)(b2 & 255) << 16) | ((unsigned)(b3 & 255) << 24);
            }
            if (lane == 0) ((float*)(P.ws + WS_HS))[row] = am * (1.0f / 127.0f);
        }
        if (WITH_BG) {
            const bool u1 = (lane & 1) != 0, u2 = (lane & 2) != 0, u4 = (lane & 4) != 0;
            float z4[4];
#pragma unroll
            for (int q = 0; q < 4; ++q) { const float keep = u1 ? a8[2 * q + 1] : a8[2 * q], send = u1 ? a8[2 * q] : a8[2 * q + 1]; z4[q] = keep + __shfl_xor(send, 1); }
            float z2[2];
#pragma unroll
            for (int q = 0; q < 2; ++q) { const float keep = u2 ? z4[2 * q + 1] : z4[2 * q], send = u2 ? z4[2 * q] : z4[2 * q + 1]; z2[q] = keep + __shfl_xor(send, 2); }
            const float keep = u4 ? z2[1] : z2[0], send = u4 ? z2[0] : z2[1];
            float t = keep + __shfl_xor(send, 4);
            t += __shfl_xor(t, 8); t += __shfl_xor(t, 16); t += __shfl_xor(t, 32);
            if (lane < 4) ((float*)(P.ws + WS_BETA))[(size_t)row * 4 + lane] = 1.0f / (1.0f + __expf(-t));
            else if (lane < 8) {
                const int hq = lane - 4; const float xx = t + P.dt_bias[hq];
                const float sp = xx > 20.f ? xx : log1pf(__expf(xx));
                ((float*)(P.ws + WS_G))[(size_t)row * 4 + hq] = -__expf(P.a_log[hq]) * sp;
            }
        }
    }
}

namespace pg8 {
#define PG8_LAS __attribute__((address_space(3)))
constexpr int BM = 256, BK = 64, HALF = 128, HTB = HALF * BK * 2, NXCD = 8, WGM = 8;
__host__ __device__ __forceinline__ int lds_byte(int r, int c) { const int st = (r >> 4) * 2 + (c >> 5), rr = r & 15, cc = c & 31, ob = rr * 64 + cc * 2; return st * 1024 + (ob ^ (((ob >> 9) & 1) << 5)); }
__host__ __device__ __forceinline__ void stage_rc(int b, int& R, int& C) { const int st = b / 1024, sb = b % 1024, swz = sb ^ (((sb >> 9) & 1) << 5); R = (st >> 1) * 16 + swz / 64; C = (st & 1) * 32 + (swz % 64) / 2; }
__host__ __device__ __forceinline__ int perm32(int rho) { const int n = rho >> 4, i = rho & 15; return 8 * (i >> 2) + 4 * n + (i & 3); }
struct Unit { int pm, pn; };
struct Gemm { const bf16_t* A; const bf16_t* Bt; int M, N, K; };
struct StaticOrder {
    int nM, nN, nwg, G, c;
    __host__ __device__ void init(int M, int N, int G_, int c_) { nM = M / BM; nN = N / BM; nwg = nM * nN; G = G_; c = c_; }
    __host__ __device__ bool next(int i, Unit& u) const {
        const long L = (long)i * G + c; if (L >= nwg) return false;
        int wgid = (int)L; { const int q = nwg / NXCD, r = nwg % NXCD, xcd = wgid % NXCD, off = wgid / NXCD; wgid = (xcd < r ? xcd * (q + 1) : r * (q + 1) + (xcd - r) * q) + off; }
        const int nig = WGM * nN, gid = wgid / nig, fm = gid * WGM, gsz = (nM - fm) < WGM ? (nM - fm) : WGM;
        u.pm = fm + ((wgid % nig) % gsz); u.pn = (wgid % nig) / gsz; return true;
    }
};

template <class Epi>
__device__ __forceinline__ void gemm_phase(PG8_LAS unsigned char* lds, const Gemm g, const StaticOrder& S, const Epi& E) {
    const int tid = opaque_tid(), wid = __builtin_amdgcn_readfirstlane(tid >> 6), lane = tid & 63, wr = wid >> 2, wc = wid & 3, fr = lane & 15, fq = lane >> 4;
    const int K = g.K, nt = K / BK;
    unsigned voffA[2], voffB[2];
#pragma unroll
    for (int i = 0; i < 2; ++i) { int R, C; stage_rc(tid * 16 + i * 8192, R, C); const int Rb = 64 * (R >> 5) + perm32(R & 31);
        voffA[i] = (unsigned)(R * K + C) * 2u; voffB[i] = (unsigned)(Rb * K + C) * 2u; }
    const size_t kstep = (size_t)(BK * 2);
    const size_t hstep = (size_t)HALF * K * 2;
    const size_t hstepB = (size_t)32 * K * 2;
    const size_t tstep = 2 * hstep;
    const unsigned ldsw = (unsigned)wid * 1024u;
    const int aoff = lds_byte(wr * 64 + fr, fq * 8), boff = lds_byte(wc * 32 + fr, fq * 8);
#define PG8_SA(b, h) (((b) * 2 + (h)) * HTB)
#define PG8_SB(b, h) ((4 + (b) * 2 + (h)) * HTB)
#define PG8_STAGE(bufoff, gbase, voff) do { _Pragma("unroll") for (int _i = 0; _i < 2; ++_i) \
        __builtin_amdgcn_global_load_lds((const unsigned*)((const char*)(gbase) + (voff)[_i]), (PG8_LAS unsigned*)(lds + (bufoff) + ldsw + _i * 8192), 16, 0, 0); } while (0)
#define PG8_LDA(dst, b, h) do { _Pragma("unroll") for (int m = 0; m < 4; ++m) _Pragma("unroll") for (int k = 0; k < 2; ++k) dst[m][k] = *(const PG8_LAS bf16x8*)(lds + PG8_SA(b, h) + aoff + m * 2048 + k * 1024); } while (0)
#define PG8_LDB(dst, b, h) do { _Pragma("unroll") for (int n = 0; n < 2; ++n) _Pragma("unroll") for (int k = 0; k < 2; ++k) dst[n][k] = *(const PG8_LAS bf16x8*)(lds + PG8_SB(b, h) + boff + n * 2048 + k * 1024); } while (0)
#define PG8_MMA(ai, bj, At, Bt) do { __builtin_amdgcn_s_setprio(1); _Pragma("unroll") for (int m = 0; m < 4; ++m) _Pragma("unroll") for (int n = 0; n < 2; ++n) _Pragma("unroll") for (int k = 0; k < 2; ++k) \
        acc[ai][bj][m][n] = __builtin_amdgcn_mfma_f32_16x16x32_bf16(Bt[n][k], At[m][k], acc[ai][bj][m][n], 0, 0, 0); __builtin_amdgcn_s_setprio(0); } while (0)
#define PG8_WAIT_V(n) asm volatile("s_waitcnt vmcnt(" #n ")" ::: "memory")
#define PG8_WAIT_L(n) asm volatile("s_waitcnt lgkmcnt(" #n ")" ::: "memory")
#define PG8_BAR __builtin_amdgcn_s_barrier()
#define PG8_SCHED __builtin_amdgcn_sched_barrier(0)
    Unit cur, nxt; int ui = 0;
    if (!S.next(0, cur)) return;
    f32x4 acc[2][2][4][2];
#pragma unroll
    for (int a = 0; a < 2; ++a)
#pragma unroll
        for (int b = 0; b < 2; ++b)
#pragma unroll
            for (int m = 0; m < 4; ++m)
#pragma unroll
                for (int n = 0; n < 2; ++n) acc[a][b][m][n] = (f32x4){0.f, 0.f, 0.f, 0.f};
    bf16x8 At[4][2], B0[2][2], B1[2][2];
    const char* cA = (const char*)g.A + (size_t)cur.pm * tstep; const char* cB = (const char*)g.Bt + (size_t)cur.pn * tstep;
    PG8_STAGE(PG8_SB(0, 0), cB, voffB); PG8_STAGE(PG8_SB(0, 1), cB + hstepB, voffB); PG8_STAGE(PG8_SA(0, 0), cA, voffA); PG8_STAGE(PG8_SA(0, 1), cA + hstep, voffA);
    if (wr == 1) PG8_BAR;
    PG8_WAIT_V(2); PG8_BAR;
    PG8_STAGE(PG8_SB(1, 0), cB + kstep, voffB); PG8_STAGE(PG8_SA(1, 0), cA + kstep, voffA); PG8_STAGE(PG8_SB(1, 1), cB + hstepB + kstep, voffB);
    PG8_WAIT_V(6); PG8_BAR;
    for (;;) {
        const bool has_next = S.next(ui + 1, nxt);
        const char* nA = has_next ? (const char*)g.A + (size_t)nxt.pm * tstep : cA; const char* nB = has_next ? (const char*)g.Bt + (size_t)nxt.pn * tstep : cB;
        for (int t = 0; t < nt; t += 2) {
            const bool last = (t == nt - 2);
            const char* a1 = cA + (size_t)(t + 1) * kstep;
            const char* a2 = last ? nA : cA + (size_t)(t + 2) * kstep; const char* b2 = last ? nB : cB + (size_t)(t + 2) * kstep;
            const char* a3 = a2 + kstep; const char* b3 = b2 + kstep;
            PG8_LDB(B0, 0, 0); PG8_LDB(B1, 0, 1); PG8_SCHED; PG8_LDA(At, 0, 0); PG8_STAGE(PG8_SA(1, 1), a1 + hstep, voffA);
            PG8_WAIT_V(8); PG8_WAIT_L(0); PG8_BAR; PG8_MMA(0, 0, At, B0); PG8_MMA(0, 1, At, B1); PG8_BAR; PG8_SCHED;
            PG8_LDA(At, 0, 1); PG8_STAGE(PG8_SB(0, 0), b2, voffB); PG8_STAGE(PG8_SB(0, 1), b2 + hstepB, voffB); PG8_STAGE(PG8_SA(0, 0), a2, voffA);
            PG8_WAIT_V(8); PG8_WAIT_L(0); PG8_BAR; PG8_MMA(1, 0, At, B0); PG8_MMA(1, 1, At, B1); PG8_BAR; PG8_SCHED;
            PG8_LDB(B0, 1, 0); PG8_LDB(B1, 1, 1); PG8_SCHED; PG8_LDA(At, 1, 0); PG8_STAGE(PG8_SA(0, 1), a2 + hstep, voffA);
            PG8_WAIT_V(8); PG8_WAIT_L(0); PG8_BAR; PG8_MMA(0, 0, At, B0); PG8_MMA(0, 1, At, B1); PG8_BAR; PG8_SCHED;
            PG8_LDA(At, 1, 1); PG8_STAGE(PG8_SB(1, 0), b3, voffB); PG8_STAGE(PG8_SB(1, 1), b3 + hstepB, voffB); PG8_STAGE(PG8_SA(1, 0), a3, voffA);
            PG8_WAIT_V(8); PG8_WAIT_L(0); PG8_BAR; PG8_MMA(1, 0, At, B0); PG8_MMA(1, 1, At, B1); PG8_BAR; PG8_SCHED;
        }
        if (wr == 0) PG8_BAR;
        E(acc, cur, wr, wc, fr, fq);
        if (!has_next) break;
#pragma unroll
        for (int a = 0; a < 2; ++a)
#pragma unroll
            for (int b = 0; b < 2; ++b)
#pragma unroll
                for (int m = 0; m < 4; ++m)
#pragma unroll
                    for (int n = 0; n < 2; ++n) acc[a][b][m][n] = (f32x4){0.f, 0.f, 0.f, 0.f};
        cur = nxt; cA = nA; cB = nB; ++ui;
        if (wr == 1) PG8_BAR;
    }
    PG8_WAIT_V(0);
    PG8_BAR;
#undef PG8_SA
#undef PG8_SB
#undef PG8_STAGE
#undef PG8_LDA
#undef PG8_LDB
#undef PG8_MMA
#undef PG8_WAIT_V
#undef PG8_WAIT_L
#undef PG8_BAR
#undef PG8_SCHED
}
}

#define ACC_T const f32x4 (&acc)[2][2][4][2]
__device__ __forceinline__ u32x4 pack_acc8(const f32x4& a, const f32x4& b, float s) {
    u32x4 o; o.x = pk2(a[0] * s, a[1] * s); o.y = pk2(a[2] * s, a[3] * s); o.z = pk2(b[0] * s, b[1] * s); o.w = pk2(b[2] * s, b[3] * s); return o;
}
struct EpiQK {
    const float *q_gain, *k_gain;
    bf16_t *qa, *ka;
    __device__ __forceinline__ void operator()(ACC_T, const pg8::Unit& u, int wr, int wc, int fr, int fq) const {
        const int pn = u.pn, bb = u.pm >> 3, s0 = (u.pm & 7) * 256 + wr * 64;
        {
            const bool isq = pn < 2; const int head = (pn & 1) * 4 + wc;
            const float* gn = isq ? q_gain : k_gain; const float sc = isq ? 0.125f * 1.4426950408889634f : 1.0f;
            bf16_t* ub = (isq ? qa : ka) + ((size_t)(bb * AH + head) * SEQ + s0) * 64;
            const unsigned lo = isq ? (unsigned)(fr * 64 + 8 * fq) : (unsigned)(fq * 256 + fr * 8);
            const float* gl = gn + 8 * fq;
#pragma unroll
            for (int ai = 0; ai < 2; ++ai)
#pragma unroll
                for (int m = 0; m < 4; ++m) {
                    float ss = 0.f;
#pragma unroll
                    for (int bj = 0; bj < 2; ++bj)
#pragma unroll
                        for (int n = 0; n < 2; ++n)
#pragma unroll
                            for (int r = 0; r < 4; ++r) ss += acc[ai][bj][m][n][r] * acc[ai][bj][m][n][r];
                    ss += __shfl_xor(ss, 16); ss += __shfl_xor(ss, 32);
                    const float rstd = rsqrtf(ss * (1.0f / 64.0f) + EPS) * sc;
                    bf16_t* p = isq ? (ub + (ai * 128 + m * 16) * 64) : (ub + (ai * 4 + (m >> 1)) * 2048 + (m & 1) * 128);
#pragma unroll
                    for (int bj = 0; bj < 2; ++bj) {
                        const f32x4 g0 = *(const f32x4*)(gl + 32 * bj), g1 = *(const f32x4*)(gl + 32 * bj + 4);
                        u32x4 o;
                        o.x = pk2(acc[ai][bj][m][0][0] * rstd * g0[0], acc[ai][bj][m][0][1] * rstd * g0[1]); o.y = pk2(acc[ai][bj][m][0][2] * rstd * g0[2], acc[ai][bj][m][0][3] * rstd * g0[3]);
                        o.z = pk2(acc[ai][bj][m][1][0] * rstd * g1[0], acc[ai][bj][m][1][1] * rstd * g1[1]); o.w = pk2(acc[ai][bj][m][1][2] * rstd * g1[2], acc[ai][bj][m][1][3] * rstd * g1[3]);
                        *(u32x4*)(p + (isq ? 32 * bj : 1024 * bj) + lo) = o;
                    }
                }
        }
    }
};
struct EpiV {
    bf16_t* vt;
    __device__ __forceinline__ void operator()(ACC_T, const pg8::Unit& u, int wr, int wc, int fr, int fq) const {
        const int pn = u.pn, bb = u.pm >> 3, s0 = (u.pm & 7) * 256 + wr * 64;
        {
            const int head = (pn & 1) * 4 + wc;
            bf16_t* ub = vt + ((size_t)(bb * AH + head) * SEQ + s0) * 64;
            const int pp = swap23(fr);
            const unsigned lo = (unsigned)((pp >> 3) * 256 + 8 * fq * 8 + (pp & 7));
#pragma unroll
            for (int ai = 0; ai < 2; ++ai)
#pragma unroll
                for (int m = 0; m < 4; ++m)
#pragma unroll
                    for (int bj = 0; bj < 2; ++bj)
#pragma unroll
                        for (int n = 0; n < 2; ++n)
#pragma unroll
                            for (int r = 0; r < 4; ++r)
                                (ub + (ai * 2 + (m >> 2)) * 4096 + ((bj * 2 + ((m >> 1) & 1)) * 2 + (m & 1)) * 512 + (4 * n + r) * 8)[lo] = (bf16_t)f2bf(acc[ai][bj][m][n][r]);
        }
    }
};
struct EpiOut {
    const float* mod; bf16_t* dlt;
    __device__ __forceinline__ void operator()(ACC_T, const pg8::Unit& u, int wr, int wc, int fr, int fq) const {
        bf16_t* ub = dlt + (size_t)(u.pm * 256 + wr * 64) * DM + u.pn * 256 + wc * 64;
        const float* ug = mod + (u.pm >> 3) * 6144 + 2048 + u.pn * 256 + wc * 64;
        const unsigned lo = (unsigned)(fr * DM + 8 * fq), lg = (unsigned)(8 * fq);
#pragma unroll
        for (int bj = 0; bj < 2; ++bj) {
            const f32x4 g0 = *(const f32x4*)(ug + 32 * bj + lg), g1 = *(const f32x4*)(ug + 32 * bj + 4 + lg);
#pragma unroll
            for (int ai = 0; ai < 2; ++ai)
#pragma unroll
                for (int m = 0; m < 4; ++m) {
                    const f32x4& a0 = acc[ai][bj][m][0]; const f32x4& a1 = acc[ai][bj][m][1];
                    u32x4 o; o.x = pk2(a0[0] * g0[0], a0[1] * g0[1]); o.y = pk2(a0[2] * g0[2], a0[3] * g0[3]); o.z = pk2(a1[0] * g1[0], a1[1] * g1[1]); o.w = pk2(a1[2] * g1[2], a1[3] * g1[3]);
                    *(u32x4*)(ub + (ai * 128 + m * 16) * DM + 32 * bj + lo) = o;
                }
        }
    }
};
struct EpiBf {
    bf16_t* dst; int ld;
    __device__ __forceinline__ void operator()(ACC_T, const pg8::Unit& u, int wr, int wc, int fr, int fq) const {
        bf16_t* ub = dst + (size_t)(u.pm * 256 + wr * 64) * ld + u.pn * 256 + wc * 64;
        const unsigned lo = (unsigned)(fr * ld + 8 * fq);
#pragma unroll
        for (int ai = 0; ai < 2; ++ai)
#pragma unroll
            for (int m = 0; m < 4; ++m)
#pragma unroll
                for (int bj = 0; bj < 2; ++bj) *(u32x4*)(ub + (ai * 128 + m * 16) * ld + 32 * bj + lo) = pack_acc8(acc[ai][bj][m][0], acc[ai][bj][m][1], 1.0f);
    }
};
struct EpiInAll {
    EpiQK qk; EpiV v; EpiBf pbf;
    __device__ __forceinline__ void operator()(ACC_T, const pg8::Unit& u, int wr, int wc, int fr, int fq) const {
        if (u.pn < 4) qk(acc, u, wr, wc, fr, fq);
        else if (u.pn < 6) { pg8::Unit u2 = u; u2.pn = u.pn - 4; v(acc, u2, wr, wc, fr, fq); }
        else { pg8::Unit u2 = u; u2.pn = u.pn - 6; pbf(acc, u2, wr, wc, fr, fq); }
    }
};
#undef ACC_T
template <class Epi>
__device__ __forceinline__ void gemm_run(const bf16_t* A, const bf16_t* Bt, int M, int N, int K, const Epi& e, unsigned char* lds, int bid, int nblk) {
    pg8::Gemm g{A, Bt, M, N, K}; pg8::StaticOrder S; S.init(M, N, nblk, bid);
    pg8::gemm_phase<Epi>((PG8_LAS unsigned char*)lds, g, S, e);
}

__device__ void attn_phase(const Params& P, unsigned char* lds, int bid, int nblk) {
    const int tid0 = opaque_tid();
    {
        const int head = tid0 >> 6, lane = tid0 & 63;
        float* biasL = (float*)lds + head * 260;
        for (int i = lane; i < 257; i += 64) biasL[i] = (P.rel_bias[head * 257 + i] - P.rel_bias[head * 257 + 256]) * 1.4426950408889634f;
    }
    const bf16_t* qa = (const bf16_t*)(P.ws + WS_QA); const bf16_t* ka = (const bf16_t*)(P.ws + WS_KA); const bf16_t* vt = (const bf16_t*)(P.ws + WS_VT);
    bf16_t* mix = (bf16_t*)(P.ws + WS_H);
    for (int it = bid; it < 512; it += nblk) {
        int tid = tid0; asm volatile("" : "+v"(tid));
        const int head = tid >> 6, lane = tid & 63, l31 = lane & 31, hh = lane >> 5;
        const float* biasL = (const float*)lds + head * 260;
        float* ssq = (float*)(lds + 8 * 260 * 4);
        float* park = (float*)(lds + 16384) + head * 4096;
        const int it2 = it & 255, b = it2 & 15, pp = it2 >> 4, n = (it < 256) ? pp : 31 - pp;
        const size_t hb = (size_t)(b * AH + head);
        const bf16_t* qbase = qa + (hb * SEQ + (size_t)n * 64) * 64;
        const int cstart = (n >= 8) ? 0 : 8 - n;
        float ssv[2];
#pragma unroll
        for (int qt = 0; qt < 2; ++qt) {
            const int qi = 32 * qt + l31;
            bf16x8 bq[4];
#pragma unroll
            for (int ks = 0; ks < 4; ++ks) bq[ks] = *(const bf16x8*)(qbase + qi * 64 + 16 * ks + 8 * hh);
            f32x16 o0, o1;
#pragma unroll
            for (int r = 0; r < 16; ++r) { o0[r] = 0.f; o1[r] = 0.f; }
            float mrun = -1e30f, lrun = 0.f;
            bf16x8 kc0[4], kc1[4];
            {
                const bf16_t* kb = ka + (hb * SEQ + (size_t)(n + cstart - 8) * 64) * 64;
#pragma unroll
                for (int ks = 0; ks < 4; ++ks) { kc0[ks] = *(const bf16x8*)(kb + (2 * ks + hh) * 256 + l31 * 8); kc1[ks] = *(const bf16x8*)(kb + 2048 + (2 * ks + hh) * 256 + l31 * 8); }
            }
            for (int c = cstart; c <= 8; ++c) {
                const int kc = n + c - 8;
                const bf16_t* vb = vt + (hb * SEQ + (size_t)kc * 64) * 64;
                bf16x8 v0[4], v1[4], kn0[4], kn1[4];
#pragma unroll
                for (int kt = 0; kt < 2; ++kt)
#pragma unroll
                    for (int sp = 0; sp < 2; ++sp) {
                        v0[2 * kt + sp] = *(const bf16x8*)(vb + ((kt * 2 + sp) * 2 + hh) * 256 + l31 * 8);
                        v1[2 * kt + sp] = *(const bf16x8*)(vb + 2048 + ((kt * 2 + sp) * 2 + hh) * 256 + l31 * 8);
                    }
                {
                    const int kcn = (c < 8) ? kc + 1 : kc;
                    const bf16_t* kb = ka + (hb * SEQ + (size_t)kcn * 64) * 64;
#pragma unroll
                    for (int ks = 0; ks < 4; ++ks) { kn0[ks] = *(const bf16x8*)(kb + (2 * ks + hh) * 256 + l31 * 8); kn1[ks] = *(const bf16x8*)(kb + 2048 + (2 * ks + hh) * 256 + l31 * 8); }
                }
                f32x16 s0, s1;
#pragma unroll
                for (int r = 0; r < 16; ++r) { s0[r] = 0.f; s1[r] = 0.f; }
#pragma unroll
                for (int ks = 0; ks < 4; ++ks) { s0 = mfma32(kc0[ks], bq[ks], s0); s1 = mfma32(kc1[ks], bq[ks], s1); }
                if (c > 5) {
                    const int base = qi + 64 * (8 - c) + 128 - 4 * hh;
#pragma unroll
                    for (int r = 0; r < 16; ++r) {
                        const int j0 = (r & 3) + 8 * (r >> 2);
                        int i0 = base - j0; i0 = i0 > 256 ? 256 : i0;
                        int i1 = base - 32 - j0; i1 = i1 > 256 ? 256 : i1;
                        s0[r] += biasL[i0]; s1[r] += biasL[i1];
                    }
                }
                float mx = s0[0];
#pragma unroll
                for (int r = 1; r < 16; ++r) mx = fmaxf(mx, s0[r]);
#pragma unroll
                for (int r = 0; r < 16; ++r) mx = fmaxf(mx, s1[r]);
                mx = fmaxf(mx, __shfl_xor(mx, 32));
                const float mnew = fmaxf(mrun, mx);
                const bool grew = mnew > mrun;
                const float alpha = __builtin_amdgcn_exp2f(mrun - mnew);
                mrun = mnew;
                float psum = 0.f;
#pragma unroll
                for (int r = 0; r < 16; ++r) { s0[r] = __builtin_amdgcn_exp2f(s0[r] - mnew); s1[r] = __builtin_amdgcn_exp2f(s1[r] - mnew); psum += s0[r] + s1[r]; }
                lrun = lrun * alpha + psum;
                if (__any(grew)) {
#pragma unroll
                    for (int r = 0; r < 16; ++r) { o0[r] *= alpha; o1[r] *= alpha; }
                }
                bf16x8 pf[4];
                pf[0] = pack8(s0[0], s0[1], s0[2], s0[3], s0[4], s0[5], s0[6], s0[7]);
                pf[1] = pack8(s0[8], s0[9], s0[10], s0[11], s0[12], s0[13], s0[14], s0[15]);
                pf[2] = pack8(s1[0], s1[1], s1[2], s1[3], s1[4], s1[5], s1[6], s1[7]);
                pf[3] = pack8(s1[8], s1[9], s1[10], s1[11], s1[12], s1[13], s1[14], s1[15]);
#pragma unroll
                for (int q4 = 0; q4 < 4; ++q4) { o0 = mfma32(v0[q4], pf[q4], o0); o1 = mfma32(v1[q4], pf[q4], o1); }
#pragma unroll
                for (int ks = 0; ks < 4; ++ks) { kc0[ks] = kn0[ks]; kc1[ks] = kn1[ks]; }
            }
            const float ltot = lrun + __shfl_xor(lrun, 32), inv = 1.0f / ltot;
            float ss = 0.f;
#pragma unroll
            for (int r = 0; r < 16; ++r) { o0[r] *= inv; o1[r] *= inv; ss += o0[r] * o0[r] + o1[r] * o1[r]; }
            ss += __shfl_xor(ss, 32);
            ssv[qt] = ss;
#pragma unroll
            for (int r = 0; r < 16; ++r) { park[(qt * 32 + r) * 64 + lane] = o0[r]; park[(qt * 32 + 16 + r) * 64 + lane] = o1[r]; }
        }
        if (hh == 0) { ssq[head * 64 + l31] = ssv[0]; ssq[head * 64 + 32 + l31] = ssv[1]; }
        __syncthreads();
#pragma unroll
        for (int qt = 0; qt < 2; ++qt) {
            const int qi = 32 * qt + l31;
            float tot = 0.f;
#pragma unroll
            for (int h2 = 0; h2 < 8; ++h2) tot += ssq[h2 * 64 + qi];
            const float rstd = rsqrtf(tot * (1.0f / 512.0f) + EPS);
            const size_t tok = (size_t)b * SEQ + n * 64 + qi;
#pragma unroll
            for (int dt = 0; dt < 2; ++dt)
#pragma unroll
                for (int g4 = 0; g4 < 4; ++g4) {
                    const int dim = 32 * dt + 8 * g4 + 4 * hh;
                    const f32x4 gn = *(const f32x4*)(P.attn_out_gain + head * 64 + dim);
                    const float* pk = park + (qt * 32 + dt * 16 + 4 * g4) * 64 + lane;
                    u32x2 w; w.x = pk2(pk[0] * rstd * gn[0], pk[64] * rstd * gn[1]); w.y = pk2(pk[128] * rstd * gn[2], pk[192] * rstd * gn[3]);
                    *(u32x2*)(mix + tok * DM + head * 64 + dim) = w;
                }
        }
        __syncthreads();
    }
}

constexpr int RP = 136, TP = 72, AP = 72, AIP = 24, LDB = 273, RAWP = 784  , STGP = 136  ;
constexpr int L_KB = 0, L_KK = 17408, L_QS = 34816, L_UT = 0, L_WT = 18432, L_AINV = 36864, L_QG = 52224, L_VBT = 69632, L_KBGT = 88064, L_KDT = 106496,
              L_NL = 124928, L_LD = 134144, L_AM = 138752, L_GC = 147968, L_RED = 148480;
static_assert(L_AINV + 4 * 16 * AIP * 2 <= L_QG && L_LD + 4 * LDB * 4 <= L_AM && L_RED + 4096 <= LDS_BYTES - 16, "lds map");

__device__ void dn1_phase(const Params& P, unsigned char* lds, int bid, int nblk) {
    const int tid0 = opaque_tid();
    bf16_t* KB = (bf16_t*)(lds + L_KB); bf16_t* KK = (bf16_t*)(lds + L_KK); bf16_t* QS = (bf16_t*)(lds + L_QS);
    bf16_t* UT = (bf16_t*)(lds + L_UT); bf16_t* WT = (bf16_t*)(lds + L_WT); bf16_t* AINV = (bf16_t*)(lds + L_AINV); bf16_t* QG = (bf16_t*)(lds + L_QG);
    bf16_t* VBT = (bf16_t*)(lds + L_VBT); bf16_t* KBGT = (bf16_t*)(lds + L_KBGT); bf16_t* KDT = (bf16_t*)(lds + L_KDT);
    bf16_t* NL = (bf16_t*)(lds + L_NL); float* LD = (float*)(lds + L_LD); bf16_t* AM = (bf16_t*)(lds + L_AM);
    float* gcs = (float*)(lds + L_GC); float* bts = gcs + 64; float* red = (float*)(lds + L_RED);
    const bf16_t* pb = (const bf16_t*)(P.ws + WS_PB);
    const float* betaG = (const float*)(P.ws + WS_BETA); const float* gG = (const float*)(P.ws + WS_G);
    bf16_t* negM = (bf16_t*)(P.ws + WS_NEGM); bf16_t* BmT = (bf16_t*)P.out; bf16_t* Qp = (bf16_t*)(P.ws + WS_QP); bf16_t* Ol = (bf16_t*)(P.ws + WS_OL);
    float* egl = (float*)(P.ws + WS_EGL);
    u32x4 rv[7]; float gpre = 0.f, bpre = 0.f;
#define DN1_PREFETCH(IT)                                                                                                   \
    {                                                                                                                      \
        const int tidp_ = tid0, n_ = (IT) & 31, bh_ = (IT) >> 5, h_ = bh_ & 3, b_ = bh_ >> 2;                               \
        _Pragma("unroll") for (int q = 0; q < 7; ++q) {                                                                    \
            const int ci = tidp_ + 512 * q, row = ci / 48, c16 = ci - row * 48, mat = c16 >> 4, cc = c16 & 15;             \
            const int srow = n_ * 64 - 3 + row;                                                                            \
            const bool ok = (ci < 67 * 48) && (srow >= 0);                                                                 \
            const bf16_t* src = pb + (size_t)(b_ * SEQ + (ok ? srow : 0)) * PBW + mat * 512 + h_ * 128 + cc * 8;           \
            rv[q] = *(const u32x4*)src;                                                                                    \
            if (!ok) rv[q] = (u32x4){0u, 0u, 0u, 0u};                                                                      \
        }                                                                                                                  \
        if (tidp_ < 64) { const size_t tg_ = (size_t)(b_ * SEQ + n_ * 64 + tidp_) * 4 + h_; gpre = gG[tg_]; bpre = betaG[tg_]; } \
    }
    unsigned* qctr = (unsigned*)P.ws + 4000;
    volatile int* qnext = (volatile int*)(lds + LDS_BYTES - 32);
    if (bid < 2048) { DN1_PREFETCH(bid) }
    int item = bid;
    while (item < 2048) {
        if (tid0 == 0) *qnext = nblk + (int)__hip_atomic_fetch_add(qctr, 1u, __ATOMIC_RELAXED, __HIP_MEMORY_SCOPE_AGENT);
        int tid = tid0; asm volatile("" : "+v"(tid));
        const int wid = tid >> 6, lane = tid & 63, fr = lane & 15, fq = lane >> 4;
        const int n = item & 31, bh = item >> 5, h = bh & 3, b = bh >> 2;
        const int t0 = b * SEQ + n * 64;
        if (wid == 0) {
            float gv = gpre;
#pragma unroll
            for (int o = 1; o < 64; o <<= 1) { const float t = __shfl_up(gv, o); if (lane >= o) gv += t; }
            gcs[lane] = gv; bts[lane] = bpre;
        }
#pragma unroll
        for (int q = 0; q < 7; ++q) {
            const int ci = tid + 512 * q, row = ci / 48, c16 = ci - row * 48;
            if (ci < 67 * 48) *(u32x4*)(lds + row * RAWP + c16 * 16) = rv[q];
        }
        __syncthreads();
        const int r = lane, cg = __builtin_amdgcn_readfirstlane(wid);
        float cv[3][16];
#pragma unroll
        for (int mat = 0; mat < 3; ++mat) {
            const int col = mat * 512 + h * 128 + 16 * cg;
            float* a = cv[mat];
#pragma unroll
            for (int i = 0; i < 16; ++i) a[i] = 0.f;
#pragma unroll
            for (int tap = 0; tap < 4; ++tap) {
                const unsigned char* src = lds + (r + tap) * RAWP + (mat * 128 + 16 * cg) * 2;
                const u32x4 x0 = *(const u32x4*)src, x1 = *(const u32x4*)(src + 16);
                const float* wp = P.conv_w + tap * 1536 + col;
                const f32x4 w0 = *(const f32x4*)wp, w1 = *(const f32x4*)(wp + 4), w2 = *(const f32x4*)(wp + 8), w3 = *(const f32x4*)(wp + 12);
                a[0] += bflo(x0.x) * w0[0]; a[1] += bfhi(x0.x) * w0[1]; a[2] += bflo(x0.y) * w0[2]; a[3] += bfhi(x0.y) * w0[3];
                a[4] += bflo(x0.z) * w1[0]; a[5] += bfhi(x0.z) * w1[1]; a[6] += bflo(x0.w) * w1[2]; a[7] += bfhi(x0.w) * w1[3];
                a[8] += bflo(x1.x) * w2[0]; a[9] += bfhi(x1.x) * w2[1]; a[10] += bflo(x1.y) * w2[2]; a[11] += bfhi(x1.y) * w2[3];
                a[12] += bflo(x1.z) * w3[0]; a[13] += bfhi(x1.z) * w3[1]; a[14] += bflo(x1.w) * w3[2]; a[15] += bfhi(x1.w) * w3[3];
            }
            float ss = 0.f;
#pragma unroll
            for (int i = 0; i < 16; ++i) { a[i] = silu_f(a[i]); ss += a[i] * a[i]; }
            if (mat < 2) red[(mat * 8 + cg) * 64 + r] = ss;
        }
        __syncthreads();
        {
            float sq = 0.f, sk = 0.f;
#pragma unroll
            for (int g8 = 0; g8 < 8; ++g8) { sq += red[g8 * 64 + r]; sk += red[(8 + g8) * 64 + r]; }
            const float gc = gcs[r], bt = bts[r], gl = gcs[63];
            const float eg = __expf(gc), edk = __expf(gl - gc);
            if (tid == 0) egl[item] = __expf(gl);
            const float rq = rsqrtf(sq + EPS) * 0.08838834764831845f, rk = rsqrtf(sk + EPS);
            u32x4 o0, o1;
#define STORE_ROW(ARR, A, F)                                                                                                             \
    {                                                                                                                                    \
        o0.x = pk2(A[0] * (F), A[1] * (F)); o0.y = pk2(A[2] * (F), A[3] * (F)); o0.z = pk2(A[4] * (F), A[5] * (F)); o0.w = pk2(A[6] * (F), A[7] * (F));       \
        o1.x = pk2(A[8] * (F), A[9] * (F)); o1.y = pk2(A[10] * (F), A[11] * (F)); o1.z = pk2(A[12] * (F), A[13] * (F)); o1.w = pk2(A[14] * (F), A[15] * (F)); \
        *(u32x4*)(ARR + r * RP + 16 * cg) = o0; *(u32x4*)(ARR + r * RP + 16 * cg + 8) = o1;                                              \
    }
            const float rqe = rq * eg, rkb = rk * bt, f1 = rk * bt * eg, f2 = rk * edk;
            STORE_ROW(QS, cv[0], rq)
            STORE_ROW(QG, cv[0], rqe)
            STORE_ROW(KK, cv[1], rk)
            STORE_ROW(KB, cv[1], rkb)
#undef STORE_ROW
#pragma unroll
            for (int i = 0; i < 16; ++i) {
                const int c = 16 * cg + i;
                KBGT[c * TP + r] = (bf16_t)f2bf(cv[1][i] * f1);
                KDT[c * TP + r] = (bf16_t)f2bf(cv[1][i] * f2);
                VBT[c * TP + r] = (bf16_t)f2bf(cv[2][i] * bt);
            }
        }
        __syncthreads();
        const int item_next = __builtin_amdgcn_readfirstlane(*qnext);
        if (item_next < 2048) { DN1_PREFETCH(item_next) }
        {
            const int mat = wid >> 2, ti = wid & 3;
            const bf16_t* Asrc = mat ? QS : KB;
            bf16x8 af[4];
#pragma unroll
            for (int ks = 0; ks < 4; ++ks) af[ks] = *(const bf16x8*)(Asrc + (16 * ti + fr) * RP + 32 * ks + 8 * fq);
            for (int tj = 0; tj < 4; ++tj) {
                const int j = 16 * tj + fr;
                if (tj > ti) {
                    if (mat) {
#pragma unroll
                        for (int rr = 0; rr < 4; ++rr) AM[(16 * ti + 4 * fq + rr) * AP + j] = 0;
                    }
                    continue;
                }
                f32x4 acc = (f32x4){0.f, 0.f, 0.f, 0.f};
#pragma unroll
                for (int ks = 0; ks < 4; ++ks) { const bf16x8 bf = *(const bf16x8*)(KK + j * RP + 32 * ks + 8 * fq); acc = mfma16(af[ks], bf, acc); }
                const float gj = gcs[j];
#pragma unroll
                for (int rr = 0; rr < 4; ++rr) {
                    const int i = 16 * ti + 4 * fq + rr;
                    const float dec = __expf(gcs[i] - gj);
                    if (mat == 0) {
                        if (tj < ti) NL[i * AP + j] = (bf16_t)f2bf(-acc[rr] * dec);
                        else LD[ti * LDB + (4 * fq + rr) * 17 + fr] = (i > j) ? acc[rr] * dec : 0.f;
                    } else AM[i * AP + j] = (bf16_t)f2bf((i >= j) ? acc[rr] * dec : 0.f);
                }
            }
        }
        __syncthreads();
        {
            {
                const int blk = lane >> 4, cp = lane & 15;
                float xv[16];
#pragma unroll
                for (int i = 0; i < 16; ++i) {
                    float a = (i == cp) ? 1.0f : 0.0f;
#pragma unroll
                    for (int jj = 0; jj < i; ++jj) a -= LD[blk * LDB + i * 17 + jj] * xv[jj];
                    xv[i] = a;
                }
#pragma unroll
                for (int i = 0; i < 16; ++i) AINV[(blk * 16 + i) * AIP + cp] = (bf16_t)f2bf(xv[i]);
            }
#pragma unroll 1
            for (int cti = 0; cti < 2; ++cti) {
                const int ct = 2 * wid + cti;
                const bf16_t* RT = (ct < 8) ? (VBT + (16 * ct) * TP) : (KBGT + (16 * (ct - 8)) * TP);
                bf16_t* XT = (ct < 8) ? (UT + (16 * ct) * TP) : (WT + (16 * (ct - 8)) * TP);
#pragma unroll
                for (int bq = 0; bq < 4; ++bq) {
                    const u32x2 r2 = *(const u32x2*)(RT + fr * TP + 16 * bq + 4 * fq);
                    f32x4 acc = (f32x4){bflo(r2.x), bfhi(r2.x), bflo(r2.y), bfhi(r2.y)};
                    if (bq > 0) {
#pragma unroll
                        for (int ks = 0; ks < (16 * bq + 31) / 32; ++ks) {
                            bf16x8 a = *(const bf16x8*)(NL + (16 * bq + fr) * AP + 32 * ks + 8 * fq);
                            bf16x8 xb = *(const bf16x8*)(XT + fr * TP + 32 * ks + 8 * fq);
                            if (32 * ks + 8 * fq >= 16 * bq) { a = (bf16x8){0, 0, 0, 0, 0, 0, 0, 0}; xb = (bf16x8){0, 0, 0, 0, 0, 0, 0, 0}; }
                            acc = mfma16(a, xb, acc);
                        }
                    }
                    u32x4 uf; uf.x = pk2(acc[0], acc[1]); uf.y = pk2(acc[2], acc[3]); uf.z = 0u; uf.w = 0u;
                    const u32x2 ai2 = *(const u32x2*)(AINV + (bq * 16 + fr) * AIP + 4 * fq);
                    u32x4 af; af.x = ai2.x; af.y = ai2.y; af.z = 0u; af.w = 0u;
                    f32x4 xo = (f32x4){0.f, 0.f, 0.f, 0.f};
                    xo = mfma16(__builtin_bit_cast(bf16x8, af), __builtin_bit_cast(bf16x8, uf), xo);
                    u32x2 o; o.x = pk2(xo[0], xo[1]); o.y = pk2(xo[2], xo[3]);
                    *(u32x2*)(XT + fr * TP + 16 * bq + 4 * fq) = o;
                }
            }
        }
        __syncthreads();
        {
            const size_t ib = (size_t)item * 16384;
            bf16_t* stg = (bf16_t*)(lds + L_VBT) + wid * (16 * STGP);
            {
                const bf16x8 b0 = *(const bf16x8*)(KDT + (16 * wid + fr) * TP + 8 * fq), b1 = *(const bf16x8*)(KDT + (16 * wid + fr) * TP + 32 + 8 * fq);
#pragma unroll
                for (int t = 0; t < 8; ++t) {
                    const bf16x8 a0 = *(const bf16x8*)(WT + (16 * t + fr) * TP + 8 * fq), a1 = *(const bf16x8*)(WT + (16 * t + fr) * TP + 32 + 8 * fq);
                    f32x4 acc = (f32x4){0.f, 0.f, 0.f, 0.f};
                    acc = mfma16(a0, b0, acc); acc = mfma16(a1, b1, acc);
                    u32x2 o; o.x = pk2(-acc[0], -acc[1]); o.y = pk2(-acc[2], -acc[3]);
                    *(u32x2*)(stg + fr * STGP + 16 * t + 4 * fq) = o;
                }
#pragma unroll
                for (int q = 0; q < 4; ++q) {
                    const int row = (lane >> 4) + 4 * q;
                    const u32x4 v = *(const u32x4*)(stg + row * STGP + (lane & 15) * 8);
                    *(u32x4*)(negM + ib + (size_t)(16 * wid + row) * 128 + (lane & 15) * 8) = v;
                }
            }
            {
                const bf16x8 b0 = *(const bf16x8*)(UT + (16 * wid + fr) * TP + 8 * fq), b1 = *(const bf16x8*)(UT + (16 * wid + fr) * TP + 32 + 8 * fq);
#pragma unroll
                for (int t = 0; t < 8; ++t) {
                    const bf16x8 a0 = *(const bf16x8*)(KDT + (16 * t + fr) * TP + 8 * fq), a1 = *(const bf16x8*)(KDT + (16 * t + fr) * TP + 32 + 8 * fq);
                    f32x4 acc = (f32x4){0.f, 0.f, 0.f, 0.f};
                    acc = mfma16(a0, b0, acc); acc = mfma16(a1, b1, acc);
                    u32x2 o; o.x = pk2(acc[0], acc[1]); o.y = pk2(acc[2], acc[3]);
                    *(u32x2*)(stg + fr * STGP + 16 * t + 4 * fq) = o;
                }
#pragma unroll
                for (int q = 0; q < 4; ++q) {
                    const int row = (lane >> 4) + 4 * q;
                    const u32x4 v = *(const u32x4*)(stg + row * STGP + (lane & 15) * 8);
                    *(u32x4*)(BmT + ib + (size_t)(16 * wid + row) * 128 + (lane & 15) * 8) = v;
                }
            }
            {
                const int it4 = wid & 3, hf = wid >> 2;
                const bf16x8 b0 = *(const bf16x8*)(AM + (16 * it4 + fr) * AP + 8 * fq), b1 = *(const bf16x8*)(AM + (16 * it4 + fr) * AP + 32 + 8 * fq);
#pragma unroll
                for (int tt = 0; tt < 4; ++tt) {
                    const int t = 4 * hf + tt;
                    const bf16x8 a0 = *(const bf16x8*)(WT + (16 * t + fr) * TP + 8 * fq), a1 = *(const bf16x8*)(WT + (16 * t + fr) * TP + 32 + 8 * fq);
                    f32x4 acc = (f32x4){0.f, 0.f, 0.f, 0.f};
                    acc = mfma16(a0, b0, acc); acc = mfma16(a1, b1, acc);
                    const u32x2 qg = *(const u32x2*)(QG + (16 * it4 + fr) * RP + 16 * t + 4 * fq);
                    u32x2 o; o.x = pk2(bflo(qg.x) - acc[0], bfhi(qg.x) - acc[1]); o.y = pk2(bflo(qg.y) - acc[2], bfhi(qg.y) - acc[3]);
                    *(u32x2*)(stg + fr * STGP + 16 * tt + 4 * fq) = o;
                }
#pragma unroll
                for (int q = 0; q < 2; ++q) {
                    const int row = (lane >> 3) + 8 * q;
                    const u32x4 v = *(const u32x4*)(stg + row * STGP + (lane & 7) * 8);
                    *(u32x4*)(Qp + (size_t)item * 8192 + (size_t)(16 * it4 + row) * 128 + 64 * hf + (lane & 7) * 8) = v;
                }
#pragma unroll
                for (int tt = 0; tt < 4; ++tt) {
                    const int t = 4 * hf + tt;
                    const bf16x8 a0 = *(const bf16x8*)(UT + (16 * t + fr) * TP + 8 * fq), a1 = *(const bf16x8*)(UT + (16 * t + fr) * TP + 32 + 8 * fq);
                    f32x4 acc = (f32x4){0.f, 0.f, 0.f, 0.f};
                    acc = mfma16(a0, b0, acc); acc = mfma16(a1, b1, acc);
                    u32x2 o; o.x = pk2(acc[0], acc[1]); o.y = pk2(acc[2], acc[3]);
                    *(u32x2*)(stg + fr * STGP + 16 * tt + 4 * fq) = o;
                }
#pragma unroll
                for (int q = 0; q < 2; ++q) {
                    const int row = (lane >> 3) + 8 * q;
                    const u32x4 v = *(const u32x4*)(stg + row * STGP + (lane & 7) * 8);
                    *(u32x4*)(Ol + (size_t)item * 8192 + (size_t)(16 * it4 + row) * 128 + 64 * hf + (lane & 7) * 8) = v;
                }
            }
        }
        __syncthreads();
        item = item_next;
    }
}
#undef DN1_PREFETCH

__device__ void dn2_phase(const Params& P, unsigned char* lds, int bid, int nblk) {
    const int tid = opaque_tid(), wid = tid >> 6, lane = tid & 63, fr = lane & 15, fq = lane >> 4;
    const bf16_t* negM = (const bf16_t*)(P.ws + WS_NEGM); const bf16_t* BmT = (const bf16_t*)P.out;
    const float* egl = (const float*)(P.ws + WS_EGL); bf16_t* SnT = (bf16_t*)(P.ws + WS_SNT);
    constexpr int SP = 136;
    bf16_t* ST = (bf16_t*)lds;
    for (int sid = bid; sid < 256; sid += nblk) {
        const int bh = sid >> 2, sl = sid & 3;
        f32x4 acc[2];
        acc[0] = (f32x4){0.f, 0.f, 0.f, 0.f}; acc[1] = (f32x4){0.f, 0.f, 0.f, 0.f};
        bf16x8 an[4]; u32x2 bmn[2]; float egn;
        {
            const size_t ib = ((size_t)bh * 32) * 16384;
#pragma unroll
            for (int ks = 0; ks < 4; ++ks) an[ks] = *(const bf16x8*)(negM + ib + (size_t)(16 * wid + fr) * 128 + 32 * ks + 8 * fq);
#pragma unroll
            for (int nn = 0; nn < 2; ++nn) bmn[nn] = *(const u32x2*)(BmT + ib + (size_t)(32 * sl + 16 * nn + fr) * 128 + 16 * wid + 4 * fq);
            egn = egl[bh * 32];
        }
        __syncthreads();
#pragma unroll
        for (int nn = 0; nn < 2; ++nn) *(u32x2*)(ST + (16 * nn + fr) * SP + 16 * wid + 4 * fq) = (u32x2){0u, 0u};
        __syncthreads();
        for (int n = 0; n < 32; ++n) {
            const bf16_t* cur = ST + (n & 1) * 32 * SP; bf16_t* nxt = ST + ((n & 1) ^ 1) * 32 * SP;
            const size_t ib = ((size_t)bh * 32 + n) * 16384;
            {
                const int col = tid >> 4, chn = tid & 15;
                *(u32x4*)(SnT + ib + (size_t)(32 * sl + col) * 128 + 8 * chn) = *(const u32x4*)(cur + col * SP + 8 * chn);
            }
            if (n == 31) break;
            bf16x8 a[4]; u32x2 bm[2];
#pragma unroll
            for (int ks = 0; ks < 4; ++ks) a[ks] = an[ks];
            bm[0] = bmn[0]; bm[1] = bmn[1];
            const float eg = egn;
            if (n + 1 < 31) {
                const size_t ib2 = ib + 16384;
#pragma unroll
                for (int ks = 0; ks < 4; ++ks) an[ks] = *(const bf16x8*)(negM + ib2 + (size_t)(16 * wid + fr) * 128 + 32 * ks + 8 * fq);
#pragma unroll
                for (int nn = 0; nn < 2; ++nn) bmn[nn] = *(const u32x2*)(BmT + ib2 + (size_t)(32 * sl + 16 * nn + fr) * 128 + 16 * wid + 4 * fq);
                egn = egl[bh * 32 + n + 1];
            }
#pragma unroll
            for (int nn = 0; nn < 2; ++nn) {
                acc[nn][0] = eg * acc[nn][0] + bflo(bm[nn].x); acc[nn][1] = eg * acc[nn][1] + bfhi(bm[nn].x);
                acc[nn][2] = eg * acc[nn][2] + bflo(bm[nn].y); acc[nn][3] = eg * acc[nn][3] + bfhi(bm[nn].y);
#pragma unroll
                for (int ks = 0; ks < 4; ++ks) {
                    const bf16x8 sb = *(const bf16x8*)(cur + (16 * nn + fr) * SP + 32 * ks + 8 * fq);
                    acc[nn] = mfma16(a[ks], sb, acc[nn]);
                }
                u32x2 o; o.x = pk2(acc[nn][0], acc[nn][1]); o.y = pk2(acc[nn][2], acc[nn][3]);
                *(u32x2*)(nxt + (16 * nn + fr) * SP + 16 * wid + 4 * fq) = o;
            }
            __syncthreads();
        }
    }
}

__device__ void dn3_phase(const Params& P, unsigned char* lds, int bid, int nblk) {
    const int tid = opaque_tid(), wid = tid >> 6, lane = tid & 63, fr = lane & 15, fq = lane >> 4;
    const bf16_t* SnT = (const bf16_t*)(P.ws + WS_SNT); const bf16_t* Qp = (const bf16_t*)(P.ws + WS_QP); const bf16_t* Ol = (const bf16_t*)(P.ws + WS_OL);
    const bf16_t* pb = (const bf16_t*)(P.ws + WS_PB); bf16_t* mix = (bf16_t*)(P.ws + WS_H);
    constexpr int SP3 = 136, SBUF = 128 * SP3 * 2;
    static_assert(4 * SBUF <= LDS_BYTES - 32, "dn3 staging");
    const int half = wid >> 2, q4 = wid & 3, th = tid & 255;
    struct Ops { u32x4 sv[8]; bf16x8 bq[4]; u32x2 olv[8], zv[8]; };
    auto loadOps = [&](int it2, Ops& o) {
        const int item = it2 * 2 + half;
        const int n = item & 31, bh = item >> 5, h = bh & 3, b = bh >> 2;
        const int i = 16 * q4 + fr;
        const bf16_t* sb = SnT + (size_t)item * 16384;
#pragma unroll
        for (int k = 0; k < 8; ++k) o.sv[k] = *(const u32x4*)(sb + (size_t)(th + 256 * k) * 8);
        const bf16_t* qrow = Qp + (size_t)item * 8192 + (size_t)i * 128;
#pragma unroll
        for (int ks = 0; ks < 4; ++ks) o.bq[ks] = *(const bf16x8*)(qrow + 32 * ks + 8 * fq);
        const bf16_t* olr = Ol + (size_t)item * 8192 + (size_t)i * 128;
        const size_t tok = (size_t)b * SEQ + n * 64 + i;
#pragma unroll
        for (int dt = 0; dt < 8; ++dt) { o.olv[dt] = *(const u32x2*)(olr + 16 * dt + 4 * fq); o.zv[dt] = *(const u32x2*)(pb + tok * PBW + 1536 + h * 128 + 16 * dt + 4 * fq); }
    };
    Ops cur;
    if (bid < 1024) loadOps(bid, cur);
    int par = 0;
    for (int it2 = bid; it2 < 1024; it2 += nblk, par ^= 1) {
        const int item = it2 * 2 + half;
        const int n = item & 31, bh = item >> 5, h = bh & 3, b = bh >> 2;
        const int i = 16 * q4 + fr;
        const size_t tok = (size_t)b * SEQ + n * 64 + i;
        unsigned char* SB = lds + (par * 2 + half) * SBUF;
#pragma unroll
        for (int k = 0; k < 8; ++k) { const int piece = th + 256 * k; *(u32x4*)(SB + (piece >> 4) * (SP3 * 2) + (piece & 15) * 16) = cur.sv[k]; }
        bf16x8 bq[4]; u32x2 olv[8], zv[8];
#pragma unroll
        for (int ks = 0; ks < 4; ++ks) bq[ks] = cur.bq[ks];
#pragma unroll
        for (int dt = 0; dt < 8; ++dt) { olv[dt] = cur.olv[dt]; zv[dt] = cur.zv[dt]; }
        __syncthreads();
        if (it2 + nblk < 1024) loadOps(it2 + nblk, cur);
        __builtin_amdgcn_sched_barrier(0);
        f32x4 acc[8];
#pragma unroll
        for (int dt = 0; dt < 8; ++dt) {
            acc[dt] = (f32x4){bflo(olv[dt].x), bfhi(olv[dt].x), bflo(olv[dt].y), bfhi(olv[dt].y)};
#pragma unroll
            for (int ks = 0; ks < 4; ++ks) { const bf16x8 a = *(const bf16x8*)(SB + (16 * dt + fr) * (SP3 * 2) + (32 * ks + 8 * fq) * 2); acc[dt] = mfma16(a, bq[ks], acc[dt]); }
        }
        float ss = 0.f;
#pragma unroll
        for (int dt = 0; dt < 8; ++dt) ss += acc[dt][0] * acc[dt][0] + acc[dt][1] * acc[dt][1] + acc[dt][2] * acc[dt][2] + acc[dt][3] * acc[dt][3];
        ss += __shfl_xor(ss, 16); ss += __shfl_xor(ss, 32);
        const float rstd = rsqrtf(ss * (1.0f / 128.0f) + EPS);
#pragma unroll
        for (int dt = 0; dt < 8; ++dt) {
            const int dv = 16 * dt + 4 * fq;
            const u32x2 z = zv[dt];
            const f32x4 gn = *(const f32x4*)(P.dn_out_gain + dv);
            u32x2 o;
            o.x = pk2(acc[dt][0] * rstd * gn[0] * silu_f(bflo(z.x)), acc[dt][1] * rstd * gn[1] * silu_f(bfhi(z.x)));
            o.y = pk2(acc[dt][2] * rstd * gn[2] * silu_f(bflo(z.y)), acc[dt][3] * rstd * gn[3] * silu_f(bfhi(z.y)));
            *(u32x2*)(mix + tok * DM + 512 + h * 128 + dv) = o;
        }
    }
}

__device__ __forceinline__ void sort16_desc(float (&v)[16]) {
#define CE_(A, B) { const float hi_ = fmaxf(v[A], v[B]), lo_ = fminf(v[A], v[B]); v[A] = hi_; v[B] = lo_; }
    CE_(0,13) CE_(1,12) CE_(2,15) CE_(3,14) CE_(4,8) CE_(5,6) CE_(7,11) CE_(9,10)
    CE_(0,5) CE_(1,7) CE_(2,9) CE_(3,4) CE_(6,13) CE_(8,14) CE_(10,15) CE_(11,12)
    CE_(0,1) CE_(2,3) CE_(4,5) CE_(6,8) CE_(7,9) CE_(10,11) CE_(12,13) CE_(14,15)
    CE_(0,2) CE_(1,3) CE_(4,10) CE_(5,11) CE_(6,7) CE_(8,9) CE_(12,14) CE_(13,15)
    CE_(1,2) CE_(3,12) CE_(4,6) CE_(5,7) CE_(8,10) CE_(9,11) CE_(13,14)
    CE_(1,4) CE_(2,6) CE_(5,8) CE_(7,10) CE_(9,13) CE_(11,14)
    CE_(2,4) CE_(3,6) CE_(9,12) CE_(11,13)
    CE_(3,5) CE_(6,8) CE_(7,9) CE_(10,12)
    CE_(3,4) CE_(5,6) CE_(7,8) CE_(9,10) CE_(11,12)
    CE_(6,7) CE_(8,9)
#undef CE_
}
__device__ __forceinline__ void merge_top16(float (&a)[16], const float (&b)[16]) {
#pragma unroll
    for (int i = 0; i < 16; ++i) a[i] = fmaxf(a[i], b[15 - i]);
#pragma unroll
    for (int j = 8; j > 0; j >>= 1) {
#pragma unroll
        for (int i = 0; i < 16; ++i) {
            const int l = i ^ j;
            if (l > i) { const float hi = fmaxf(a[i], a[l]), lo = fminf(a[i], a[l]); a[i] = hi; a[l] = lo; }
        }
    }
}
__device__ __forceinline__ unsigned lut16(unsigned long long lo, unsigned long long hi, unsigned idx) {
    const unsigned long long w = (idx & 8u) ? hi : lo;
    return (unsigned)(w >> ((idx & 7u) * 8u)) & 127u;
}

__device__ void route_phase(const Params& P, unsigned char* lds, int bid, int nblk) {
    const int tid = opaque_tid(), wid = tid >> 6, lane = tid & 63, l31 = lane & 31, hh = lane >> 5;
    const bf16_t* qry = (const bf16_t*)(P.ws + WS_PB); const bf16_t* skp = (const bf16_t*)(P.ws + WS_SK);
    {
#pragma unroll
        for (int i = 0; i < 8; ++i) {
            const int f = wid * 8 + i, p = f >> 5, kt = (f >> 3) & 3, ks = f & 7;
            const u32x4 v = *(const u32x4*)(skp + p * 16384 + (32 * kt + l31) * 128 + 16 * ks + 8 * hh);
            *(u32x4*)(lds + f * 1024 + lane * 16) = v;
        }
        __syncthreads();
    }
    for (int wi = bid * 8 + wid; wi < 1024 * 8; wi += nblk * 8) {
        const int tg = wi >> 3, hd = wi & 7;
        const int tok = tg * 32 + l31;
        const bf16_t* qrow = qry + (size_t)tok * 2048 + hd * 256;
        float top[2][16];
        float ssq = 0.f;
        bf16x8 bq[2][8];
#pragma unroll
        for (int p = 0; p < 2; ++p)
#pragma unroll
            for (int ks = 0; ks < 8; ++ks) {
                bq[p][ks] = *(const bf16x8*)(qrow + 128 * p + 16 * ks + 8 * hh);
                const u32x4 u = __builtin_bit_cast(u32x4, bq[p][ks]);
                ssq += bflo(u.x) * bflo(u.x) + bfhi(u.x) * bfhi(u.x) + bflo(u.y) * bflo(u.y) + bfhi(u.y) * bfhi(u.y) + bflo(u.z) * bflo(u.z) + bfhi(u.z) * bfhi(u.z) +
                       bflo(u.w) * bflo(u.w) + bfhi(u.w) * bfhi(u.w);
            }
        ssq += __shfl_xor(ssq, 32);
        const float rstd = rsqrtf(ssq * (1.0f / 256.0f) + EPS);
#pragma unroll
        for (int p = 0; p < 2; ++p) {
            float run[16];
#pragma unroll
            for (int kt = 0; kt < 4; ++kt) {
                __builtin_amdgcn_sched_barrier(0);
                f32x16 s;
#pragma unroll
                for (int r = 0; r < 16; ++r) s[r] = 0.f;
#pragma unroll
                for (int ks = 0; ks < 8; ++ks) { const bf16x8 a = *(const bf16x8*)(lds + ((p * 4 + kt) * 8 + ks) * 1024 + lane * 16); s = mfma32(a, bq[p][ks], s); }
                float cur[16];
#pragma unroll
                for (int r = 0; r < 16; ++r) {
                    const unsigned key = 32 * kt + (r & 3) + 8 * (r >> 2) + 4 * hh;
                    cur[r] = __uint_as_float((__float_as_uint(s[r] * rstd) & ~127u) | key);
                }
                sort16_desc(cur);
                if (kt == 0) {
#pragma unroll
                    for (int r = 0; r < 16; ++r) run[r] = cur[r];
                } else merge_top16(run, cur);
            }
            float oth[16];
#pragma unroll
            for (int r = 0; r < 16; ++r) oth[r] = __shfl_xor(run[r], 32);
            merge_top16(run, oth);
#pragma unroll
            for (int r = 0; r < 16; ++r) top[p][r] = run[r];
        }
        float v1[16], v2[16];
        unsigned long long p1lo = 0ull, p1hi = 0ull, p2lo = 0ull, p2hi = 0ull;
#pragma unroll
        for (int r = 0; r < 16; ++r) {
            const unsigned u1 = __float_as_uint(top[0][r]), u2 = __float_as_uint(top[1][r]);
            v1[r] = __uint_as_float(u1 & ~127u); v2[r] = __uint_as_float(u2 & ~127u);
            if (r < 8) { p1lo |= (unsigned long long)(u1 & 127u) << (8 * r); p2lo |= (unsigned long long)(u2 & 127u) << (8 * r); }
            else { p1hi |= (unsigned long long)(u1 & 127u) << (8 * (r - 8)); p2hi |= (unsigned long long)(u2 & 127u) << (8 * (r - 8)); }
        }
#define CAND(a, b) __uint_as_float((__float_as_uint(v1[a] + v2[b]) & ~255u) | (unsigned)((a) * 16 + (b)))
        const float NEG = -3.0e38f;
        float g0[16], g1[16], g2[16], g3[16];
#pragma unroll
        for (int r = 0; r < 16; ++r) g0[r] = CAND(0, r);
        g1[0] = CAND(1, 0); g1[1] = CAND(1, 1); g1[2] = CAND(1, 2); g1[3] = CAND(1, 3); g1[4] = CAND(1, 4); g1[5] = CAND(1, 5); g1[6] = CAND(1, 6); g1[7] = CAND(1, 7);
        g1[8] = CAND(2, 0); g1[9] = CAND(2, 1); g1[10] = CAND(2, 2); g1[11] = CAND(2, 3); g1[12] = CAND(2, 4); g1[13] = CAND(4, 0); g1[14] = CAND(4, 1); g1[15] = CAND(4, 2);
        g2[0] = CAND(3, 0); g2[1] = CAND(3, 1); g2[2] = CAND(3, 2); g2[3] = CAND(3, 3); g2[4] = CAND(5, 0); g2[5] = CAND(5, 1); g2[6] = CAND(6, 0); g2[7] = CAND(6, 1);
        g2[8] = CAND(7, 0); g2[9] = CAND(7, 1); g2[10] = CAND(8, 0); g2[11] = CAND(9, 0); g2[12] = CAND(10, 0); g2[13] = CAND(11, 0); g2[14] = CAND(12, 0); g2[15] = CAND(13, 0);
        g3[0] = CAND(14, 0); g3[1] = CAND(15, 0);
#pragma unroll
        for (int r = 2; r < 16; ++r) g3[r] = NEG;
#undef CAND
        sort16_desc(g1); sort16_desc(g2); sort16_desc(g3);
        merge_top16(g0, g1); merge_top16(g2, g3); merge_top16(g0, g2);
        float e[16], es = 0.f; int eid[16];
        const float m0 = __uint_as_float(__float_as_uint(g0[0]) & ~255u);
#pragma unroll
        for (int r = 0; r < 16; ++r) {
            const unsigned u = __float_as_uint(g0[r]);
            const float sv = __uint_as_float(u & ~255u);
            e[r] = __expf(sv - m0); es += e[r];
            const unsigned a = (u >> 4) & 15u, bb = u & 15u;
            eid[r] = (int)(lut16(p1lo, p1hi, a) * 128u + lut16(p2lo, p2hi, bb));
        }
        const float inv = 1.0f / es;
        if (hh == 0) {
            {
                bf16_t* i16 = (bf16_t*)(P.ws + WS_IDS16) + ((size_t)tok * 8 + hd) * 16;
                u32x4 a0, a1;
                a0.x = (unsigned)eid[0] | ((unsigned)eid[1] << 16); a0.y = (unsigned)eid[2] | ((unsigned)eid[3] << 16); a0.z = (unsigned)eid[4] | ((unsigned)eid[5] << 16); a0.w = (unsigned)eid[6] | ((unsigned)eid[7] << 16);
                a1.x = (unsigned)eid[8] | ((unsigned)eid[9] << 16); a1.y = (unsigned)eid[10] | ((unsigned)eid[11] << 16); a1.z = (unsigned)eid[12] | ((unsigned)eid[13] << 16); a1.w = (unsigned)eid[14] | ((unsigned)eid[15] << 16);
                *(u32x4*)i16 = a0; *(u32x4*)(i16 + 8) = a1;
                bf16_t* g16 = (bf16_t*)(P.ws + WS_GATES16) + ((size_t)tok * 8 + hd) * 16;
                u32x4 c0, c1;
                c0.x = pk2(e[0] * inv, e[1] * inv); c0.y = pk2(e[2] * inv, e[3] * inv); c0.z = pk2(e[4] * inv, e[5] * inv); c0.w = pk2(e[6] * inv, e[7] * inv);
                c1.x = pk2(e[8] * inv, e[9] * inv); c1.y = pk2(e[10] * inv, e[11] * inv); c1.z = pk2(e[12] * inv, e[13] * inv); c1.w = pk2(e[14] * inv, e[15] * inv);
                *(u32x4*)g16 = c0; *(u32x4*)(g16 + 8) = c1;
            }
        }
    }
}


#define XL_RANK(j) (3520 + 64 * (j))
struct XLabel { int NL, x, j, nloc; };
__device__ __forceinline__ XLabel xcd_label(const Params& P, const unsigned char* lds, int bid, int nblk) {
    XLabel L;
    L.NL = nblk < 8 ? nblk : 8; L.x = bid % L.NL; L.j = bid / L.NL; L.nloc = (nblk - L.x + L.NL - 1) / L.NL;
    const volatile unsigned* st = (const volatile unsigned*)(lds + LDS_BYTES - 16);
    const unsigned myx = st[2], myr = st[3];
    unsigned* bar = (unsigned*)P.ws;
    unsigned sum = 0u, mine = 0u; bool ok = true;
#pragma unroll
    for (unsigned k = 0; k < 8; ++k) { const unsigned c = __hip_atomic_load(&bar[256 + 64 * k], __ATOMIC_RELAXED, __HIP_MEMORY_SCOPE_AGENT); sum += c; ok = ok && (c > 0u); mine = (k == myx) ? c : mine; }
    if (ok && sum == (unsigned)nblk && myx < 8u && myr < mine) { L.NL = 8; L.x = (int)myx; L.j = (int)myr; L.nloc = (int)mine; }
    L.NL = __builtin_amdgcn_readfirstlane(L.NL); L.x = __builtin_amdgcn_readfirstlane(L.x); L.j = __builtin_amdgcn_readfirstlane(L.j); L.nloc = __builtin_amdgcn_readfirstlane(L.nloc);
    return L;
}

typedef int i32x2 __attribute__((ext_vector_type(2)));
typedef _Float16 f16x2h __attribute__((ext_vector_type(2)));
struct DnIds { u32x4 i0, i1; };
constexpr int DTB = 32;
constexpr int DR_IDS = 0, DR_H = 8192, DN_REGION = 12288;
static_assert(8 * DN_REGION <= LDS_BYTES - 32, "down-pass staging regions");
__device__ void peer_down_phase(const Params& P, unsigned char* lds, int bid, int nblk) {
    const int tid0 = opaque_tid(), wid = __builtin_amdgcn_readfirstlane(tid0 >> 6);
    int lane_v = tid0 & 63;
    const signed char* ed8 = (const signed char*)(P.ws + WS_ED8); const signed char* h8 = (const signed char*)(P.ws + WS_H8);
    const bf16_t* ids16 = (const bf16_t*)(P.ws + WS_IDS16); int* part = (int*)(P.ws + WS_PART);
    const XLabel XL = xcd_label(P, lds, bid, nblk);
    const int NL = XL.NL, x = XL.x, j = XL.j, nloc = XL.nloc;
    const int nw = nloc * 8, widx = j * 8 + wid;
    const int per = (((NTOK + nw - 1) / nw) + DTB - 1) / DTB * DTB;
    const int t0 = widx * per, t1 = (t0 + per) < NTOK ? (t0 + per) : NTOK;
    if (t0 >= t1) return;
    unsigned char* R = lds + wid * DN_REGION;
    for (int s = x; s < 8; s += NL) {
        asm volatile("" : "+v"(lane_v));
        const int lane = lane_v, e = lane >> 3, ch = lane & 7;
        const bool c0 = (lane & 1) != 0, c1 = (lane & 2) != 0, c2 = (lane & 4) != 0;
        auto issueH = [&](u32x4 (&S)[8], const DnIds& c, const int hf) {
            const signed char* base = ed8 + (size_t)s * NEXP * 128 + 16 * ch;
#pragma unroll
            for (int b = 0; b < 8; ++b) {
                const unsigned word = hf ? c.i1[b >> 1] : c.i0[b >> 1];
                const unsigned id = (b & 1) ? (word >> 16) : (word & 0xffffu);
                S[b] = *(const u32x4*)(base + (size_t)id * 128);
            }
        };
        auto computeH = [&](const u32x4 (&S)[8], const u32x4& h, int (&d)[16], const int hf) {
#pragma unroll
            for (int b = 0; b < 8; ++b) {
                int t = 0;
                t = __builtin_amdgcn_sdot4((int)S[b].x, (int)h.x, t, false); t = __builtin_amdgcn_sdot4((int)S[b].y, (int)h.y, t, false);
                t = __builtin_amdgcn_sdot4((int)S[b].z, (int)h.z, t, false); t = __builtin_amdgcn_sdot4((int)S[b].w, (int)h.w, t, false);
                const int bb = 8 * hf + b;
                d[(bb >> 1) + 8 * (bb & 1)] = t;
            }
        };
        int nbn = DTB - 4 * wid;
        for (int blk = t0, nb; blk < t1; blk += nb, nbn = DTB) {
            nb = nbn;
            nb = (t1 - blk) < nb ? (t1 - blk) : nb;
            {
                u32x4 st[12];
                const char* gi = (const char*)ids16 + (size_t)blk * 256 + lane * 16;
#pragma unroll
                for (int k = 0; k < 8; ++k) st[k] = *(const u32x4*)(gi + k * 1024);
                const char* gh = (const char*)h8 + ((size_t)(blk + (lane >> 3)) * DM + 128 * s) + (lane & 7) * 16;
#pragma unroll
                for (int k = 0; k < 4; ++k) st[8 + k] = *(const u32x4*)(gh + (size_t)k * 8 * DM);
                unsigned char* Rl = R + lane * 16;
#pragma unroll
                for (int k = 0; k < 8; ++k) *(u32x4*)(Rl + DR_IDS + k * 1024) = st[k];
#pragma unroll
                for (int k = 0; k < 4; ++k) *(u32x4*)(Rl + DR_H + k * 1024) = st[8 + k];
            }
            auto ldsIds = [&](int tt) -> DnIds { const u32x4* p = (const u32x4*)(R + DR_IDS + tt * 256 + 32 * e); DnIds c; c.i0 = p[0]; c.i1 = p[1]; return c; };
            u32x4 HA[8], HB[8];
            {
                const DnIds ic = ldsIds(0);
                issueH(HA, ic, 0); __builtin_amdgcn_sched_barrier(0); issueH(HB, ic, 1);
                __builtin_amdgcn_sched_barrier(0);
            }
            auto iter = [&](const int tt, auto moreTag) {
                constexpr bool more = decltype(moreTag)::value;
                const DnIds inx = ldsIds(more ? tt + 1 : tt);
                const u32x4 hreg = *(const u32x4*)(R + DR_H + tt * 128 + 16 * ch);
                int d[16];
                computeH(HA, hreg, d, 0); __builtin_amdgcn_sched_barrier(0); if constexpr (more) issueH(HA, inx, 0); __builtin_amdgcn_sched_barrier(0);
                computeH(HB, hreg, d, 1); __builtin_amdgcn_sched_barrier(0); if constexpr (more) issueH(HB, inx, 1); __builtin_amdgcn_sched_barrier(0);
                int e8[8], f4[4], g2[2];
#pragma unroll
                for (int q = 0; q < 8; ++q) { const int keep = c0 ? d[2 * q + 1] : d[2 * q], send = c0 ? d[2 * q] : d[2 * q + 1]; e8[q] = keep + __shfl_xor(send, 1); }
#pragma unroll
                for (int q = 0; q < 4; ++q) { const int keep = c1 ? e8[2 * q + 1] : e8[2 * q], send = c1 ? e8[2 * q] : e8[2 * q + 1]; f4[q] = keep + __shfl_xor(send, 2); }
#pragma unroll
                for (int q = 0; q < 2; ++q) { const int keep = c2 ? f4[2 * q + 1] : f4[2 * q], send = c2 ? f4[2 * q] : f4[2 * q + 1]; g2[q] = keep + __shfl_xor(send, 4); }
                const auto pk = __builtin_amdgcn_cvt_pkrtz((float)g2[0] * 0.015625f, (float)g2[1] * 0.015625f);
                *(unsigned*)(part + ((size_t)s * NTOK + (size_t)(blk + tt)) * 64 + 8 * e + ch) = __builtin_bit_cast(unsigned, pk);
            };
            for (int tt = 0; tt + 1 < nb; ++tt) iter(tt, std::true_type{});
            iter(nb - 1, std::false_type{});
        }
    }
}

__device__ __forceinline__ float gelu_erf(float v) {
    const float av = fabsf(v), t = __builtin_amdgcn_rcpf(av * 0.2316418882f + 1.0f);
    float q = t * 0.5307027145f + (-0.7265760135f); q = q * t + 0.7107068705f; q = q * t + (-0.142248368f); q = q * t + 0.127414796f; q = q * t;
    const float ex = __builtin_amdgcn_exp2f(v * v * (-0.72134752044f));
    const float m = v * (q * ex);
    return v < 0.f ? m : v - m;
}
__device__ void peer_combine_phase(const Params& P, unsigned char* lds, int bid, int nblk) {
    const int tid = opaque_tid(), wid = tid >> 6, lane = tid & 63;
    const int* part = (const int*)(P.ws + WS_PART);
    const float* SD = (const float*)(P.ws + WS_SD); const float* SU = (const float*)(P.ws + WS_SU); const float* HS = (const float*)(P.ws + WS_HS);
    const unsigned* ids16 = (const unsigned*)(P.ws + WS_IDS16); const unsigned* gates16 = (const unsigned*)(P.ws + WS_GATES16);
    unsigned short* wq = (unsigned short*)(P.ws + WS_WQ8); float* wsc = (float*)(P.ws + WS_WSC);
    static_assert(2 * NEXP * 4 <= LDS_BYTES - 32, "combine tables");
    float* sdL = (float*)lds; float* suL = sdL + NEXP;
    {
#pragma unroll
        for (int k = 0; k < 8; ++k) { const int o = (tid + 512 * k) * 4; *(f32x4*)(sdL + o) = *(const f32x4*)(SD + o); *(f32x4*)(suL + o) = *(const f32x4*)(SU + o); }
        __syncthreads();
    }
    constexpr int CU_ = 4;
    const int tstep = nblk * 8;
    for (int tok0 = bid * 8 + wid; tok0 < NTOK; tok0 += CU_ * tstep) {
        unsigned pv[CU_][8]; unsigned idp[CU_], gtp[CU_]; float hs[CU_]; int tk[CU_];
#pragma unroll
        for (int u = 0; u < CU_; ++u) {
            const int t = tok0 + u * tstep; tk[u] = t < NTOK ? t : tok0;
#pragma unroll
            for (int s = 0; s < 8; ++s) pv[u][s] = *(const unsigned*)(part + ((size_t)s * NTOK + tk[u]) * 64 + lane);
            idp[u] = ids16[(size_t)tk[u] * 64 + lane]; gtp[u] = gates16[(size_t)tk[u] * 64 + lane]; hs[u] = HS[tk[u]];
        }
        __builtin_amdgcn_sched_barrier(0);
        float sd0[CU_], sd1[CU_], su0[CU_], su1[CU_];
#pragma unroll
        for (int u = 0; u < CU_; ++u) { const unsigned id0 = idp[u] & 0xffffu, id1 = idp[u] >> 16; sd0[u] = sdL[id0]; sd1[u] = sdL[id1]; su0[u] = suL[id0]; su1[u] = suL[id1]; }
        __builtin_amdgcn_sched_barrier(0);
#pragma unroll
        for (int u = 0; u < CU_; ++u) {
            float a0 = 0.f, a1 = 0.f;
#pragma unroll
            for (int s = 0; s < 8; ++s) { const f16x2h hv = __builtin_bit_cast(f16x2h, pv[u][s]); a0 += (float)hv[0]; a1 += (float)hv[1]; }
            const float f0 = a0 * 64.0f * sd0[u] * hs[u], f1 = a1 * 64.0f * sd1[u] * hs[u];
            const float w0 = bflo(gtp[u]) * gelu_erf(f0) * su0[u], w1 = bfhi(gtp[u]) * gelu_erf(f1) * su1[u];
            float am = fmaxf(fabsf(w0), fabsf(w1));
            am = fmaxf(am, __shfl_xor(am, 1)); am = fmaxf(am, __shfl_xor(am, 2)); am = fmaxf(am, __shfl_xor(am, 4)); am = fmaxf(am, __shfl_xor(am, 16)); am = fmaxf(am, __shfl_xor(am, 32));
            am = am > 0.f ? am : 1.0f;
            const float inv = 127.0f / am;
            const int q0 = (int)rintf(w0 * inv), q1 = (int)rintf(w1 * inv);
            wq[(size_t)tk[u] * 64 + lane] = (unsigned short)((unsigned)(q0 & 255) | ((unsigned)(q1 & 255) << 8));
            if ((lane & 0x37) == 0) wsc[(size_t)tk[u] * 2 + (lane >> 3)] = am * (1.0f / 127.0f);
        }
    }
}

typedef float f32x2 __attribute__((ext_vector_type(2)));
typedef int i32x4 __attribute__((ext_vector_type(4)));
struct UpIds { u32x4 i0, i1; };
constexpr int UTB = 16;
constexpr int UR_IDS = 0, UR_WQ = 4096, UR_X = 6144, UR_DL = 14336, UR_SC = 18432, UP_REGION = 18560;
static_assert(8 * UP_REGION <= LDS_BYTES - 32, "up-pass staging regions");
__device__ void peer_up_phase(const Params& P, unsigned char* lds, int bid, int nblk) {
    const int tid0 = opaque_tid(), wid = __builtin_amdgcn_readfirstlane(tid0 >> 6);
    int lane_v = tid0 & 63;
    const signed char* eu8 = (const signed char*)(P.ws + WS_EU8);
    const bf16_t* dlt = (const bf16_t*)(P.ws + WS_DLT);
    const bf16_t* ids16 = (const bf16_t*)(P.ws + WS_IDS16); const signed char* wq8 = (const signed char*)(P.ws + WS_WQ8); const float* wsc = (const float*)(P.ws + WS_WSC);
    const float* mod = (const float*)(P.ws + WS_MOD);
    const XLabel XL = xcd_label(P, lds, bid, nblk);
    const int NL = XL.NL, x = XL.x, j = XL.j, nloc = XL.nloc;
    const int nw = nloc * 8, widx = j * 8 + wid;
    const int per = (((NTOK + nw - 1) / nw) + UTB - 1) / UTB * UTB;
    const int t0 = widx * per, t1 = (t0 + per) < NTOK ? (t0 + per) : NTOK;
    if (t0 >= t1) return;
    unsigned char* R = lds + wid * UP_REGION;
    for (int s = x; s < 8; s += NL) {
        asm volatile("" : "+v"(lane_v));
        const int lane = lane_v, e = lane >> 3, ch = lane & 7;
        const bool hi = (lane & 8) != 0;
        const int colp = 16 * ch + 4 * (lane >> 4) + (hi ? 2 : 0), col = 128 * s + colp;
        unsigned mk[4];
#pragma unroll
        for (int r = 0; r < 4; ++r) mk[r] = (((lane & 15) >> 2) == r) ? (0xFFu << (8 * (lane & 3))) : 0u;
        auto issueH = [&](u32x4 (&S)[8], const UpIds& c, const int hf) {
            const signed char* base = eu8 + (size_t)s * NEXP * 128 + 16 * ch;
#pragma unroll
            for (int b = 0; b < 8; ++b) {
                const unsigned word = hf ? c.i1[b >> 1] : c.i0[b >> 1];
                const unsigned id = (b & 1) ? (word >> 16) : (word & 0xffffu);
                S[b] = *(const u32x4*)(base + (size_t)id * 128);
            }
        };
        auto computeH = [&](const u32x4 (&S)[8], const u32x4& wa, const u32x4& wb, i32x4& acc0, i32x4& acc1, const int hf) {
#pragma unroll
            for (int b = 0; b < 8; ++b) {
                const int bb = 8 * hf + b;
                const unsigned sel = 0x01010101u * (unsigned)(bb & 3);
                const unsigned r0 = __builtin_amdgcn_perm(wa[bb >> 2], wa[bb >> 2], sel), r1 = __builtin_amdgcn_perm(wb[bb >> 2], wb[bb >> 2], sel);
                const i32x4 A0 = {(int)(r0 & mk[0]), (int)(r0 & mk[1]), (int)(r0 & mk[2]), (int)(r0 & mk[3])};
                const i32x4 A1 = {(int)(r1 & mk[0]), (int)(r1 & mk[1]), (int)(r1 & mk[2]), (int)(r1 & mk[3])};
                const i32x4 Bv = {(int)S[b].x, (int)S[b].y, (int)S[b].z, (int)S[b].w};
                acc0 = __builtin_amdgcn_mfma_i32_16x16x64_i8(A0, Bv, acc0, 0, 0, 0);
                acc1 = __builtin_amdgcn_mfma_i32_16x16x64_i8(A1, Bv, acc1, 0, 0, 0);
            }
        };
        int nbn = UTB - 2 * wid;
        for (int blk = t0, nb; blk < t1; blk += nb, nbn = UTB) {
            nb = nbn;
            nb = (t1 - blk) < nb ? (t1 - blk) : nb;
            nb = (2048 - (blk & 2047)) < nb ? (2048 - (blk & 2047)) : nb;
            {
                u32x4 st[18];
                const u32x4 stsc = *(const u32x4*)((const char*)wsc + (size_t)blk * 8 + (lane & 7) * 16);
                const char* gi = (const char*)ids16 + (size_t)blk * 256 + lane * 16;
#pragma unroll
                for (int k = 0; k < 4; ++k) st[k] = *(const u32x4*)(gi + k * 1024);
                const char* gw = (const char*)wq8 + (size_t)blk * 128 + lane * 16;
#pragma unroll
                for (int k = 0; k < 2; ++k) st[4 + k] = *(const u32x4*)(gw + k * 1024);
                const char* gx = (const char*)P.x + (size_t)(128 * s) * 4 + (lane & 31) * 16;
#pragma unroll
                for (int k = 0; k < 8; ++k) { int tx = blk + 2 * k + (lane >> 5); tx = tx < NTOK ? tx : NTOK - 1; st[6 + k] = *(const u32x4*)(gx + (size_t)tx * DM * 4); }
                const char* gd = (const char*)dlt + ((size_t)(blk + (lane >> 4)) * DM + 128 * s) * 2 + (lane & 15) * 16;
#pragma unroll
                for (int k = 0; k < 4; ++k) st[14 + k] = *(const u32x4*)(gd + (size_t)k * 4 * DM * 2);
                unsigned char* Rl = R + lane * 16;
#pragma unroll
                for (int k = 0; k < 4; ++k) *(u32x4*)(Rl + UR_IDS + k * 1024) = st[k];
#pragma unroll
                for (int k = 0; k < 2; ++k) *(u32x4*)(Rl + UR_WQ + k * 1024) = st[4 + k];
#pragma unroll
                for (int k = 0; k < 8; ++k) *(u32x4*)(Rl + UR_X + k * 1024) = st[6 + k];
#pragma unroll
                for (int k = 0; k < 4; ++k) *(u32x4*)(Rl + UR_DL + k * 1024) = st[14 + k];
                if (lane < 8) *(u32x4*)(Rl + UR_SC) = stsc;
            }
            const f32x2 g2 = *(const f32x2*)(mod + (blk >> 11) * 6144 + 5120 + col);
            auto ldsIds = [&](int tt) -> UpIds { const u32x4* p = (const u32x4*)(R + UR_IDS + tt * 256 + 32 * e); UpIds c; c.i0 = p[0]; c.i1 = p[1]; return c; };
            u32x4 HA[8], HB[8];
            {
                const UpIds ic = ldsIds(0);
                issueH(HA, ic, 0); __builtin_amdgcn_sched_barrier(0); issueH(HB, ic, 1);
                __builtin_amdgcn_sched_barrier(0);
            }
            auto iter = [&](const int tt, auto moreTag) {
                constexpr bool more = decltype(moreTag)::value;
                const UpIds inx = ldsIds(more ? tt + 1 : tt);
                const u32x4* wp = (const u32x4*)(R + UR_WQ + tt * 128 + 32 * (lane >> 4));
                const u32x4 w0 = wp[0], w1 = wp[1];
                const f32x2 xv = *(const f32x2*)(R + UR_X + tt * 512 + 4 * colp); const unsigned dv = *(const unsigned*)(R + UR_DL + tt * 256 + 2 * colp);
                const float scl = *(const float*)(R + UR_SC + tt * 8 + (hi ? 4 : 0));
                i32x4 acc0 = {0, 0, 0, 0}, acc1 = {0, 0, 0, 0};
                computeH(HA, w0, w1, acc0, acc1, 0); __builtin_amdgcn_sched_barrier(0); if constexpr (more) issueH(HA, inx, 0); __builtin_amdgcn_sched_barrier(0);
                computeH(HB, w0, w1, acc0, acc1, 1); __builtin_amdgcn_sched_barrier(0); if constexpr (more) issueH(HB, inx, 1); __builtin_amdgcn_sched_barrier(0);
                {
                    float v[4];
#pragma unroll
                    for (int r = 0; r < 4; ++r) v[r] = (float)(hi ? acc1[r] : acc0[r]) * scl;
                    const float k0 = hi ? v[2] : v[0], k1 = hi ? v[3] : v[1], s0 = hi ? v[0] : v[2], s1 = hi ? v[1] : v[3];
                    const float y0 = k0 + __shfl_xor(s0, 8), y1 = k1 + __shfl_xor(s1, 8);
                    f32x2 o; o[0] = xv[0] + bflo(dv) + g2[0] * y0; o[1] = xv[1] + bfhi(dv) + g2[1] * y1;
                    *(f32x2*)(P.out + (size_t)(blk + tt) * DM + col) = o;
                }
            };
            for (int tt = 0; tt + 1 < nb; ++tt) iter(tt, std::true_type{});
            iter(nb - 1, std::false_type{});
        }
    }
}

#define XB_TMO      128
#define XB_XCNT(j)  (256  + 64 * (j))
#define XB_XSUB(j)  (1280 + 64 * (j))
#define XB_XGEN(j)  (2304 + 64 * (j))
#define XB_TOP      3328
#define XB_TOPGEN   3392
#define XCD_BAR_WORDS 3456
#define XB_SPIN_CAP (1u << 23)
__device__ __forceinline__ unsigned xb_ld(unsigned* p)              { return __hip_atomic_load(p, __ATOMIC_RELAXED, __HIP_MEMORY_SCOPE_AGENT); }
__device__ __forceinline__ unsigned xb_add(unsigned* p, unsigned v) { return __hip_atomic_fetch_add(p, v, __ATOMIC_RELAXED, __HIP_MEMORY_SCOPE_AGENT); }
__device__ __forceinline__ unsigned xb_xcc_id() { return (unsigned)__builtin_amdgcn_s_getreg((3 << 11) | 20) & 0xFu; }
#define XB_SPIN(cond, bar) do { unsigned _sp = 0; while (cond) { __builtin_amdgcn_s_sleep(1); \
    if ((++_sp & 255u) == 0u) { if (xb_ld(&(bar)[XB_TMO])) break; if (_sp > XB_SPIN_CAP) { atomicAdd(&(bar)[XB_TMO], 1u); break; } } } } while (0)
struct XcdBarrier { unsigned* bar; unsigned x; volatile unsigned* st; };
__device__ __forceinline__ XcdBarrier xcd_barrier_post(unsigned* bar, volatile unsigned* st) {
    XcdBarrier b; b.bar = bar; b.x = xb_xcc_id(); b.st = st;
    if (threadIdx.x == 0) (void)xb_add(&bar[XB_XCNT(b.x)], 1u);
    return b;
}
__device__ __forceinline__ void xcd_barrier_complete(unsigned* bar, unsigned x, unsigned& nloc, unsigned& nx) {
    const unsigned G = gridDim.x * gridDim.y * gridDim.z;
    unsigned sum, cnt, mine, sp = 0u;
    for (;;) {
        sum = 0u; cnt = 0u; mine = 0u;
#pragma unroll
        for (unsigned j = 0; j < 16; ++j) { const unsigned c = xb_ld(&bar[XB_XCNT(j)]); sum += c; cnt += (c > 0u) ? 1u : 0u; mine = (j == x) ? c : mine; }
        if (sum == G) break;
        __builtin_amdgcn_s_sleep(1);
        if ((++sp & 255u) == 0u) { if (xb_ld(&bar[XB_TMO])) break; if (sp > XB_SPIN_CAP) { atomicAdd(&bar[XB_TMO], 1u); break; } }
    }
    nloc = mine > 0u ? mine : 1u; nx = cnt > 0u ? cnt : 1u;
}
__device__ __forceinline__ void xcd_barrier(const XcdBarrier& b) {
    asm volatile("s_waitcnt vmcnt(0)" ::: "memory");
    __syncthreads();
    if (threadIdx.x == 0) {
        unsigned* bar = b.bar;
        __builtin_amdgcn_s_waitcnt(0);
        unsigned nloc = b.st[0], nx = b.st[1];
        if (nloc == 0u) { xcd_barrier_complete(bar, b.x, nloc, nx); b.st[0] = nloc; b.st[1] = nx; }
        const unsigned old = xb_add(&bar[XB_XSUB(b.x)], 1u);
        const unsigned gen = old / nloc;
        if (old + 1u == (gen + 1u) * nloc) {
            __builtin_amdgcn_fence(__ATOMIC_RELEASE, "agent");
            asm volatile("s_waitcnt vmcnt(0)" ::: "memory");
            const unsigned og = xb_add(&bar[XB_TOP], 1u);
            const unsigned tg = og / nx;
            if (og + 1u == (tg + 1u) * nx) xb_add(&bar[XB_TOPGEN], 1u);
            else XB_SPIN(xb_ld(&bar[XB_TOPGEN]) == tg, bar);
            __builtin_amdgcn_fence(__ATOMIC_ACQUIRE, "agent");
            xb_add(&bar[XB_XGEN(b.x)], 1u);
            asm volatile("s_waitcnt vmcnt(0)" ::: "memory");
        } else {
            XB_SPIN(xb_ld(&bar[XB_XGEN(b.x)]) == gen, bar);
            __builtin_amdgcn_fence(__ATOMIC_ACQUIRE, "agent");
            asm volatile("s_waitcnt vmcnt(0)" ::: "memory");
        }
    }
    __syncthreads();
}

constexpr int NPHASES = 11;
__device__ __forceinline__ void run_phase(const Params& P, int ph, unsigned char* lds, int bid, int nblk) {
    const float* mod = (const float*)(P.ws + WS_MOD);
    switch (ph) {
        case 0: phase0(P, lds, bid, nblk); break;
        case 1: norm_mod_phase<true, false>(P, P.x, nullptr, nullptr, P.norm1_gain, mod, 0, 1024, (bf16_t*)(P.ws + WS_H), bid, nblk); break;
        case 2: {
            const bf16_t* h1 = (const bf16_t*)(P.ws + WS_H); const bf16_t* wt = (const bf16_t*)(P.ws + WS_WINT);
            EpiInAll e{EpiQK{P.q_gain, P.k_gain, (bf16_t*)(P.ws + WS_QA), (bf16_t*)(P.ws + WS_KA)}, EpiV{(bf16_t*)(P.ws + WS_VT)}, EpiBf{(bf16_t*)(P.ws + WS_PB), PBW}};
            gemm_run(h1, wt, NTOK, 3584, DM, e, lds, bid, nblk);
        } break;
        case 3: attn_phase(P, lds, bid, nblk); __syncthreads(); dn1_phase(P, lds, bid, nblk); break;
        case 4: dn2_phase(P, lds, bid, nblk); break;
        case 5: dn3_phase(P, lds, bid, nblk); break;
        case 6: {
            EpiOut e{mod, (bf16_t*)(P.ws + WS_DLT)};
            gemm_run((const bf16_t*)(P.ws + WS_H), (const bf16_t*)(P.ws + WS_WOUTT), NTOK, DM, DM, e, lds, bid, nblk);
        } break;
        case 7: norm_mod_phase<false, true>(P, P.x, (const bf16_t*)(P.ws + WS_DLT), P.out, P.norm2_gain, mod, 3072, 4096, (bf16_t*)(P.ws + WS_H), bid, nblk); break;
        case 8: {
            EpiBf e{(bf16_t*)(P.ws + WS_PB), 2048};
            gemm_run((const bf16_t*)(P.ws + WS_H), (const bf16_t*)(P.ws + WS_WQT), NTOK, 2048, DM, e, lds, bid, nblk);
        } break;
        case 9: route_phase(P, lds, bid, nblk); break;
        case 10: peer_down_phase(P, lds, bid, nblk); break;
        case 12: peer_combine_phase(P, lds, bid, nblk); break;
        case 11: peer_up_phase(P, lds, bid, nblk); break;
        default: break;
    }
}

#if MULTI_LAUNCH
template <int PH>
__global__ void __launch_bounds__(NTHREADS) k_phase(Params P) {
    __shared__ __attribute__((aligned(16))) unsigned char lds[LDS_BYTES];
    run_phase(P, PH, lds, blockIdx.x, gridDim.x);
}
#else
__global__ void __launch_bounds__(NTHREADS) k_mega(Params P) {
    __shared__ __attribute__((aligned(16))) unsigned char lds[LDS_BYTES];
    cg::grid_group grid = cg::this_grid();
    const int bid = blockIdx.x, nblk = gridDim.x;
    volatile unsigned* st = (volatile unsigned*)(lds + LDS_BYTES - 16);
    if (threadIdx.x == 0) {
        st[0] = 0u; st[1] = 0u;
        const unsigned xcc = xb_xcc_id();
        st[2] = xcc; st[3] = __hip_atomic_fetch_add((unsigned*)P.ws + XL_RANK(xcc & 7u), 1u, __ATOMIC_RELAXED, __HIP_MEMORY_SCOPE_AGENT);
    }
    __syncthreads();
    const XcdBarrier xb = xcd_barrier_post((unsigned*)P.ws, st);
#define PH_(N) run_phase(P, N, lds, bid, nblk)
#define XBAR() xcd_barrier(xb)
    if (P.ws == nullptr) grid.sync();
    PH_(0); XBAR(); PH_(1); XBAR(); PH_(2); XBAR(); PH_(3); XBAR(); PH_(4); XBAR(); PH_(5); XBAR();
    PH_(6); XBAR(); PH_(7); XBAR(); PH_(8); XBAR(); PH_(9); XBAR(); PH_(10); XBAR(); PH_(12); XBAR(); PH_(11);
#undef PH_
#undef XBAR
}
#endif

extern "C" void kernel_launch(void* const* d_in, const int* in_sizes, int n_in, void* d_out, int out_size, void* d_ws, size_t ws_size, hipStream_t stream) {
    static int grid = 0;
    if (grid == 0) {
        if (n_in != 22 || out_size != NTOK * DM || ws_size < WS_END) { fprintf(stderr, "kernel_launch: unexpected shapes (n_in %d out %d ws %zu)\n", n_in, out_size, ws_size); grid = -1; return; }
        int dev = 0, cus = 0, per_cu = 0;
        (void)hipGetDevice(&dev);
        (void)hipDeviceGetAttribute(&cus, hipDeviceAttributeMultiprocessorCount, dev);
#if MULTI_LAUNCH
        (void)hipOccupancyMaxActiveBlocksPerMultiprocessor(&per_cu, k_phase<3>, NTHREADS, 0);
#else
        (void)hipOccupancyMaxActiveBlocksPerMultiprocessor(&per_cu, k_mega, NTHREADS, 0);
#endif
        if (per_cu < 1) { fprintf(stderr, "kernel_launch: occupancy query says %d blocks per CU\n", per_cu); per_cu = 1; }
        grid = cus;
        (void)hipGetLastError();
    }
    if (grid < 0) return;
    Params p{};
    const float** pp = (const float**)&p;
    for (int i = 0; i < 22; ++i) pp[i] = (const float*)d_in[i];
    p.out = (float*)d_out; p.ws = (unsigned char*)d_ws;
#if MULTI_LAUNCH
    (void)hipMemsetAsync(d_ws, 0, 16384, stream);
#define LP_(PH) hipLaunchKernelGGL(k_phase<PH>, dim3(grid), dim3(NTHREADS), 0, stream, p)
    LP_(0); LP_(1); LP_(2); LP_(3); LP_(4); LP_(5); LP_(6); LP_(7); LP_(8); LP_(9); LP_(10); LP_(12); LP_(11);
#undef LP_
#else
    (void)hipMemsetAsync(d_ws, 0, 16384, stream);
    void* args[] = {&p};
    hipError_t e = hipLaunchCooperativeKernel((void*)k_mega, dim3(grid), dim3(NTHREADS), args, 0, stream);
    if (e != hipSuccess) fprintf(stderr, "cooperative launch failed: %s (grid %d)\n", hipGetErrorString(e), grid);
#endif
}
```

```cpp
#include <hip/hip_runtime.h>
#include <hip/hip_cooperative_groups.h>
#include <cstdio>
#include <cstdint>
#include <type_traits>
namespace cg = cooperative_groups;

#ifndef MULTI_LAUNCH
#define MULTI_LAUNCH 0
#endif

typedef unsigned short bf16_t;
typedef short bf16x8 __attribute__((ext_vector_type(8)));
typedef float f32x4 __attribute__((ext_vector_type(4)));
typedef float f32x16 __attribute__((ext_vector_type(16)));
typedef unsigned u32x4 __attribute__((ext_vector_type(4)));
typedef unsigned u32x2 __attribute__((ext_vector_type(2)));
typedef __bf16 bf16x2_t __attribute__((ext_vector_type(2)));

constexpr int NB = 16, SEQ = 2048, DM = 1024, NTOK = NB * SEQ;
constexpr int CH = 64, NCH = SEQ / CH;
constexpr int AH = 8, AHD = 64;
constexpr int DH = 4, DHD = 128;
constexpr int IPW = 3592, NPAD = 3712;
constexpr int PBW = 2048;
constexpr int NEXP = 16384;
constexpr float EPS = 1e-6f;
constexpr int NTHREADS = 512;

constexpr size_t MiB = 1u << 20;
constexpr size_t WS_MOD = 1 * MiB;
constexpr size_t WS_SK = 2 * MiB;
constexpr size_t WS_WINT = 3 * MiB;
constexpr size_t WS_WOUTT = 11 * MiB;
constexpr size_t WS_WQT = 13 * MiB;
constexpr size_t WS_ED8 = 17 * MiB;
constexpr size_t WS_PART = 145 * MiB;
constexpr size_t WS_EU8 = 33 * MiB;
constexpr size_t WS_H8 = 49 * MiB;
constexpr size_t WS_SD = 2 * MiB + 128 * 1024;
constexpr size_t WS_SU = 2 * MiB + 192 * 1024;
constexpr size_t WS_HS = 2 * MiB + 256 * 1024;
constexpr size_t WS_H = 81 * MiB;
constexpr size_t WS_PB = 145 * MiB;
constexpr size_t WS_QA = 273 * MiB;
constexpr size_t WS_KA = 305 * MiB;
constexpr size_t WS_VT = 337 * MiB;
constexpr size_t WS_QP = 369 * MiB;
constexpr size_t WS_OL = 401 * MiB;
constexpr size_t WS_BETA = 433 * MiB;
constexpr size_t WS_G = 433 * MiB + 512 * 1024;
constexpr size_t WS_EGL = 434 * MiB;
constexpr size_t WS_NEGM = 435 * MiB;
constexpr size_t WS_END = 499 * MiB;
constexpr size_t WS_SNT = WS_QA;
constexpr size_t WS_WQ8 = WS_KA;
constexpr size_t WS_WSC = WS_KA + 4 * MiB;
constexpr size_t WS_IDS16 = WS_KA + 8 * MiB;
constexpr size_t WS_DLT = WS_QP;
constexpr size_t WS_GATES16 = WS_KA + 16 * MiB;

struct Params {
    const float *x, *c, *w_ada, *b_ada, *norm1_gain, *w_in, *q_gain, *k_gain, *rel_bias, *attn_out_gain, *conv_w, *a_log, *dt_bias,
        *dn_out_gain, *w_out, *norm2_gain, *w_query, *query_gain, *sk1, *sk2, *e_down, *e_up;
    float* out;
    unsigned char* ws;
};

typedef float f32x2h __attribute__((ext_vector_type(2)));
typedef __bf16 bf16x2h __attribute__((ext_vector_type(2)));
__device__ __forceinline__ unsigned f2bf(float f) { return (unsigned)__builtin_bit_cast(unsigned short, (__bf16)f); }
__device__ __forceinline__ unsigned pk2(float lo, float hi) { const f32x2h v = {lo, hi}; return __builtin_bit_cast(unsigned, __builtin_convertvector(v, bf16x2h)); }
__device__ __forceinline__ float bflo(unsigned u) { return __uint_as_float(u << 16); }
__device__ __forceinline__ float bfhi(unsigned u) { return __uint_as_float(u & 0xffff0000u); }
__device__ __forceinline__ float bf2f(bf16_t v) { return __uint_as_float(((unsigned)v) << 16); }
__device__ __forceinline__ float silu_f(float v) { return v * __builtin_amdgcn_rcpf(1.0f + __expf(-v)); }
__device__ __forceinline__ float dot2bf(unsigned a, unsigned b, float acc) {
    return __builtin_amdgcn_fdot2_f32_bf16(__builtin_bit_cast(bf16x2_t, a), __builtin_bit_cast(bf16x2_t, b), acc, false);
}
__device__ __forceinline__ f32x4 mfma16(bf16x8 a, bf16x8 b, f32x4 c) { return __builtin_amdgcn_mfma_f32_16x16x32_bf16(a, b, c, 0, 0, 0); }
__device__ __forceinline__ f32x16 mfma32(bf16x8 a, bf16x8 b, f32x16 c) { return __builtin_amdgcn_mfma_f32_32x32x16_bf16(a, b, c, 0, 0, 0); }
__device__ __forceinline__ bf16x8 pack8(float a0, float a1, float a2, float a3, float a4, float a5, float a6, float a7) {
    u32x4 u; u.x = pk2(a0, a1); u.y = pk2(a2, a3); u.z = pk2(a4, a5); u.w = pk2(a6, a7); return __builtin_bit_cast(bf16x8, u);
}
__device__ __forceinline__ int opaque_tid() { int t = threadIdx.x; asm volatile("" : "+v"(t)); return t; }
__device__ __forceinline__ int swap23(int v) { return (v & ~12) | ((v & 4) << 1) | ((v & 8) >> 1); }

constexpr int LDS_BYTES = 153600;

__device__ void phase0(const Params& P, unsigned char* lds, int bid, int nblk) {
    const int tid = opaque_tid();
    float* sc = (float*)lds;
    float* red = (float*)(lds + 65536);
    float* tile = (float*)(lds + 98304);
    float* mod = (float*)(P.ws + WS_MOD);
    if (bid < 384) {
        for (int e = tid; e < 16384; e += NTHREADS) { int b = e >> 10, k = e & 1023; float v = P.c[e]; sc[k * 16 + b] = silu_f(v); }
        __syncthreads();
        for (int it = bid; it < 384; it += nblk) {
            const int j0 = it * 16, cl = tid & 15, kg = tid >> 4;
            float acc[16];
#pragma unroll
            for (int b = 0; b < 16; ++b) acc[b] = 0.f;
            for (int i = 0; i < 32; ++i) {
                const int k = kg + 32 * i;
                const float w = P.w_ada[(size_t)k * 6144 + j0 + cl];
                const f32x4* sp = (const f32x4*)(sc + k * 16);
#pragma unroll
                for (int q = 0; q < 4; ++q) { f32x4 s4 = sp[q]; acc[4 * q] += s4[0] * w; acc[4 * q + 1] += s4[1] * w; acc[4 * q + 2] += s4[2] * w; acc[4 * q + 3] += s4[3] * w; }
            }
#pragma unroll
            for (int b = 0; b < 16; ++b) red[(kg * 16 + b) * 16 + cl] = acc[b];
            __syncthreads();
            if (tid < 256) {
                const int b = tid >> 4, c2 = tid & 15; float s = 0.f;
                for (int g = 0; g < 32; ++g) s += red[(g * 16 + b) * 16 + c2];
                mod[b * 6144 + j0 + c2] = s + P.b_ada[j0 + c2];
            }
            __syncthreads();
        }
    }
    for (int it = bid; it < 928 + 256 + 512; it += nblk) {
        const float* src; bf16_t* dst; int N, nt, kt;
        if (it < 928) { src = P.w_in; dst = (bf16_t*)(P.ws + WS_WINT); N = IPW; nt = it % 58; kt = it / 58; }
        else if (it < 928 + 256) { const int r = it - 928; src = P.w_out; dst = (bf16_t*)(P.ws + WS_WOUTT); N = 1024; nt = r % 16; kt = r / 16; }
        else { const int r = it - 1184; src = P.w_query; dst = (bf16_t*)(P.ws + WS_WQT); N = 2048; nt = r % 32; kt = r / 32; }
        const int n0 = nt * 64, k0 = kt * 64;
        {
            const int nl = tid & 63, kb = tid >> 6;
#pragma unroll
            for (int i = 0; i < 8; ++i) { const int kk = kb + 8 * i; const int n = n0 + nl; tile[kk * 65 + nl] = (n < N) ? src[(size_t)(k0 + kk) * N + n] : 0.f; }
        }
        __syncthreads();
        {
            const int kl = (tid & 7) * 8, nl = tid >> 3;
            u32x4 o;
            o.x = pk2(tile[(kl + 0) * 65 + nl], tile[(kl + 1) * 65 + nl]); o.y = pk2(tile[(kl + 2) * 65 + nl], tile[(kl + 3) * 65 + nl]);
            o.z = pk2(tile[(kl + 4) * 65 + nl], tile[(kl + 5) * 65 + nl]); o.w = pk2(tile[(kl + 6) * 65 + nl], tile[(kl + 7) * 65 + nl]);
            *(u32x4*)(dst + (size_t)(n0 + nl) * 1024 + k0 + kl) = o;
        }
        __syncthreads();
    }
    {
        const int lane = tid & 63, wv = tid >> 6;
        for (int row = bid * 8 + wv; row < 2 * NEXP; row += nblk * 8) {
            const bool up = row >= NEXP; const int er = up ? row - NEXP : row;
            const float* src = (up ? P.e_up : P.e_down) + (size_t)er * 1024 + 16 * lane;
            f32x4 v[4]; float am = 0.f;
#pragma unroll
            for (int q = 0; q < 4; ++q) { v[q] = *(const f32x4*)(src + 4 * q); am = fmaxf(am, fmaxf(fmaxf(fabsf(v[q][0]), fabsf(v[q][1])), fmaxf(fabsf(v[q][2]), fabsf(v[q][3])))); }
#pragma unroll
            for (int o = 32; o > 0; o >>= 1) am = fmaxf(am, __shfl_xor(am, o));
            am = am > 0.f ? am : 1.0f;
            u32x4 o4;
            {
                const float sc = am * (1.0f / 127.0f), inv = 127.0f / am;
#pragma unroll
                for (int q = 0; q < 4; ++q) {
                    const int b0 = (int)rintf(v[q][0] * inv), b1 = (int)rintf(v[q][1] * inv), b2 = (int)rintf(v[q][2] * inv), b3 = (int)rintf(v[q][3] * inv);
                    o4[q] = (unsigned)(b0 & 255) | ((unsigned)(b1 & 255) << 8) | ((unsigned)(b2 & 255) << 16) | ((unsigned)(b3 & 255) << 24);
                }
                *(u32x4*)((signed char*)(P.ws + (up ? WS_EU8 : WS_ED8)) + ((size_t)(lane >> 3) * NEXP + er) * 128 + 16 * (lane & 7)) = o4;
                if (lane == 0) ((float*)(P.ws + (up ? WS_SU : WS_SD)))[er] = sc;
            }
        }
    }
    {
        const int gid = bid * NTHREADS + tid;
        if (gid < 32768) {
            const int p = gid >> 14, rem = gid & 16383, d = rem & 127;
            const float v = (p ? P.sk2 : P.sk1)[rem] * P.query_gain[128 * p + d];
            ((bf16_t*)(P.ws + WS_SK))[gid] = (bf16_t)f2bf(v);
        }
    }
}

template <bool WITH_BG, bool WITH_Q8>
__device__ void norm_mod_phase(const Params& P, const float* __restrict__ src, const bf16_t* __restrict__ dlt, float* __restrict__ x1out, const float* __restrict__ gain, const float* __restrict__ mod, int shift_off, int scale_off,
                               bf16_t* __restrict__ dst, int bid, int nblk) {
    const int tid_ = opaque_tid(); const int lane = tid_ & 63, wid = tid_ >> 6;
    float wreg[WITH_BG ? 16 : 1][8];
    if (WITH_BG) {
#pragma unroll
        for (int i = 0; i < 4; ++i)
#pragma unroll
            for (int jj = 0; jj < 4; ++jj) {
                const float* wp = P.w_in + (size_t)(256 * i + 4 * lane + jj) * IPW + 3584;
                const f32x4 w0 = *(const f32x4*)wp, w1 = *(const f32x4*)(wp + 4);
                wreg[4 * i + jj][0] = w0[0]; wreg[4 * i + jj][1] = w0[1]; wreg[4 * i + jj][2] = w0[2]; wreg[4 * i + jj][3] = w0[3];
                wreg[4 * i + jj][4] = w1[0]; wreg[4 * i + jj][5] = w1[1]; wreg[4 * i + jj][6] = w1[2]; wreg[4 * i + jj][7] = w1[3];
            }
    }
    for (int row = bid * 8 + wid; row < NTOK; row += nblk * 8) {
        const int b = row >> 11;
        f32x4 v[4]; float ss = 0.f;
#pragma unroll
        for (int i = 0; i < 4; ++i) {
            v[i] = *(const f32x4*)(src + (size_t)row * DM + 256 * i + 4 * lane);
            if (WITH_Q8) {
                const u32x2 d2 = *(const u32x2*)(dlt + (size_t)row * DM + 256 * i + 4 * lane);
                v[i][0] += bflo(d2.x); v[i][1] += bfhi(d2.x); v[i][2] += bflo(d2.y); v[i][3] += bfhi(d2.y);
            }
            ss += v[i][0] * v[i][0] + v[i][1] * v[i][1] + v[i][2] * v[i][2] + v[i][3] * v[i][3];
        }
#pragma unroll
        for (int o = 32; o > 0; o >>= 1) ss += __shfl_xor(ss, o);
        const float rstd = rsqrtf(ss * (1.0f / DM) + EPS);
        float a8[8];
        float yq[WITH_Q8 ? 4 : 1][4];
#pragma unroll
        for (int q = 0; q < 8; ++q) a8[q] = 0.f;
#pragma unroll
        for (int i = 0; i < 4; ++i) {
            const int c = 256 * i + 4 * lane;
            const f32x4 g = *(const f32x4*)(gain + c), sh = *(const f32x4*)(mod + b * 6144 + shift_off + c), sc = *(const f32x4*)(mod + b * 6144 + scale_off + c);
            float y[4];
#pragma unroll
            for (int jj = 0; jj < 4; ++jj) {
                y[jj] = v[i][jj] * rstd * g[jj] * (1.0f + sc[jj]) + sh[jj];
                if (WITH_BG) {
#pragma unroll
                    for (int q = 0; q < 8; ++q) a8[q] += y[jj] * wreg[4 * i + jj][q];
                }
            }
            u32x2 o; o.x = pk2(y[0], y[1]); o.y = pk2(y[2], y[3]);
            *(u32x2*)(dst + (size_t)row * DM + c) = o;
            if (WITH_Q8) { yq[i][0] = y[0]; yq[i][1] = y[1]; yq[i][2] = y[2]; yq[i][3] = y[3]; }
        }
        if (WITH_Q8) {
            float am = 0.f;
#pragma unroll
            for (int i = 0; i < 4; ++i) am = fmaxf(am, fmaxf(fmaxf(fabsf(yq[i][0]), fabsf(yq[i][1])), fmaxf(fabsf(yq[i][2]), fabsf(yq[i][3]))));
#pragma unroll
            for (int o = 32; o > 0; o >>= 1) am = fmaxf(am, __shfl_xor(am, o));
            am = am > 0.f ? am : 1.0f;
            const float inv = 127.0f / am;
#pragma unroll
            for (int i = 0; i < 4; ++i) {
                const int b0 = (int)rintf(yq[i][0] * inv), b1 = (int)rintf(yq[i][1] * inv), b2 = (int)rintf(yq[i][2] * inv), b3 = (int)rintf(yq[i][3] * inv);
                *(unsigned*)((signed char*)(P.ws + WS_H8) + (size_t)row * DM + 256 * i + 4 * lane) = (unsigned)(b0 & 255) | ((unsigned)(b1 & 255) << 8) | ((unsigned)(b2 & 255) << 16) | ((unsigned)(b3 & 255) << 24);
            }
            if (lane == 0) ((float*)(P.ws + WS_HS))[row] = am * (1.0f / 127.0f);
        }
        if (WITH_BG) {
            const bool u1 = (lane & 1) != 0, u2 = (lane & 2) != 0, u4 = (lane & 4) != 0;
            float z4[4];
#pragma unroll
            for (int q = 0; q < 4; ++q) { const float keep = u1 ? a8[2 * q + 1] : a8[2 * q], send = u1 ? a8[2 * q] : a8[2 * q + 1]; z4[q] = keep + __shfl_xor(send, 1); }
            float z2[2];
#pragma unroll
            for (int q = 0; q < 2; ++q) { const float keep = u2 ? z4[2 * q + 1] : z4[2 * q], send = u2 ? z4[2 * q] : z4[2 * q + 1]; z2[q] = keep + __shfl_xor(send, 2); }
            const float keep = u4 ? z2[1] : z2[0], send = u4 ? z2[0] : z2[1];
            float t = keep + __shfl_xor(send, 4);
            t += __shfl_xor(t, 8); t += __shfl_xor(t, 16); t += __shfl_xor(t, 32);
            if (lane < 4) ((float*)(P.ws + WS_BETA))[(size_t)row * 4 + lane] = 1.0f / (1.0f + __expf(-t));
            else if (lane < 8) {
                const int hq = lane - 4; const float xx = t + P.dt_bias[hq];
                const float sp = xx > 20.f ? xx : log1pf(__expf(xx));
                ((float*)(P.ws + WS_G))[(size_t)row * 4 + hq] = -__expf(P.a_log[hq]) * sp;
            }
        }
    }
}

namespace pg8 {
#define PG8_LAS __attribute__((address_space(3)))
constexpr int BM = 256, BK = 64, HALF = 128, HTB = HALF * BK * 2, NXCD = 8, WGM = 8;
__host__ __device__ __forceinline__ int lds_byte(int r, int c) { const int st = (r >> 4) * 2 + (c >> 5), rr = r & 15, cc = c & 31, ob = rr * 64 + cc * 2; return st * 1024 + (ob ^ (((ob >> 9) & 1) << 5)); }
__host__ __device__ __forceinline__ void stage_rc(int b, int& R, int& C) { const int st = b / 1024, sb = b % 1024, swz = sb ^ (((sb >> 9) & 1) << 5); R = (st >> 1) * 16 + swz / 64; C = (st & 1) * 32 + (swz % 64) / 2; }
__host__ __device__ __forceinline__ int perm32(int rho) { const int n = rho >> 4, i = rho & 15; return 8 * (i >> 2) + 4 * n + (i & 3); }
struct Unit { int pm, pn; };
struct Gemm { const bf16_t* A; const bf16_t* Bt; int M, N, K; };
struct StaticOrder {
    int nM, nN, nwg, G, c;
    __host__ __device__ void init(int M, int N, int G_, int c_) { nM = M / BM; nN = N / BM; nwg = nM * nN; G = G_; c = c_; }
    __host__ __device__ bool next(int i, Unit& u) const {
        const long L = (long)i * G + c; if (L >= nwg) return false;
        int wgid = (int)L; { const int q = nwg / NXCD, r = nwg % NXCD, xcd = wgid % NXCD, off = wgid / NXCD; wgid = (xcd < r ? xcd * (q + 1) : r * (q + 1) + (xcd - r) * q) + off; }
        const int nig = WGM * nN, gid = wgid / nig, fm = gid * WGM, gsz = (nM - fm) < WGM ? (nM - fm) : WGM;
        u.pm = fm + ((wgid % nig) % gsz); u.pn = (wgid % nig) / gsz; return true;
    }
};

template <class Epi>
__device__ __forceinline__ void gemm_phase(PG8_LAS unsigned char* lds, const Gemm g, const StaticOrder& S, const Epi& E) {
    const int tid = opaque_tid(), wid = __builtin_amdgcn_readfirstlane(tid >> 6), lane = tid & 63, wr = wid >> 2, wc = wid & 3, fr = lane & 15, fq = lane >> 4;
    const int K = g.K, nt = K / BK;
    unsigned voffA[2], voffB[2];
#pragma unroll
    for (int i = 0; i < 2; ++i) { int R, C; stage_rc(tid * 16 + i * 8192, R, C); const int Rb = 64 * (R >> 5) + perm32(R & 31);
        voffA[i] = (unsigned)(R * K + C) * 2u; voffB[i] = (unsigned)(Rb * K + C) * 2u; }
    const size_t kstep = (size_t)(BK * 2);
    const size_t hstep = (size_t)HALF * K * 2;
    const size_t hstepB = (size_t)32 * K * 2;
    const size_t tstep = 2 * hstep;
    const unsigned ldsw = (unsigned)wid * 1024u;
    const int aoff = lds_byte(wr * 64 + fr, fq * 8), boff = lds_byte(wc * 32 + fr, fq * 8);
#define PG8_SA(b, h) (((b) * 2 + (h)) * HTB)
#define PG8_SB(b, h) ((4 + (b) * 2 + (h)) * HTB)
#define PG8_STAGE(bufoff, gbase, voff) do { _Pragma("unroll") for (int _i = 0; _i < 2; ++_i) \
        __builtin_amdgcn_global_load_lds((const unsigned*)((const char*)(gbase) + (voff)[_i]), (PG8_LAS unsigned*)(lds + (bufoff) + ldsw + _i * 8192), 16, 0, 0); } while (0)
#define PG8_LDA(dst, b, h) do { _Pragma("unroll") for (int m = 0; m < 4; ++m) _Pragma("unroll") for (int k = 0; k < 2; ++k) dst[m][k] = *(const PG8_LAS bf16x8*)(lds + PG8_SA(b, h) + aoff + m * 2048 + k * 1024); } while (0)
#define PG8_LDB(dst, b, h) do { _Pragma("unroll") for (int n = 0; n < 2; ++n) _Pragma("unroll") for (int k = 0; k < 2; ++k) dst[n][k] = *(const PG8_LAS bf16x8*)(lds + PG8_SB(b, h) + boff + n * 2048 + k * 1024); } while (0)
#define PG8_MMA(ai, bj, At, Bt) do { __builtin_amdgcn_s_setprio(1); _Pragma("unroll") for (int m = 0; m < 4; ++m) _Pragma("unroll") for (int n = 0; n < 2; ++n) _Pragma("unroll") for (int k = 0; k < 2; ++k) \
        acc[ai][bj][m][n] = __builtin_amdgcn_mfma_f32_16x16x32_bf16(Bt[n][k], At[m][k], acc[ai][bj][m][n], 0, 0, 0); __builtin_amdgcn_s_setprio(0); } while (0)
#define PG8_WAIT_V(n) asm volatile("s_waitcnt vmcnt(" #n ")" ::: "memory")
#define PG8_WAIT_L(n) asm volatile("s_waitcnt lgkmcnt(" #n ")" ::: "memory")
#define PG8_BAR __builtin_amdgcn_s_barrier()
#define PG8_SCHED __builtin_amdgcn_sched_barrier(0)
    Unit cur, nxt; int ui = 0;
    if (!S.next(0, cur)) return;
    f32x4 acc[2][2][4][2];
#pragma unroll
    for (int a = 0; a < 2; ++a)
#pragma unroll
        for (int b = 0; b < 2; ++b)
#pragma unroll
            for (int m = 0; m < 4; ++m)
#pragma unroll
                for (int n = 0; n < 2; ++n) acc[a][b][m][n] = (f32x4){0.f, 0.f, 0.f, 0.f};
    bf16x8 At[4][2], B0[2][2], B1[2][2];
    const char* cA = (const char*)g.A + (size_t)cur.pm * tstep; const char* cB = (const char*)g.Bt + (size_t)cur.pn * tstep;
    PG8_STAGE(PG8_SB(0, 0), cB, voffB); PG8_STAGE(PG8_SB(0, 1), cB + hstepB, voffB); PG8_STAGE(PG8_SA(0, 0), cA, voffA); PG8_STAGE(PG8_SA(0, 1), cA + hstep, voffA);
    if (wr == 1) PG8_BAR;
    PG8_WAIT_V(2); PG8_BAR;
    PG8_STAGE(PG8_SB(1, 0), cB + kstep, voffB); PG8_STAGE(PG8_SA(1, 0), cA + kstep, voffA); PG8_STAGE(PG8_SB(1, 1), cB + hstepB + kstep, voffB);
    PG8_WAIT_V(6); PG8_BAR;
    for (;;) {
        const bool has_next = S.next(ui + 1, nxt);
        const char* nA = has_next ? (const char*)g.A + (size_t)nxt.pm * tstep : cA; const char* nB = has_next ? (const char*)g.Bt + (size_t)nxt.pn * tstep : cB;
        for (int t = 0; t < nt; t += 2) {
            const bool last = (t == nt - 2);
            const char* a1 = cA + (size_t)(t + 1) * kstep;
            const char* a2 = last ? nA : cA + (size_t)(t + 2) * kstep; const char* b2 = last ? nB : cB + (size_t)(t + 2) * kstep;
            const char* a3 = a2 + kstep; const char* b3 = b2 + kstep;
            PG8_LDB(B0, 0, 0); PG8_LDB(B1, 0, 1); PG8_SCHED; PG8_LDA(At, 0, 0); PG8_STAGE(PG8_SA(1, 1), a1 + hstep, voffA);
            PG8_WAIT_V(8); PG8_WAIT_L(0); PG8_BAR; PG8_MMA(0, 0, At, B0); PG8_MMA(0, 1, At, B1); PG8_BAR; PG8_SCHED;
            PG8_LDA(At, 0, 1); PG8_STAGE(PG8_SB(0, 0), b2, voffB); PG8_STAGE(PG8_SB(0, 1), b2 + hstepB, voffB); PG8_STAGE(PG8_SA(0, 0), a2, voffA);
            PG8_WAIT_V(8); PG8_WAIT_L(0); PG8_BAR; PG8_MMA(1, 0, At, B0); PG8_MMA(1, 1, At, B1); PG8_BAR; PG8_SCHED;
            PG8_LDB(B0, 1, 0); PG8_LDB(B1, 1, 1); PG8_SCHED; PG8_LDA(At, 1, 0); PG8_STAGE(PG8_SA(0, 1), a2 + hstep, voffA);
            PG8_WAIT_V(8); PG8_WAIT_L(0); PG8_BAR; PG8_MMA(0, 0, At, B0); PG8_MMA(0, 1, At, B1); PG8_BAR; PG8_SCHED;
            PG8_LDA(At, 1, 1); PG8_STAGE(PG8_SB(1, 0), b3, voffB); PG8_STAGE(PG8_SB(1, 1), b3 + hstepB, voffB); PG8_STAGE(PG8_SA(1, 0), a3, voffA);
            PG8_WAIT_V(8); PG8_WAIT_L(0); PG8_BAR; PG8_MMA(1, 0, At, B0); PG8_MMA(1, 1, At, B1); PG8_BAR; PG8_SCHED;
        }
        if (wr == 0) PG8_BAR;
        E(acc, cur, wr, wc, fr, fq);
        if (!has_next) break;
#pragma unroll
        for (int a = 0; a < 2; ++a)
#pragma unroll
            for (int b = 0; b < 2; ++b)
#pragma unroll
                for (int m = 0; m < 4; ++m)
#pragma unroll
                    for (int n = 0; n < 2; ++n) acc[a][b][m][n] = (f32x4){0.f, 0.f, 0.f, 0.f};
        cur = nxt; cA = nA; cB = nB; ++ui;
        if (wr == 1) PG8_BAR;
    }
    PG8_WAIT_V(0);
    PG8_BAR;
#undef PG8_SA
#undef PG8_SB
#undef PG8_STAGE
#undef PG8_LDA
#undef PG8_LDB
#undef PG8_MMA
#undef PG8_WAIT_V
#undef PG8_WAIT_L
#undef PG8_BAR
#undef PG8_SCHED
}
}

#define ACC_T const f32x4 (&acc)[2][2][4][2]
__device__ __forceinline__ u32x4 pack_acc8(const f32x4& a, const f32x4& b, float s) {
    u32x4 o; o.x = pk2(a[0] * s, a[1] * s); o.y = pk2(a[2] * s, a[3] * s); o.z = pk2(b[0] * s, b[1] * s); o.w = pk2(b[2] * s, b[3] * s); return o;
}
struct EpiQK {
    const float *q_gain, *k_gain;
    bf16_t *qa, *ka;
    __device__ __forceinline__ void operator()(ACC_T, const pg8::Unit& u, int wr, int wc, int fr, int fq) const {
        const int pn = u.pn, bb = u.pm >> 3, s0 = (u.pm & 7) * 256 + wr * 64;
        {
            const bool isq = pn < 2; const int head = (pn & 1) * 4 + wc;
            const float* gn = isq ? q_gain : k_gain; const float sc = isq ? 0.125f * 1.4426950408889634f : 1.0f;
            bf16_t* ub = (isq ? qa : ka) + ((size_t)(bb * AH + head) * SEQ + s0) * 64;
            const unsigned lo = isq ? (unsigned)(fr * 64 + 8 * fq) : (unsigned)(fq * 256 + fr * 8);
            const float* gl = gn + 8 * fq;
#pragma unroll
            for (int ai = 0; ai < 2; ++ai)
#pragma unroll
                for (int m = 0; m < 4; ++m) {
                    float ss = 0.f;
#pragma unroll
                    for (int bj = 0; bj < 2; ++bj)
#pragma unroll
                        for (int n = 0; n < 2; ++n)
#pragma unroll
                            for (int r = 0; r < 4; ++r) ss += acc[ai][bj][m][n][r] * acc[ai][bj][m][n][r];
                    ss += __shfl_xor(ss, 16); ss += __shfl_xor(ss, 32);
                    const float rstd = rsqrtf(ss * (1.0f / 64.0f) + EPS) * sc;
                    bf16_t* p = isq ? (ub + (ai * 128 + m * 16) * 64) : (ub + (ai * 4 + (m >> 1)) * 2048 + (m & 1) * 128);
#pragma unroll
                    for (int bj = 0; bj < 2; ++bj) {
                        const f32x4 g0 = *(const f32x4*)(gl + 32 * bj), g1 = *(const f32x4*)(gl + 32 * bj + 4);
                        u32x4 o;
                        o.x = pk2(acc[ai][bj][m][0][0] * rstd * g0[0], acc[ai][bj][m][0][1] * rstd * g0[1]); o.y = pk2(acc[ai][bj][m][0][2] * rstd * g0[2], acc[ai][bj][m][0][3] * rstd * g0[3]);
                        o.z = pk2(acc[ai][bj][m][1][0] * rstd * g1[0], acc[ai][bj][m][1][1] * rstd * g1[1]); o.w = pk2(acc[ai][bj][m][1][2] * rstd * g1[2], acc[ai][bj][m][1][3] * rstd * g1[3]);
                        *(u32x4*)(p + (isq ? 32 * bj : 1024 * bj) + lo) = o;
                    }
                }
        }
    }
};
template <int CTRL> __device__ __forceinline__ unsigned dpp_u32(unsigned v) { return (unsigned)__builtin_amdgcn_update_dpp(0, (int)v, CTRL, 0xf, 0xf, false); }
struct EpiV {
    bf16_t* vt;
    __device__ __forceinline__ void operator()(ACC_T, const pg8::Unit& u, int wr, int wc, int fr, int fq) const {
        const int pn = u.pn, bb = u.pm >> 3, s0 = (u.pm & 7) * 256 + wr * 64;
        {
            const int head = (pn & 1) * 4 + wc;
            bf16_t* ub = vt + ((size_t)(bb * AH + head) * SEQ + s0) * 64;
            const int pp = swap23(fr);
            const bool u2 = (fr & 8) != 0, u1 = (fr & 2) != 0, u0 = (fr & 1) != 0;
            const unsigned selv = u0 ? 0x03020706u : 0x05040100u;
            const unsigned lo = (unsigned)((pp >> 3) * 256 + (8 * fq + (pp & 7)) * 8);
#pragma unroll
            for (int ai = 0; ai < 2; ++ai)
#pragma unroll
                for (int m = 0; m < 4; ++m)
#pragma unroll
                    for (int bj = 0; bj < 2; ++bj) {
                        unsigned D0 = pk2(acc[ai][bj][m][0][0], acc[ai][bj][m][0][1]), D1 = pk2(acc[ai][bj][m][0][2], acc[ai][bj][m][0][3]);
                        unsigned D2 = pk2(acc[ai][bj][m][1][0], acc[ai][bj][m][1][1]), D3 = pk2(acc[ai][bj][m][1][2], acc[ai][bj][m][1][3]);
                        {
                            const unsigned r0 = dpp_u32<0x128>(u2 ? D0 : D2), r1 = dpp_u32<0x128>(u2 ? D1 : D3);
                            D0 = u2 ? r0 : D0; D1 = u2 ? r1 : D1; D2 = u2 ? D2 : r0; D3 = u2 ? D3 : r1;
                        }
                        {
                            const unsigned r0 = dpp_u32<0x4E>(u1 ? D0 : D1), r1 = dpp_u32<0x4E>(u1 ? D2 : D3);
                            D0 = u1 ? r0 : D0; D2 = u1 ? r1 : D2; D1 = u1 ? D1 : r0; D3 = u1 ? D3 : r1;
                        }
                        {
                            D0 = __builtin_amdgcn_perm(dpp_u32<0xB1>(D0), D0, selv); D1 = __builtin_amdgcn_perm(dpp_u32<0xB1>(D1), D1, selv);
                            D2 = __builtin_amdgcn_perm(dpp_u32<0xB1>(D2), D2, selv); D3 = __builtin_amdgcn_perm(dpp_u32<0xB1>(D3), D3, selv);
                        }
                        *(u32x4*)(ub + (ai * 2 + (m >> 2)) * 4096 + ((bj * 2 + ((m >> 1) & 1)) * 2 + (m & 1)) * 512 + lo) = (u32x4){D0, D1, D2, D3};
                    }
        }
    }
};
struct EpiOut {
    const float* mod; bf16_t* dlt;
    __device__ __forceinline__ void operator()(ACC_T, const pg8::Unit& u, int wr, int wc, int fr, int fq) const {
        bf16_t* ub = dlt + (size_t)(u.pm * 256 + wr * 64) * DM + u.pn * 256 + wc * 64;
        const float* ug = mod + (u.pm >> 3) * 6144 + 2048 + u.pn * 256 + wc * 64;
        const unsigned lo = (unsigned)(fr * DM + 8 * fq), lg = (unsigned)(8 * fq);
#pragma unroll
        for (int bj = 0; bj < 2; ++bj) {
            const f32x4 g0 = *(const f32x4*)(ug + 32 * bj + lg), g1 = *(const f32x4*)(ug + 32 * bj + 4 + lg);
#pragma unroll
            for (int ai = 0; ai < 2; ++ai)
#pragma unroll
                for (int m = 0; m < 4; ++m) {
                    const f32x4& a0 = acc[ai][bj][m][0]; const f32x4& a1 = acc[ai][bj][m][1];
                    u32x4 o; o.x = pk2(a0[0] * g0[0], a0[1] * g0[1]); o.y = pk2(a0[2] * g0[2], a0[3] * g0[3]); o.z = pk2(a1[0] * g1[0], a1[1] * g1[1]); o.w = pk2(a1[2] * g1[2], a1[3] * g1[3]);
                    *(u32x4*)(ub + (ai * 128 + m * 16) * DM + 32 * bj + lo) = o;
                }
        }
    }
};
struct EpiBf {
    bf16_t* dst; int ld;
    __device__ __forceinline__ void operator()(ACC_T, const pg8::Unit& u, int wr, int wc, int fr, int fq) const {
        bf16_t* ub = dst + (size_t)(u.pm * 256 + wr * 64) * ld + u.pn * 256 + wc * 64;
        const unsigned lo = (unsigned)(fr * ld + 8 * fq);
#pragma unroll
        for (int ai = 0; ai < 2; ++ai)
#pragma unroll
            for (int m = 0; m < 4; ++m)
#pragma unroll
                for (int bj = 0; bj < 2; ++bj) *(u32x4*)(ub + (ai * 128 + m * 16) * ld + 32 * bj + lo) = pack_acc8(acc[ai][bj][m][0], acc[ai][bj][m][1], 1.0f);
    }
};
struct EpiInAll {
    EpiQK qk; EpiV v; EpiBf pbf;
    __device__ __forceinline__ void operator()(ACC_T, const pg8::Unit& u, int wr, int wc, int fr, int fq) const {
        if (u.pn < 4) qk(acc, u, wr, wc, fr, fq);
        else if (u.pn < 6) { pg8::Unit u2 = u; u2.pn = u.pn - 4; v(acc, u2, wr, wc, fr, fq); }
        else { pg8::Unit u2 = u; u2.pn = u.pn - 6; pbf(acc, u2, wr, wc, fr, fq); }
    }
};
#undef ACC_T
template <class Epi>
__device__ __forceinline__ void gemm_run(const bf16_t* A, const bf16_t* Bt, int M, int N, int K, const Epi& e, unsigned char* lds, int bid, int nblk) {
    pg8::Gemm g{A, Bt, M, N, K}; pg8::StaticOrder S; S.init(M, N, nblk, bid);
    pg8::gemm_phase<Epi>((PG8_LAS unsigned char*)lds, g, S, e);
}

__device__ void attn_phase(const Params& P, unsigned char* lds, int bid, int nblk) {
    const int tid0 = opaque_tid();
    {
        const int head = tid0 >> 6, lane = tid0 & 63;
        float* biasL = (float*)lds + head * 260;
        for (int i = lane; i < 257; i += 64) biasL[i] = (P.rel_bias[head * 257 + i] - P.rel_bias[head * 257 + 256]) * 1.4426950408889634f;
    }
    const bf16_t* qa = (const bf16_t*)(P.ws + WS_QA); const bf16_t* ka = (const bf16_t*)(P.ws + WS_KA); const bf16_t* vt = (const bf16_t*)(P.ws + WS_VT);
    bf16_t* mix = (bf16_t*)(P.ws + WS_H);
    for (int it = bid; it < 512; it += nblk) {
        int tid = tid0; asm volatile("" : "+v"(tid));
        const int head = tid >> 6, lane = tid & 63, l31 = lane & 31, hh = lane >> 5;
        const float* biasL = (const float*)lds + head * 260;
        float* ssq = (float*)(lds + 8 * 260 * 4);
        float* park = (float*)(lds + 16384) + head * 4096;
        const int it2 = it & 255, b = it2 & 15, pp = it2 >> 4, n = (it < 256) ? pp : 31 - pp;
        const size_t hb = (size_t)(b * AH + head);
        const bf16_t* qbase = qa + (hb * SEQ + (size_t)n * 64) * 64;
        const int cstart = (n >= 8) ? 0 : 8 - n;
        float ssv[2];
#pragma unroll
        for (int qt = 0; qt < 2; ++qt) {
            const int qi = 32 * qt + l31;
            bf16x8 bq[4];
#pragma unroll
            for (int ks = 0; ks < 4; ++ks) bq[ks] = *(const bf16x8*)(qbase + qi * 64 + 16 * ks + 8 * hh);
            f32x16 o0, o1;
#pragma unroll
            for (int r = 0; r < 16; ++r) { o0[r] = 0.f; o1[r] = 0.f; }
            float mrun = -1e30f, lrun = 0.f;
            bf16x8 kc0[4], kc1[4];
            {
                const bf16_t* kb = ka + (hb * SEQ + (size_t)(n + cstart - 8) * 64) * 64;
#pragma unroll
                for (int ks = 0; ks < 4; ++ks) { kc0[ks] = *(const bf16x8*)(kb + (2 * ks + hh) * 256 + l31 * 8); kc1[ks] = *(const bf16x8*)(kb + 2048 + (2 * ks + hh) * 256 + l31 * 8); }
            }
            for (int c = cstart; c <= 8; ++c) {
                const int kc = n + c - 8;
                const bf16_t* vb = vt + (hb * SEQ + (size_t)kc * 64) * 64;
                bf16x8 v0[4], v1[4], kn0[4], kn1[4];
#pragma unroll
                for (int kt = 0; kt < 2; ++kt)
#pragma unroll
                    for (int sp = 0; sp < 2; ++sp) {
                        v0[2 * kt + sp] = *(const bf16x8*)(vb + ((kt * 2 + sp) * 2 + hh) * 256 + l31 * 8);
                        v1[2 * kt + sp] = *(const bf16x8*)(vb + 2048 + ((kt * 2 + sp) * 2 + hh) * 256 + l31 * 8);
                    }
                {
                    const int kcn = (c < 8) ? kc + 1 : kc;
                    const bf16_t* kb = ka + (hb * SEQ + (size_t)kcn * 64) * 64;
#pragma unroll
                    for (int ks = 0; ks < 4; ++ks) { kn0[ks] = *(const bf16x8*)(kb + (2 * ks + hh) * 256 + l31 * 8); kn1[ks] = *(const bf16x8*)(kb + 2048 + (2 * ks + hh) * 256 + l31 * 8); }
                }
                f32x16 s0, s1;
#pragma unroll
                for (int r = 0; r < 16; ++r) { s0[r] = 0.f; s1[r] = 0.f; }
#pragma unroll
                for (int ks = 0; ks < 4; ++ks) { s0 = mfma32(kc0[ks], bq[ks], s0); s1 = mfma32(kc1[ks], bq[ks], s1); }
                if (c > 5) {
                    const int base = qi + 64 * (8 - c) + 128 - 4 * hh;
#pragma unroll
                    for (int r = 0; r < 16; ++r) {
                        const int j0 = (r & 3) + 8 * (r >> 2);
                        int i0 = base - j0; i0 = i0 > 256 ? 256 : i0;
                        int i1 = base - 32 - j0; i1 = i1 > 256 ? 256 : i1;
                        s0[r] += biasL[i0]; s1[r] += biasL[i1];
                    }
                }
                float mx = s0[0];
#pragma unroll
                for (int r = 1; r < 16; ++r) mx = fmaxf(mx, s0[r]);
#pragma unroll
                for (int r = 0; r < 16; ++r) mx = fmaxf(mx, s1[r]);
                mx = fmaxf(mx, __shfl_xor(mx, 32));
                const float mnew = fmaxf(mrun, mx);
                const bool grew = mnew > mrun;
                const float alpha = __builtin_amdgcn_exp2f(mrun - mnew);
                mrun = mnew;
                float psum = 0.f;
#pragma unroll
                for (int r = 0; r < 16; ++r) { s0[r] = __builtin_amdgcn_exp2f(s0[r] - mnew); s1[r] = __builtin_amdgcn_exp2f(s1[r] - mnew); psum += s0[r] + s1[r]; }
                lrun = lrun * alpha + psum;
                if (__any(grew)) {
#pragma unroll
                    for (int r = 0; r < 16; ++r) { o0[r] *= alpha; o1[r] *= alpha; }
                }
                bf16x8 pf[4];
                pf[0] = pack8(s0[0], s0[1], s0[2], s0[3], s0[4], s0[5], s0[6], s0[7]);
                pf[1] = pack8(s0[8], s0[9], s0[10], s0[11], s0[12], s0[13], s0[14], s0[15]);
                pf[2] = pack8(s1[0], s1[1], s1[2], s1[3], s1[4], s1[5], s1[6], s1[7]);
                pf[3] = pack8(s1[8], s1[9], s1[10], s1[11], s1[12], s1[13], s1[14], s1[15]);
#pragma unroll
                for (int q4 = 0; q4 < 4; ++q4) { o0 = mfma32(v0[q4], pf[q4], o0); o1 = mfma32(v1[q4], pf[q4], o1); }
#pragma unroll
                for (int ks = 0; ks < 4; ++ks) { kc0[ks] = kn0[ks]; kc1[ks] = kn1[ks]; }
            }
            const float ltot = lrun + __shfl_xor(lrun, 32), inv = 1.0f / ltot;
            float ss = 0.f;
#pragma unroll
            for (int r = 0; r < 16; ++r) { o0[r] *= inv; o1[r] *= inv; ss += o0[r] * o0[r] + o1[r] * o1[r]; }
            ss += __shfl_xor(ss, 32);
            ssv[qt] = ss;
#pragma unroll
            for (int r = 0; r < 16; ++r) { park[(qt * 32 + r) * 64 + lane] = o0[r]; park[(qt * 32 + 16 + r) * 64 + lane] = o1[r]; }
        }
        if (hh == 0) { ssq[head * 64 + l31] = ssv[0]; ssq[head * 64 + 32 + l31] = ssv[1]; }
        __syncthreads();
#pragma unroll
        for (int qt = 0; qt < 2; ++qt) {
            const int qi = 32 * qt + l31;
            float tot = 0.f;
#pragma unroll
            for (int h2 = 0; h2 < 8; ++h2) tot += ssq[h2 * 64 + qi];
            const float rstd = rsqrtf(tot * (1.0f / 512.0f) + EPS);
            const size_t tok = (size_t)b * SEQ + n * 64 + qi;
#pragma unroll
            for (int dt = 0; dt < 2; ++dt)
#pragma unroll
                for (int g4 = 0; g4 < 4; ++g4) {
                    const int dim = 32 * dt + 8 * g4 + 4 * hh;
                    const f32x4 gn = *(const f32x4*)(P.attn_out_gain + head * 64 + dim);
                    const float* pk = park + (qt * 32 + dt * 16 + 4 * g4) * 64 + lane;
                    u32x2 w; w.x = pk2(pk[0] * rstd * gn[0], pk[64] * rstd * gn[1]); w.y = pk2(pk[128] * rstd * gn[2], pk[192] * rstd * gn[3]);
                    *(u32x2*)(mix + tok * DM + head * 64 + dim) = w;
                }
        }
        __syncthreads();
    }
}

constexpr int RP = 136, TP = 72, AP = 72, AIP = 24, LDB = 273, RAWP = 784  , STGP = 136  ;
constexpr int L_KB = 0, L_KK = 17408, L_QS = 34816, L_UT = 0, L_WT = 18432, L_AINV = 36864, L_QG = 52224, L_VBT = 69632, L_KBGT = 88064, L_KDT = 106496,
              L_NL = 124928, L_LD = 134144, L_AM = 138752, L_GC = 147968, L_RED = 148480;
static_assert(L_AINV + 4 * 16 * AIP * 2 <= L_QG && L_LD + 4 * LDB * 4 <= L_AM && L_RED + 4096 <= LDS_BYTES - 16, "lds map");

__device__ void dn1_phase(const Params& P, unsigned char* lds, int bid, int nblk) {
    const int tid0 = opaque_tid();
    bf16_t* KB = (bf16_t*)(lds + L_KB); bf16_t* KK = (bf16_t*)(lds + L_KK); bf16_t* QS = (bf16_t*)(lds + L_QS);
    bf16_t* UT = (bf16_t*)(lds + L_UT); bf16_t* WT = (bf16_t*)(lds + L_WT); bf16_t* AINV = (bf16_t*)(lds + L_AINV); bf16_t* QG = (bf16_t*)(lds + L_QG);
    bf16_t* VBT = (bf16_t*)(lds + L_VBT); bf16_t* KBGT = (bf16_t*)(lds + L_KBGT); bf16_t* KDT = (bf16_t*)(lds + L_KDT);
    bf16_t* NL = (bf16_t*)(lds + L_NL); float* LD = (float*)(lds + L_LD); bf16_t* AM = (bf16_t*)(lds + L_AM);
    float* gcs = (float*)(lds + L_GC); float* bts = gcs + 64; float* red = (float*)(lds + L_RED);
    const bf16_t* pb = (const bf16_t*)(P.ws + WS_PB);
    const float* betaG = (const float*)(P.ws + WS_BETA); const float* gG = (const float*)(P.ws + WS_G);
    bf16_t* negM = (bf16_t*)(P.ws + WS_NEGM); bf16_t* BmT = (bf16_t*)P.out; bf16_t* Qp = (bf16_t*)(P.ws + WS_QP); bf16_t* Ol = (bf16_t*)(P.ws + WS_OL);
    float* egl = (float*)(P.ws + WS_EGL);
    u32x4 rv[7]; float gpre = 0.f, bpre = 0.f;
#define DN1_PREFETCH(IT)                                                                                                   \
    {                                                                                                                      \
        const int tidp_ = tid0, n_ = (IT) & 31, bh_ = (IT) >> 5, h_ = bh_ & 3, b_ = bh_ >> 2;                               \
        _Pragma("unroll") for (int q = 0; q < 7; ++q) {                                                                    \
            const int ci = tidp_ + 512 * q, row = ci / 48, c16 = ci - row * 48, mat = c16 >> 4, cc = c16 & 15;             \
            const int srow = n_ * 64 - 3 + row;                                                                            \
            const bool ok = (ci < 67 * 48) && (srow >= 0);                                                                 \
            const bf16_t* src = pb + (size_t)(b_ * SEQ + (ok ? srow : 0)) * PBW + mat * 512 + h_ * 128 + cc * 8;           \
            rv[q] = *(const u32x4*)src;                                                                                    \
            if (!ok) rv[q] = (u32x4){0u, 0u, 0u, 0u};                                                                      \
        }                                                                                                                  \
        if (tidp_ < 64) { const size_t tg_ = (size_t)(b_ * SEQ + n_ * 64 + tidp_) * 4 + h_; gpre = gG[tg_]; bpre = betaG[tg_]; } \
    }
    unsigned* qctr = (unsigned*)P.ws + 4000;
    volatile int* qnext = (volatile int*)(lds + LDS_BYTES - 32);
    if (bid < 2048) { DN1_PREFETCH(bid) }
    int item = bid;
    while (item < 2048) {
        if (tid0 == 0) *qnext = nblk + (int)__hip_atomic_fetch_add(qctr, 1u, __ATOMIC_RELAXED, __HIP_MEMORY_SCOPE_AGENT);
        int tid = tid0; asm volatile("" : "+v"(tid));
        const int wid = tid >> 6, lane = tid & 63, fr = lane & 15, fq = lane >> 4;
        const int n = item & 31, bh = item >> 5, h = bh & 3, b = bh >> 2;
        const int t0 = b * SEQ + n * 64;
        if (wid == 0) {
            float gv = gpre;
#pragma unroll
            for (int o = 1; o < 64; o <<= 1) { const float t = __shfl_up(gv, o); if (lane >= o) gv += t; }
            gcs[lane] = gv; bts[lane] = bpre;
        }
#pragma unroll
        for (int q = 0; q < 7; ++q) {
            const int ci = tid + 512 * q, row = ci / 48, c16 = ci - row * 48;
            if (ci < 67 * 48) *(u32x4*)(lds + row * RAWP + c16 * 16) = rv[q];
        }
        __syncthreads();
        const int r = lane, cg = __builtin_amdgcn_readfirstlane(wid);
        float cv[3][16];
#pragma unroll
        for (int mat = 0; mat < 3; ++mat) {
            const int col = mat * 512 + h * 128 + 16 * cg;
            float* a = cv[mat];
#pragma unroll
            for (int i = 0; i < 16; ++i) a[i] = 0.f;
#pragma unroll
            for (int tap = 0; tap < 4; ++tap) {
                const unsigned char* src = lds + (r + tap) * RAWP + (mat * 128 + 16 * cg) * 2;
                const u32x4 x0 = *(const u32x4*)src, x1 = *(const u32x4*)(src + 16);
                const float* wp = P.conv_w + tap * 1536 + col;
                const f32x4 w0 = *(const f32x4*)wp, w1 = *(const f32x4*)(wp + 4), w2 = *(const f32x4*)(wp + 8), w3 = *(const f32x4*)(wp + 12);
                a[0] += bflo(x0.x) * w0[0]; a[1] += bfhi(x0.x) * w0[1]; a[2] += bflo(x0.y) * w0[2]; a[3] += bfhi(x0.y) * w0[3];
                a[4] += bflo(x0.z) * w1[0]; a[5] += bfhi(x0.z) * w1[1]; a[6] += bflo(x0.w) * w1[2]; a[7] += bfhi(x0.w) * w1[3];
                a[8] += bflo(x1.x) * w2[0]; a[9] += bfhi(x1.x) * w2[1]; a[10] += bflo(x1.y) * w2[2]; a[11] += bfhi(x1.y) * w2[3];
                a[12] += bflo(x1.z) * w3[0]; a[13] += bfhi(x1.z) * w3[1]; a[14] += bflo(x1.w) * w3[2]; a[15] += bfhi(x1.w) * w3[3];
            }
            float ss = 0.f;
#pragma unroll
            for (int i = 0; i < 16; ++i) { a[i] = silu_f(a[i]); ss += a[i] * a[i]; }
            if (mat < 2) red[(mat * 8 + cg) * 64 + r] = ss;
        }
        __syncthreads();
        {
            float sq = 0.f, sk = 0.f;
#pragma unroll
            for (int g8 = 0; g8 < 8; ++g8) { sq += red[g8 * 64 + r]; sk += red[(8 + g8) * 64 + r]; }
            const float gc = gcs[r], bt = bts[r], gl = gcs[63];
            const float eg = __expf(gc), edk = __expf(gl - gc);
            if (tid == 0) egl[item] = __expf(gl);
            const float rq = rsqrtf(sq + EPS) * 0.08838834764831845f, rk = rsqrtf(sk + EPS);
            u32x4 o0, o1;
#define STORE_ROW(ARR, A, F)                                                                                                             \
    {                                                                                                                                    \
        o0.x = pk2(A[0] * (F), A[1] * (F)); o0.y = pk2(A[2] * (F), A[3] * (F)); o0.z = pk2(A[4] * (F), A[5] * (F)); o0.w = pk2(A[6] * (F), A[7] * (F));       \
        o1.x = pk2(A[8] * (F), A[9] * (F)); o1.y = pk2(A[10] * (F), A[11] * (F)); o1.z = pk2(A[12] * (F), A[13] * (F)); o1.w = pk2(A[14] * (F), A[15] * (F)); \
        *(u32x4*)(ARR + r * RP + 16 * cg) = o0; *(u32x4*)(ARR + r * RP + 16 * cg + 8) = o1;                                              \
    }
            const float rqe = rq * eg, rkb = rk * bt, f1 = rk * bt * eg, f2 = rk * edk;
            STORE_ROW(QS, cv[0], rq)
            STORE_ROW(QG, cv[0], rqe)
            STORE_ROW(KK, cv[1], rk)
            STORE_ROW(KB, cv[1], rkb)
#undef STORE_ROW
#pragma unroll
            for (int i = 0; i < 16; ++i) {
                const int c = 16 * cg + i;
                KBGT[c * TP + r] = (bf16_t)f2bf(cv[1][i] * f1);
                KDT[c * TP + r] = (bf16_t)f2bf(cv[1][i] * f2);
                VBT[c * TP + r] = (bf16_t)f2bf(cv[2][i] * bt);
            }
        }
        __syncthreads();
        const int item_next = __builtin_amdgcn_readfirstlane(*qnext);
        if (item_next < 2048) { DN1_PREFETCH(item_next) }
        {
            const int mat = wid >> 2, ti = wid & 3;
            const bf16_t* Asrc = mat ? QS : KB;
            bf16x8 af[4];
#pragma unroll
            for (int ks = 0; ks < 4; ++ks) af[ks] = *(const bf16x8*)(Asrc + (16 * ti + fr) * RP + 32 * ks + 8 * fq);
            for (int tj = 0; tj < 4; ++tj) {
                const int j = 16 * tj + fr;
                if (tj > ti) {
                    if (mat) {
#pragma unroll
                        for (int rr = 0; rr < 4; ++rr) AM[(16 * ti + 4 * fq + rr) * AP + j] = 0;
                    }
                    continue;
                }
                f32x4 acc = (f32x4){0.f, 0.f, 0.f, 0.f};
#pragma unroll
                for (int ks = 0; ks < 4; ++ks) { const bf16x8 bf = *(const bf16x8*)(KK + j * RP + 32 * ks + 8 * fq); acc = mfma16(af[ks], bf, acc); }
                const float gj = gcs[j];
#pragma unroll
                for (int rr = 0; rr < 4; ++rr) {
                    const int i = 16 * ti + 4 * fq + rr;
                    const float dec = __expf(gcs[i] - gj);
                    if (mat == 0) {
                        if (tj < ti) NL[i * AP + j] = (bf16_t)f2bf(-acc[rr] * dec);
                        else LD[ti * LDB + (4 * fq + rr) * 17 + fr] = (i > j) ? acc[rr] * dec : 0.f;
                    } else AM[i * AP + j] = (bf16_t)f2bf((i >= j) ? acc[rr] * dec : 0.f);
                }
            }
        }
        __syncthreads();
        {
            {
                const int blk = lane >> 4, cp = lane & 15;
                float xv[16];
#pragma unroll
                for (int i = 0; i < 16; ++i) {
                    float a = (i == cp) ? 1.0f : 0.0f;
#pragma unroll
                    for (int jj = 0; jj < i; ++jj) a -= LD[blk * LDB + i * 17 + jj] * xv[jj];
                    xv[i] = a;
                }
#pragma unroll
                for (int i = 0; i < 16; ++i) AINV[(blk * 16 + i) * AIP + cp] = (bf16_t)f2bf(xv[i]);
            }
#pragma unroll 1
            for (int cti = 0; cti < 2; ++cti) {
                const int ct = 2 * wid + cti;
                const bf16_t* RT = (ct < 8) ? (VBT + (16 * ct) * TP) : (KBGT + (16 * (ct - 8)) * TP);
                bf16_t* XT = (ct < 8) ? (UT + (16 * ct) * TP) : (WT + (16 * (ct - 8)) * TP);
#pragma unroll
                for (int bq = 0; bq < 4; ++bq) {
                    const u32x2 r2 = *(const u32x2*)(RT + fr * TP + 16 * bq + 4 * fq);
                    f32x4 acc = (f32x4){bflo(r2.x), bfhi(r2.x), bflo(r2.y), bfhi(r2.y)};
                    if (bq > 0) {
#pragma unroll
                        for (int ks = 0; ks < (16 * bq + 31) / 32; ++ks) {
                            bf16x8 a = *(const bf16x8*)(NL + (16 * bq + fr) * AP + 32 * ks + 8 * fq);
                            bf16x8 xb = *(const bf16x8*)(XT + fr * TP + 32 * ks + 8 * fq);
                            if (32 * ks + 8 * fq >= 16 * bq) { a = (bf16x8){0, 0, 0, 0, 0, 0, 0, 0}; xb = (bf16x8){0, 0, 0, 0, 0, 0, 0, 0}; }
                            acc = mfma16(a, xb, acc);
                        }
                    }
                    u32x4 uf; uf.x = pk2(acc[0], acc[1]); uf.y = pk2(acc[2], acc[3]); uf.z = 0u; uf.w = 0u;
                    const u32x2 ai2 = *(const u32x2*)(AINV + (bq * 16 + fr) * AIP + 4 * fq);
                    u32x4 af; af.x = ai2.x; af.y = ai2.y; af.z = 0u; af.w = 0u;
                    f32x4 xo = (f32x4){0.f, 0.f, 0.f, 0.f};
                    xo = mfma16(__builtin_bit_cast(bf16x8, af), __builtin_bit_cast(bf16x8, uf), xo);
                    u32x2 o; o.x = pk2(xo[0], xo[1]); o.y = pk2(xo[2], xo[3]);
                    *(u32x2*)(XT + fr * TP + 16 * bq + 4 * fq) = o;
                }
            }
        }
        __syncthreads();
        {
            const size_t ib = (size_t)item * 16384;
            bf16_t* stg = (bf16_t*)(lds + L_VBT) + wid * (16 * STGP);
            {
                const bf16x8 b0 = *(const bf16x8*)(KDT + (16 * wid + fr) * TP + 8 * fq), b1 = *(const bf16x8*)(KDT + (16 * wid + fr) * TP + 32 + 8 * fq);
#pragma unroll
                for (int t = 0; t < 8; ++t) {
                    const bf16x8 a0 = *(const bf16x8*)(WT + (16 * t + fr) * TP + 8 * fq), a1 = *(const bf16x8*)(WT + (16 * t + fr) * TP + 32 + 8 * fq);
                    f32x4 acc = (f32x4){0.f, 0.f, 0.f, 0.f};
                    acc = mfma16(a0, b0, acc); acc = mfma16(a1, b1, acc);
                    u32x2 o; o.x = pk2(-acc[0], -acc[1]); o.y = pk2(-acc[2], -acc[3]);
                    *(u32x2*)(stg + fr * STGP + 16 * t + 4 * fq) = o;
                }
#pragma unroll
                for (int q = 0; q < 4; ++q) {
                    const int row = (lane >> 4) + 4 * q;
                    const u32x4 v = *(const u32x4*)(stg + row * STGP + (lane & 15) * 8);
                    *(u32x4*)(negM + ib + (size_t)(16 * wid + row) * 128 + (lane & 15) * 8) = v;
                }
            }
            {
                const bf16x8 b0 = *(const bf16x8*)(UT + (16 * wid + fr) * TP + 8 * fq), b1 = *(const bf16x8*)(UT + (16 * wid + fr) * TP + 32 + 8 * fq);
#pragma unroll
                for (int t = 0; t < 8; ++t) {
                    const bf16x8 a0 = *(const bf16x8*)(KDT + (16 * t + fr) * TP + 8 * fq), a1 = *(const bf16x8*)(KDT + (16 * t + fr) * TP + 32 + 8 * fq);
                    f32x4 acc = (f32x4){0.f, 0.f, 0.f, 0.f};
                    acc = mfma16(a0, b0, acc); acc = mfma16(a1, b1, acc);
                    u32x2 o; o.x = pk2(acc[0], acc[1]); o.y = pk2(acc[2], acc[3]);
                    *(u32x2*)(stg + fr * STGP + 16 * t + 4 * fq) = o;
                }
#pragma unroll
                for (int q = 0; q < 4; ++q) {
                    const int row = (lane >> 4) + 4 * q;
                    const u32x4 v = *(const u32x4*)(stg + row * STGP + (lane & 15) * 8);
                    *(u32x4*)(BmT + ib + (size_t)(16 * wid + row) * 128 + (lane & 15) * 8) = v;
                }
            }
            {
                const int it4 = wid & 3, hf = wid >> 2;
                const bf16x8 b0 = *(const bf16x8*)(AM + (16 * it4 + fr) * AP + 8 * fq), b1 = *(const bf16x8*)(AM + (16 * it4 + fr) * AP + 32 + 8 * fq);
#pragma unroll
                for (int tt = 0; tt < 4; ++tt) {
                    const int t = 4 * hf + tt;
                    const bf16x8 a0 = *(const bf16x8*)(WT + (16 * t + fr) * TP + 8 * fq), a1 = *(const bf16x8*)(WT + (16 * t + fr) * TP + 32 + 8 * fq);
                    f32x4 acc = (f32x4){0.f, 0.f, 0.f, 0.f};
                    acc = mfma16(a0, b0, acc); acc = mfma16(a1, b1, acc);
                    const u32x2 qg = *(const u32x2*)(QG + (16 * it4 + fr) * RP + 16 * t + 4 * fq);
                    u32x2 o; o.x = pk2(bflo(qg.x) - acc[0], bfhi(qg.x) - acc[1]); o.y = pk2(bflo(qg.y) - acc[2], bfhi(qg.y) - acc[3]);
                    *(u32x2*)(stg + fr * STGP + 16 * tt + 4 * fq) = o;
                }
#pragma unroll
                for (int q = 0; q < 2; ++q) {
                    const int row = (lane >> 3) + 8 * q;
                    const u32x4 v = *(const u32x4*)(stg + row * STGP + (lane & 7) * 8);
                    *(u32x4*)(Qp + (size_t)item * 8192 + (size_t)(16 * it4 + row) * 128 + 64 * hf + (lane & 7) * 8) = v;
                }
#pragma unroll
                for (int tt = 0; tt < 4; ++tt) {
                    const int t = 4 * hf + tt;
                    const bf16x8 a0 = *(const bf16x8*)(UT + (16 * t + fr) * TP + 8 * fq), a1 = *(const bf16x8*)(UT + (16 * t + fr) * TP + 32 + 8 * fq);
                    f32x4 acc = (f32x4){0.f, 0.f, 0.f, 0.f};
                    acc = mfma16(a0, b0, acc); acc = mfma16(a1, b1, acc);
                    u32x2 o; o.x = pk2(acc[0], acc[1]); o.y = pk2(acc[2], acc[3]);
                    *(u32x2*)(stg + fr * STGP + 16 * tt + 4 * fq) = o;
                }
#pragma unroll
                for (int q = 0; q < 2; ++q) {
                    const int row = (lane >> 3) + 8 * q;
                    const u32x4 v = *(const u32x4*)(stg + row * STGP + (lane & 7) * 8);
                    *(u32x4*)(Ol + (size_t)item * 8192 + (size_t)(16 * it4 + row) * 128 + 64 * hf + (lane & 7) * 8) = v;
                }
            }
        }
        __syncthreads();
        item = item_next;
    }
}
#undef DN1_PREFETCH

__device__ void dn2_phase(const Params& P, unsigned char* lds, int bid, int nblk) {
    const int tid = opaque_tid(), wid = tid >> 6, lane = tid & 63, fr = lane & 15, fq = lane >> 4;
    const bf16_t* negM = (const bf16_t*)(P.ws + WS_NEGM); const bf16_t* BmT = (const bf16_t*)P.out;
    const float* egl = (const float*)(P.ws + WS_EGL); bf16_t* SnT = (bf16_t*)(P.ws + WS_SNT);
    constexpr int SP = 136;
    bf16_t* ST = (bf16_t*)lds;
    for (int sid = bid; sid < 256; sid += nblk) {
        const int bh = sid >> 2, sl = sid & 3;
        f32x4 acc[2];
        acc[0] = (f32x4){0.f, 0.f, 0.f, 0.f}; acc[1] = (f32x4){0.f, 0.f, 0.f, 0.f};
        bf16x8 an[4]; u32x2 bmn[2]; float egn;
        {
            const size_t ib = ((size_t)bh * 32) * 16384;
#pragma unroll
            for (int ks = 0; ks < 4; ++ks) an[ks] = *(const bf16x8*)(negM + ib + (size_t)(16 * wid + fr) * 128 + 32 * ks + 8 * fq);
#pragma unroll
            for (int nn = 0; nn < 2; ++nn) bmn[nn] = *(const u32x2*)(BmT + ib + (size_t)(32 * sl + 16 * nn + fr) * 128 + 16 * wid + 4 * fq);
            egn = egl[bh * 32];
        }
        __syncthreads();
#pragma unroll
        for (int nn = 0; nn < 2; ++nn) *(u32x2*)(ST + (16 * nn + fr) * SP + 16 * wid + 4 * fq) = (u32x2){0u, 0u};
        __syncthreads();
        for (int n = 0; n < 32; ++n) {
            const bf16_t* cur = ST + (n & 1) * 32 * SP; bf16_t* nxt = ST + ((n & 1) ^ 1) * 32 * SP;
            const size_t ib = ((size_t)bh * 32 + n) * 16384;
            {
                const int col = tid >> 4, chn = tid & 15;
                *(u32x4*)(SnT + ib + (size_t)(32 * sl + col) * 128 + 8 * chn) = *(const u32x4*)(cur + col * SP + 8 * chn);
            }
            if (n == 31) break;
            bf16x8 a[4]; u32x2 bm[2];
#pragma unroll
            for (int ks = 0; ks < 4; ++ks) a[ks] = an[ks];
            bm[0] = bmn[0]; bm[1] = bmn[1];
            const float eg = egn;
            if (n + 1 < 31) {
                const size_t ib2 = ib + 16384;
#pragma unroll
                for (int ks = 0; ks < 4; ++ks) an[ks] = *(const bf16x8*)(negM + ib2 + (size_t)(16 * wid + fr) * 128 + 32 * ks + 8 * fq);
#pragma unroll
                for (int nn = 0; nn < 2; ++nn) bmn[nn] = *(const u32x2*)(BmT + ib2 + (size_t)(32 * sl + 16 * nn + fr) * 128 + 16 * wid + 4 * fq);
                egn = egl[bh * 32 + n + 1];
            }
#pragma unroll
            for (int nn = 0; nn < 2; ++nn) {
                acc[nn][0] = eg * acc[nn][0] + bflo(bm[nn].x); acc[nn][1] = eg * acc[nn][1] + bfhi(bm[nn].x);
                acc[nn][2] = eg * acc[nn][2] + bflo(bm[nn].y); acc[nn][3] = eg * acc[nn][3] + bfhi(bm[nn].y);
#pragma unroll
                for (int ks = 0; ks < 4; ++ks) {
                    const bf16x8 sb = *(const bf16x8*)(cur + (16 * nn + fr) * SP + 32 * ks + 8 * fq);
                    acc[nn] = mfma16(a[ks], sb, acc[nn]);
                }
                u32x2 o; o.x = pk2(acc[nn][0], acc[nn][1]); o.y = pk2(acc[nn][2], acc[nn][3]);
                *(u32x2*)(nxt + (16 * nn + fr) * SP + 16 * wid + 4 * fq) = o;
            }
            __syncthreads();
        }
    }
}

__device__ void dn3_phase(const Params& P, unsigned char* lds, int bid, int nblk) {
    const int tid = opaque_tid(), wid = tid >> 6, lane = tid & 63, fr = lane & 15, fq = lane >> 4;
    const bf16_t* SnT = (const bf16_t*)(P.ws + WS_SNT); const bf16_t* Qp = (const bf16_t*)(P.ws + WS_QP); const bf16_t* Ol = (const bf16_t*)(P.ws + WS_OL);
    const bf16_t* pb = (const bf16_t*)(P.ws + WS_PB); bf16_t* mix = (bf16_t*)(P.ws + WS_H);
    constexpr int SP3 = 136, SBUF = 128 * SP3 * 2;
    static_assert(4 * SBUF <= LDS_BYTES - 32, "dn3 staging");
    const int half = wid >> 2, q4 = wid & 3, th = tid & 255;
    struct Ops { u32x4 sv[8]; bf16x8 bq[4]; u32x2 olv[8], zv[8]; };
    auto loadOps = [&](int it2, Ops& o) {
        const int item = it2 * 2 + half;
        const int n = item & 31, bh = item >> 5, h = bh & 3, b = bh >> 2;
        const int i = 16 * q4 + fr;
        const bf16_t* sb = SnT + (size_t)item * 16384;
#pragma unroll
        for (int k = 0; k < 8; ++k) o.sv[k] = *(const u32x4*)(sb + (size_t)(th + 256 * k) * 8);
        const bf16_t* qrow = Qp + (size_t)item * 8192 + (size_t)i * 128;
#pragma unroll
        for (int ks = 0; ks < 4; ++ks) o.bq[ks] = *(const bf16x8*)(qrow + 32 * ks + 8 * fq);
        const bf16_t* olr = Ol + (size_t)item * 8192 + (size_t)i * 128;
        const size_t tok = (size_t)b * SEQ + n * 64 + i;
#pragma unroll
        for (int dt = 0; dt < 8; ++dt) { o.olv[dt] = *(const u32x2*)(olr + 16 * dt + 4 * fq); o.zv[dt] = *(const u32x2*)(pb + tok * PBW + 1536 + h * 128 + 16 * dt + 4 * fq); }
    };
    Ops cur;
    if (bid < 1024) loadOps(bid, cur);
    int par = 0;
    for (int it2 = bid; it2 < 1024; it2 += nblk, par ^= 1) {
        const int item = it2 * 2 + half;
        const int n = item & 31, bh = item >> 5, h = bh & 3, b = bh >> 2;
        const int i = 16 * q4 + fr;
        const size_t tok = (size_t)b * SEQ + n * 64 + i;
        unsigned char* SB = lds + (par * 2 + half) * SBUF;
#pragma unroll
        for (int k = 0; k < 8; ++k) { const int piece = th + 256 * k; *(u32x4*)(SB + (piece >> 4) * (SP3 * 2) + (piece & 15) * 16) = cur.sv[k]; }
        bf16x8 bq[4]; u32x2 olv[8], zv[8];
#pragma unroll
        for (int ks = 0; ks < 4; ++ks) bq[ks] = cur.bq[ks];
#pragma unroll
        for (int dt = 0; dt < 8; ++dt) { olv[dt] = cur.olv[dt]; zv[dt] = cur.zv[dt]; }
        __syncthreads();
        if (it2 + nblk < 1024) loadOps(it2 + nblk, cur);
        __builtin_amdgcn_sched_barrier(0);
        f32x4 acc[8];
#pragma unroll
        for (int dt = 0; dt < 8; ++dt) {
            acc[dt] = (f32x4){bflo(olv[dt].x), bfhi(olv[dt].x), bflo(olv[dt].y), bfhi(olv[dt].y)};
#pragma unroll
            for (int ks = 0; ks < 4; ++ks) { const bf16x8 a = *(const bf16x8*)(SB + (16 * dt + fr) * (SP3 * 2) + (32 * ks + 8 * fq) * 2); acc[dt] = mfma16(a, bq[ks], acc[dt]); }
        }
        float ss = 0.f;
#pragma unroll
        for (int dt = 0; dt < 8; ++dt) ss += acc[dt][0] * acc[dt][0] + acc[dt][1] * acc[dt][1] + acc[dt][2] * acc[dt][2] + acc[dt][3] * acc[dt][3];
        ss += __shfl_xor(ss, 16); ss += __shfl_xor(ss, 32);
        const float rstd = rsqrtf(ss * (1.0f / 128.0f) + EPS);
#pragma unroll
        for (int dt = 0; dt < 8; ++dt) {
            const int dv = 16 * dt + 4 * fq;
            const u32x2 z = zv[dt];
            const f32x4 gn = *(const f32x4*)(P.dn_out_gain + dv);
            u32x2 o;
            o.x = pk2(acc[dt][0] * rstd * gn[0] * silu_f(bflo(z.x)), acc[dt][1] * rstd * gn[1] * silu_f(bfhi(z.x)));
            o.y = pk2(acc[dt][2] * rstd * gn[2] * silu_f(bflo(z.y)), acc[dt][3] * rstd * gn[3] * silu_f(bfhi(z.y)));
            *(u32x2*)(mix + tok * DM + 512 + h * 128 + dv) = o;
        }
    }
}

__device__ __forceinline__ void sort16_desc(float (&v)[16]) {
#define CE_(A, B) { const float hi_ = fmaxf(v[A], v[B]), lo_ = fminf(v[A], v[B]); v[A] = hi_; v[B] = lo_; }
    CE_(0,13) CE_(1,12) CE_(2,15) CE_(3,14) CE_(4,8) CE_(5,6) CE_(7,11) CE_(9,10)
    CE_(0,5) CE_(1,7) CE_(2,9) CE_(3,4) CE_(6,13) CE_(8,14) CE_(10,15) CE_(11,12)
    CE_(0,1) CE_(2,3) CE_(4,5) CE_(6,8) CE_(7,9) CE_(10,11) CE_(12,13) CE_(14,15)
    CE_(0,2) CE_(1,3) CE_(4,10) CE_(5,11) CE_(6,7) CE_(8,9) CE_(12,14) CE_(13,15)
    CE_(1,2) CE_(3,12) CE_(4,6) CE_(5,7) CE_(8,10) CE_(9,11) CE_(13,14)
    CE_(1,4) CE_(2,6) CE_(5,8) CE_(7,10) CE_(9,13) CE_(11,14)
    CE_(2,4) CE_(3,6) CE_(9,12) CE_(11,13)
    CE_(3,5) CE_(6,8) CE_(7,9) CE_(10,12)
    CE_(3,4) CE_(5,6) CE_(7,8) CE_(9,10) CE_(11,12)
    CE_(6,7) CE_(8,9)
#undef CE_
}
__device__ __forceinline__ void merge_top16(float (&a)[16], const float (&b)[16]) {
#pragma unroll
    for (int i = 0; i < 16; ++i) a[i] = fmaxf(a[i], b[15 - i]);
#pragma unroll
    for (int j = 8; j > 0; j >>= 1) {
#pragma unroll
        for (int i = 0; i < 16; ++i) {
            const int l = i ^ j;
            if (l > i) { const float hi = fmaxf(a[i], a[l]), lo = fminf(a[i], a[l]); a[i] = hi; a[l] = lo; }
        }
    }
}
__device__ __forceinline__ unsigned lut16(unsigned long long lo, unsigned long long hi, unsigned idx) {
    const unsigned long long w = (idx & 8u) ? hi : lo;
    return (unsigned)(w >> ((idx & 7u) * 8u)) & 127u;
}

__device__ void route_phase(const Params& P, unsigned char* lds, int bid, int nblk) {
    const int tid = opaque_tid(), wid = tid >> 6, lane = tid & 63, l31 = lane & 31, hh = lane >> 5;
    const bf16_t* qry = (const bf16_t*)(P.ws + WS_PB); const bf16_t* skp = (const bf16_t*)(P.ws + WS_SK);
    {
#pragma unroll
        for (int i = 0; i < 8; ++i) {
            const int f = wid * 8 + i, p = f >> 5, kt = (f >> 3) & 3, ks = f & 7;
            const u32x4 v = *(const u32x4*)(skp + p * 16384 + (32 * kt + l31) * 128 + 16 * ks + 8 * hh);
            *(u32x4*)(lds + f * 1024 + lane * 16) = v;
        }
        __syncthreads();
    }
    for (int wi = bid * 8 + wid; wi < 1024 * 8; wi += nblk * 8) {
        const int tg = wi >> 3, hd = wi & 7;
        const int tok = tg * 32 + l31;
        const bf16_t* qrow = qry + (size_t)tok * 2048 + hd * 256;
        float top[2][16];
        float ssq = 0.f;
        bf16x8 bq[2][8];
#pragma unroll
        for (int p = 0; p < 2; ++p)
#pragma unroll
            for (int ks = 0; ks < 8; ++ks) {
                bq[p][ks] = *(const bf16x8*)(qrow + 128 * p + 16 * ks + 8 * hh);
                const u32x4 u = __builtin_bit_cast(u32x4, bq[p][ks]);
                ssq += bflo(u.x) * bflo(u.x) + bfhi(u.x) * bfhi(u.x) + bflo(u.y) * bflo(u.y) + bfhi(u.y) * bfhi(u.y) + bflo(u.z) * bflo(u.z) + bfhi(u.z) * bfhi(u.z) +
                       bflo(u.w) * bflo(u.w) + bfhi(u.w) * bfhi(u.w);
            }
        ssq += __shfl_xor(ssq, 32);
        const float rstd = rsqrtf(ssq * (1.0f / 256.0f) + EPS);
#pragma unroll
        for (int p = 0; p < 2; ++p) {
            float run[16];
#pragma unroll
            for (int kt = 0; kt < 4; ++kt) {
                __builtin_amdgcn_sched_barrier(0);
                f32x16 s;
#pragma unroll
                for (int r = 0; r < 16; ++r) s[r] = 0.f;
#pragma unroll
                for (int ks = 0; ks < 8; ++ks) { const bf16x8 a = *(const bf16x8*)(lds + ((p * 4 + kt) * 8 + ks) * 1024 + lane * 16); s = mfma32(a, bq[p][ks], s); }
                float cur[16];
#pragma unroll
                for (int r = 0; r < 16; ++r) {
                    const unsigned key = 32 * kt + (r & 3) + 8 * (r >> 2) + 4 * hh;
                    cur[r] = __uint_as_float((__float_as_uint(s[r] * rstd) & ~127u) | key);
                }
                sort16_desc(cur);
                if (kt == 0) {
#pragma unroll
                    for (int r = 0; r < 16; ++r) run[r] = cur[r];
                } else merge_top16(run, cur);
            }
            float oth[16];
#pragma unroll
            for (int r = 0; r < 16; ++r) oth[r] = __shfl_xor(run[r], 32);
            merge_top16(run, oth);
#pragma unroll
            for (int r = 0; r < 16; ++r) top[p][r] = run[r];
        }
        float v1[16], v2[16];
        unsigned long long p1lo = 0ull, p1hi = 0ull, p2lo = 0ull, p2hi = 0ull;
#pragma unroll
        for (int r = 0; r < 16; ++r) {
            const unsigned u1 = __float_as_uint(top[0][r]), u2 = __float_as_uint(top[1][r]);
            v1[r] = __uint_as_float(u1 & ~127u); v2[r] = __uint_as_float(u2 & ~127u);
            if (r < 8) { p1lo |= (unsigned long long)(u1 & 127u) << (8 * r); p2lo |= (unsigned long long)(u2 & 127u) << (8 * r); }
            else { p1hi |= (unsigned long long)(u1 & 127u) << (8 * (r - 8)); p2hi |= (unsigned long long)(u2 & 127u) << (8 * (r - 8)); }
        }
#define CAND(a, b) __uint_as_float((__float_as_uint(v1[a] + v2[b]) & ~255u) | (unsigned)((a) * 16 + (b)))
        const float NEG = -3.0e38f;
        float g0[16], g1[16], g2[16], g3[16];
#pragma unroll
        for (int r = 0; r < 16; ++r) g0[r] = CAND(0, r);
        g1[0] = CAND(1, 0); g1[1] = CAND(1, 1); g1[2] = CAND(1, 2); g1[3] = CAND(1, 3); g1[4] = CAND(1, 4); g1[5] = CAND(1, 5); g1[6] = CAND(1, 6); g1[7] = CAND(1, 7);
        g1[8] = CAND(2, 0); g1[9] = CAND(2, 1); g1[10] = CAND(2, 2); g1[11] = CAND(2, 3); g1[12] = CAND(2, 4); g1[13] = CAND(4, 0); g1[14] = CAND(4, 1); g1[15] = CAND(4, 2);
        g2[0] = CAND(3, 0); g2[1] = CAND(3, 1); g2[2] = CAND(3, 2); g2[3] = CAND(3, 3); g2[4] = CAND(5, 0); g2[5] = CAND(5, 1); g2[6] = CAND(6, 0); g2[7] = CAND(6, 1);
        g2[8] = CAND(7, 0); g2[9] = CAND(7, 1); g2[10] = CAND(8, 0); g2[11] = CAND(9, 0); g2[12] = CAND(10, 0); g2[13] = CAND(11, 0); g2[14] = CAND(12, 0); g2[15] = CAND(13, 0);
        g3[0] = CAND(14, 0); g3[1] = CAND(15, 0);
#pragma unroll
        for (int r = 2; r < 16; ++r) g3[r] = NEG;
#undef CAND
        sort16_desc(g1); sort16_desc(g2); sort16_desc(g3);
        merge_top16(g0, g1); merge_top16(g2, g3); merge_top16(g0, g2);
        float e[16], es = 0.f; int eid[16];
        const float m0 = __uint_as_float(__float_as_uint(g0[0]) & ~255u);
#pragma unroll
        for (int r = 0; r < 16; ++r) {
            const unsigned u = __float_as_uint(g0[r]);
            const float sv = __uint_as_float(u & ~255u);
            e[r] = __expf(sv - m0); es += e[r];
            const unsigned a = (u >> 4) & 15u, bb = u & 15u;
            eid[r] = (int)(lut16(p1lo, p1hi, a) * 128u + lut16(p2lo, p2hi, bb));
        }
        const float inv = 1.0f / es;
        if (hh == 0) {
            {
                bf16_t* i16 = (bf16_t*)(P.ws + WS_IDS16) + ((size_t)tok * 8 + hd) * 16;
                u32x4 a0, a1;
                a0.x = (unsigned)eid[0] | ((unsigned)eid[1] << 16); a0.y = (unsigned)eid[2] | ((unsigned)eid[3] << 16); a0.z = (unsigned)eid[4] | ((unsigned)eid[5] << 16); a0.w = (unsigned)eid[6] | ((unsigned)eid[7] << 16);
                a1.x = (unsigned)eid[8] | ((unsigned)eid[9] << 16); a1.y = (unsigned)eid[10] | ((unsigned)eid[11] << 16); a1.z = (unsigned)eid[12] | ((unsigned)eid[13] << 16); a1.w = (unsigned)eid[14] | ((unsigned)eid[15] << 16);
                *(u32x4*)i16 = a0; *(u32x4*)(i16 + 8) = a1;
                bf16_t* g16 = (bf16_t*)(P.ws + WS_GATES16) + ((size_t)tok * 8 + hd) * 16;
                u32x4 c0, c1;
                c0.x = pk2(e[0] * inv, e[1] * inv); c0.y = pk2(e[2] * inv, e[3] * inv); c0.z = pk2(e[4] * inv, e[5] * inv); c0.w = pk2(e[6] * inv, e[7] * inv);
                c1.x = pk2(e[8] * inv, e[9] * inv); c1.y = pk2(e[10] * inv, e[11] * inv); c1.z = pk2(e[12] * inv, e[13] * inv); c1.w = pk2(e[14] * inv, e[15] * inv);
                *(u32x4*)g16 = c0; *(u32x4*)(g16 + 8) = c1;
            }
        }
    }
}


#define XL_RANK(j) (3520 + 64 * (j))
struct XLabel { int NL, x, j, nloc; };
__device__ __forceinline__ XLabel xcd_label(const Params& P, const unsigned char* lds, int bid, int nblk) {
    XLabel L;
    L.NL = nblk < 8 ? nblk : 8; L.x = bid % L.NL; L.j = bid / L.NL; L.nloc = (nblk - L.x + L.NL - 1) / L.NL;
    const volatile unsigned* st = (const volatile unsigned*)(lds + LDS_BYTES - 16);
    const unsigned myx = st[2], myr = st[3];
    unsigned* bar = (unsigned*)P.ws;
    unsigned sum = 0u, mine = 0u; bool ok = true;
#pragma unroll
    for (unsigned k = 0; k < 8; ++k) { const unsigned c = __hip_atomic_load(&bar[256 + 64 * k], __ATOMIC_RELAXED, __HIP_MEMORY_SCOPE_AGENT); sum += c; ok = ok && (c > 0u); mine = (k == myx) ? c : mine; }
    if (ok && sum == (unsigned)nblk && myx < 8u && myr < mine) { L.NL = 8; L.x = (int)myx; L.j = (int)myr; L.nloc = (int)mine; }
    L.NL = __builtin_amdgcn_readfirstlane(L.NL); L.x = __builtin_amdgcn_readfirstlane(L.x); L.j = __builtin_amdgcn_readfirstlane(L.j); L.nloc = __builtin_amdgcn_readfirstlane(L.nloc);
    return L;
}

typedef int i32x2 __attribute__((ext_vector_type(2)));
typedef _Float16 f16x2h __attribute__((ext_vector_type(2)));
struct DnIds { u32x4 i0, i1; };
constexpr int DTB = 32;
constexpr int DR_IDS = 0, DR_H = 8192, DN_REGION = 12288;
static_assert(8 * DN_REGION <= LDS_BYTES - 32, "down-pass staging regions");
__device__ void peer_down_phase(const Params& P, unsigned char* lds, int bid, int nblk) {
    const int tid0 = opaque_tid(), wid = __builtin_amdgcn_readfirstlane(tid0 >> 6);
    int lane_v = tid0 & 63;
    const signed char* ed8 = (const signed char*)(P.ws + WS_ED8); const signed char* h8 = (const signed char*)(P.ws + WS_H8);
    const bf16_t* ids16 = (const bf16_t*)(P.ws + WS_IDS16); int* part = (int*)(P.ws + WS_PART);
    const XLabel XL = xcd_label(P, lds, bid, nblk);
    const int NL = XL.NL, x = XL.x, j = XL.j, nloc = XL.nloc;
    const int nw = nloc * 8, widx = j * 8 + wid;
    const int per = (((NTOK + nw - 1) / nw) + DTB - 1) / DTB * DTB;
    const int t0 = widx * per, t1 = (t0 + per) < NTOK ? (t0 + per) : NTOK;
    if (t0 >= t1) return;
    unsigned char* R = lds + wid * DN_REGION;
    for (int s = x; s < 8; s += NL) {
        asm volatile("" : "+v"(lane_v));
        const int lane = lane_v, e = lane >> 3, ch = lane & 7;
        const bool c0 = (lane & 1) != 0, c1 = (lane & 2) != 0, c2 = (lane & 4) != 0;
        auto issueH = [&](u32x4 (&S)[8], const DnIds& c, const int hf) {
            const signed char* base = ed8 + (size_t)s * NEXP * 128 + 16 * ch;
#pragma unroll
            for (int b = 0; b < 8; ++b) {
                const unsigned word = hf ? c.i1[b >> 1] : c.i0[b >> 1];
                const unsigned id = (b & 1) ? (word >> 16) : (word & 0xffffu);
                S[b] = *(const u32x4*)(base + (size_t)id * 128);
            }
        };
        auto computeH = [&](const u32x4 (&S)[8], const u32x4& h, int (&d)[16], const int hf) {
#pragma unroll
            for (int b = 0; b < 8; ++b) {
                int t = 0;
                t = __builtin_amdgcn_sdot4((int)S[b].x, (int)h.x, t, false); t = __builtin_amdgcn_sdot4((int)S[b].y, (int)h.y, t, false);
                t = __builtin_amdgcn_sdot4((int)S[b].z, (int)h.z, t, false); t = __builtin_amdgcn_sdot4((int)S[b].w, (int)h.w, t, false);
                const int bb = 8 * hf + b;
                d[(bb >> 1) + 8 * (bb & 1)] = t;
            }
        };
        int nbn = DTB - 4 * wid;
        for (int blk = t0, nb; blk < t1; blk += nb, nbn = DTB) {
            nb = nbn;
            nb = (t1 - blk) < nb ? (t1 - blk) : nb;
            {
                u32x4 st[12];
                const char* gi = (const char*)ids16 + (size_t)blk * 256 + lane * 16;
#pragma unroll
                for (int k = 0; k < 8; ++k) st[k] = *(const u32x4*)(gi + k * 1024);
                const char* gh = (const char*)h8 + ((size_t)(blk + (lane >> 3)) * DM + 128 * s) + (lane & 7) * 16;
#pragma unroll
                for (int k = 0; k < 4; ++k) st[8 + k] = *(const u32x4*)(gh + (size_t)k * 8 * DM);
                unsigned char* Rl = R + lane * 16;
#pragma unroll
                for (int k = 0; k < 8; ++k) *(u32x4*)(Rl + DR_IDS + k * 1024) = st[k];
#pragma unroll
                for (int k = 0; k < 4; ++k) *(u32x4*)(Rl + DR_H + k * 1024) = st[8 + k];
            }
            auto ldsIds = [&](int tt) -> DnIds { const u32x4* p = (const u32x4*)(R + DR_IDS + tt * 256 + 32 * e); DnIds c; c.i0 = p[0]; c.i1 = p[1]; return c; };
            u32x4 HA[8], HB[8];
            {
                const DnIds ic = ldsIds(0);
                issueH(HA, ic, 0); __builtin_amdgcn_sched_barrier(0); issueH(HB, ic, 1);
                __builtin_amdgcn_sched_barrier(0);
            }
            auto iter = [&](const int tt, auto moreTag) {
                constexpr bool more = decltype(moreTag)::value;
                const DnIds inx = ldsIds(more ? tt + 1 : tt);
                const u32x4 hreg = *(const u32x4*)(R + DR_H + tt * 128 + 16 * ch);
                int d[16];
                computeH(HA, hreg, d, 0); __builtin_amdgcn_sched_barrier(0); if constexpr (more) issueH(HA, inx, 0); __builtin_amdgcn_sched_barrier(0);
                computeH(HB, hreg, d, 1); __builtin_amdgcn_sched_barrier(0); if constexpr (more) issueH(HB, inx, 1); __builtin_amdgcn_sched_barrier(0);
                int e8[8], f4[4], g2[2];
#pragma unroll
                for (int q = 0; q < 8; ++q) { const int keep = c0 ? d[2 * q + 1] : d[2 * q], send = c0 ? d[2 * q] : d[2 * q + 1]; e8[q] = keep + __shfl_xor(send, 1); }
#pragma unroll
                for (int q = 0; q < 4; ++q) { const int keep = c1 ? e8[2 * q + 1] : e8[2 * q], send = c1 ? e8[2 * q] : e8[2 * q + 1]; f4[q] = keep + __shfl_xor(send, 2); }
#pragma unroll
                for (int q = 0; q < 2; ++q) { const int keep = c2 ? f4[2 * q + 1] : f4[2 * q], send = c2 ? f4[2 * q] : f4[2 * q + 1]; g2[q] = keep + __shfl_xor(send, 4); }
                const auto pk = __builtin_amdgcn_cvt_pkrtz((float)g2[0] * 0.015625f, (float)g2[1] * 0.015625f);
                *(unsigned*)(part + ((size_t)s * NTOK + (size_t)(blk + tt)) * 64 + 8 * e + ch) = __builtin_bit_cast(unsigned, pk);
            };
            for (int tt = 0; tt + 1 < nb; ++tt) iter(tt, std::true_type{});
            iter(nb - 1, std::false_type{});
        }
    }
}

__device__ __forceinline__ float gelu_erf(float v) {
    const float av = fabsf(v), t = __builtin_amdgcn_rcpf(av * 0.2316418882f + 1.0f);
    float q = t * 0.5307027145f + (-0.7265760135f); q = q * t + 0.7107068705f; q = q * t + (-0.142248368f); q = q * t + 0.127414796f; q = q * t;
    const float ex = __builtin_amdgcn_exp2f(v * v * (-0.72134752044f));
    const float m = v * (q * ex);
    return v < 0.f ? m : v - m;
}
__device__ void peer_combine_phase(const Params& P, unsigned char* lds, int bid, int nblk) {
    const int tid = opaque_tid(), wid = tid >> 6, lane = tid & 63;
    const int* part = (const int*)(P.ws + WS_PART);
    const float* SD = (const float*)(P.ws + WS_SD); const float* SU = (const float*)(P.ws + WS_SU); const float* HS = (const float*)(P.ws + WS_HS);
    const unsigned* ids16 = (const unsigned*)(P.ws + WS_IDS16); const unsigned* gates16 = (const unsigned*)(P.ws + WS_GATES16);
    unsigned short* wq = (unsigned short*)(P.ws + WS_WQ8); float* wsc = (float*)(P.ws + WS_WSC);
    static_assert(2 * NEXP * 4 <= LDS_BYTES - 32, "combine tables");
    float* sdL = (float*)lds; float* suL = sdL + NEXP;
    {
#pragma unroll
        for (int k = 0; k < 8; ++k) { const int o = (tid + 512 * k) * 4; *(f32x4*)(sdL + o) = *(const f32x4*)(SD + o); *(f32x4*)(suL + o) = *(const f32x4*)(SU + o); }
        __syncthreads();
    }
    constexpr int CU_ = 4;
    const int tstep = nblk * 8;
    for (int tok0 = bid * 8 + wid; tok0 < NTOK; tok0 += CU_ * tstep) {
        unsigned pv[CU_][8]; unsigned idp[CU_], gtp[CU_]; float hs[CU_]; int tk[CU_];
#pragma unroll
        for (int u = 0; u < CU_; ++u) {
            const int t = tok0 + u * tstep; tk[u] = t < NTOK ? t : tok0;
#pragma unroll
            for (int s = 0; s < 8; ++s) pv[u][s] = *(const unsigned*)(part + ((size_t)s * NTOK + tk[u]) * 64 + lane);
            idp[u] = ids16[(size_t)tk[u] * 64 + lane]; gtp[u] = gates16[(size_t)tk[u] * 64 + lane]; hs[u] = HS[tk[u]];
        }
        __builtin_amdgcn_sched_barrier(0);
        float sd0[CU_], sd1[CU_], su0[CU_], su1[CU_];
#pragma unroll
        for (int u = 0; u < CU_; ++u) { const unsigned id0 = idp[u] & 0xffffu, id1 = idp[u] >> 16; sd0[u] = sdL[id0]; sd1[u] = sdL[id1]; su0[u] = suL[id0]; su1[u] = suL[id1]; }
        __builtin_amdgcn_sched_barrier(0);
#pragma unroll
        for (int u = 0; u < CU_; ++u) {
            float a0 = 0.f, a1 = 0.f;
#pragma unroll
            for (int s = 0; s < 8; ++s) { const f16x2h hv = __builtin_bit_cast(f16x2h, pv[u][s]); a0 += (float)hv[0]; a1 += (float)hv[1]; }
            const float f0 = a0 * 64.0f * sd0[u] * hs[u], f1 = a1 * 64.0f * sd1[u] * hs[u];
            const float w0 = bflo(gtp[u]) * gelu_erf(f0) * su0[u], w1 = bfhi(gtp[u]) * gelu_erf(f1) * su1[u];
            float am = fmaxf(fabsf(w0), fabsf(w1));
            am = fmaxf(am, __shfl_xor(am, 1)); am = fmaxf(am, __shfl_xor(am, 2)); am = fmaxf(am, __shfl_xor(am, 4)); am = fmaxf(am, __shfl_xor(am, 16)); am = fmaxf(am, __shfl_xor(am, 32));
            am = am > 0.f ? am : 1.0f;
            const float inv = 127.0f / am;
            const int q0 = (int)rintf(w0 * inv), q1 = (int)rintf(w1 * inv);
            wq[(size_t)tk[u] * 64 + lane] = (unsigned short)((unsigned)(q0 & 255) | ((unsigned)(q1 & 255) << 8));
            if ((lane & 0x37) == 0) wsc[(size_t)tk[u] * 2 + (lane >> 3)] = am * (1.0f / 127.0f);
        }
    }
}

typedef float f32x2 __attribute__((ext_vector_type(2)));
typedef int i32x4 __attribute__((ext_vector_type(4)));
struct UpIds { u32x4 i0, i1; };
constexpr int UTB = 16;
constexpr int UR_IDS = 0, UR_WQ = 4096, UR_X = 6144, UR_DL = 14336, UR_SC = 18432, UP_REGION = 18560;
static_assert(8 * UP_REGION <= LDS_BYTES - 32, "up-pass staging regions");
__device__ void peer_up_phase(const Params& P, unsigned char* lds, int bid, int nblk) {
    const int tid0 = opaque_tid(), wid = __builtin_amdgcn_readfirstlane(tid0 >> 6);
    int lane_v = tid0 & 63;
    const signed char* eu8 = (const signed char*)(P.ws + WS_EU8);
    const bf16_t* dlt = (const bf16_t*)(P.ws + WS_DLT);
    const bf16_t* ids16 = (const bf16_t*)(P.ws + WS_IDS16); const signed char* wq8 = (const signed char*)(P.ws + WS_WQ8); const float* wsc = (const float*)(P.ws + WS_WSC);
    const float* mod = (const float*)(P.ws + WS_MOD);
    const XLabel XL = xcd_label(P, lds, bid, nblk);
    const int NL = XL.NL, x = XL.x, j = XL.j, nloc = XL.nloc;
    const int nw = nloc * 8, widx = j * 8 + wid;
    const int per = (((NTOK + nw - 1) / nw) + UTB - 1) / UTB * UTB;
    const int t0 = widx * per, t1 = (t0 + per) < NTOK ? (t0 + per) : NTOK;
    if (t0 >= t1) return;
    unsigned char* R = lds + wid * UP_REGION;
    for (int s = x; s < 8; s += NL) {
        asm volatile("" : "+v"(lane_v));
        const int lane = lane_v, e = lane >> 3, ch = lane & 7;
        const bool hi = (lane & 8) != 0;
        const int colp = 16 * ch + 4 * (lane >> 4) + (hi ? 2 : 0), col = 128 * s + colp;
        unsigned mk[4];
#pragma unroll
        for (int r = 0; r < 4; ++r) mk[r] = (((lane & 15) >> 2) == r) ? (0xFFu << (8 * (lane & 3))) : 0u;
        auto issueH = [&](u32x4 (&S)[8], const UpIds& c, const int hf) {
            const signed char* base = eu8 + (size_t)s * NEXP * 128 + 16 * ch;
#pragma unroll
            for (int b = 0; b < 8; ++b) {
                const unsigned word = hf ? c.i1[b >> 1] : c.i0[b >> 1];
                const unsigned id = (b & 1) ? (word >> 16) : (word & 0xffffu);
                S[b] = *(const u32x4*)(base + (size_t)id * 128);
            }
        };
        auto computeH = [&](const u32x4 (&S)[8], const u32x4& wa, const u32x4& wb, i32x4& acc0, i32x4& acc1, const int hf) {
#pragma unroll
            for (int b = 0; b < 8; ++b) {
                const int bb = 8 * hf + b;
                const unsigned sel = 0x01010101u * (unsigned)(bb & 3);
                const unsigned r0 = __builtin_amdgcn_perm(wa[bb >> 2], wa[bb >> 2], sel), r1 = __builtin_amdgcn_perm(wb[bb >> 2], wb[bb >> 2], sel);
                const i32x4 A0 = {(int)(r0 & mk[0]), (int)(r0 & mk[1]), (int)(r0 & mk[2]), (int)(r0 & mk[3])};
                const i32x4 A1 = {(int)(r1 & mk[0]), (int)(r1 & mk[1]), (int)(r1 & mk[2]), (int)(r1 & mk[3])};
                const i32x4 Bv = {(int)S[b].x, (int)S[b].y, (int)S[b].z, (int)S[b].w};
                acc0 = __builtin_amdgcn_mfma_i32_16x16x64_i8(A0, Bv, acc0, 0, 0, 0);
                acc1 = __builtin_amdgcn_mfma_i32_16x16x64_i8(A1, Bv, acc1, 0, 0, 0);
            }
        };
        int nbn = UTB - 2 * wid;
        for (int blk = t0, nb; blk < t1; blk += nb, nbn = UTB) {
            nb = nbn;
            nb = (t1 - blk) < nb ? (t1 - blk) : nb;
            nb = (2048 - (blk & 2047)) < nb ? (2048 - (blk & 2047)) : nb;
            {
                u32x4 st[18];
                const u32x4 stsc = *(const u32x4*)((const char*)wsc + (size_t)blk * 8 + (lane & 7) * 16);
                const char* gi = (const char*)ids16 + (size_t)blk * 256 + lane * 16;
#pragma unroll
                for (int k = 0; k < 4; ++k) st[k] = *(const u32x4*)(gi + k * 1024);
                const char* gw = (const char*)wq8 + (size_t)blk * 128 + lane * 16;
#pragma unroll
                for (int k = 0; k < 2; ++k) st[4 + k] = *(const u32x4*)(gw + k * 1024);
                const char* gx = (const char*)P.x + (size_t)(128 * s) * 4 + (lane & 31) * 16;
#pragma unroll
                for (int k = 0; k < 8; ++k) { int tx = blk + 2 * k + (lane >> 5); tx = tx < NTOK ? tx : NTOK - 1; st[6 + k] = *(const u32x4*)(gx + (size_t)tx * DM * 4); }
                const char* gd = (const char*)dlt + ((size_t)(blk + (lane >> 4)) * DM + 128 * s) * 2 + (lane & 15) * 16;
#pragma unroll
                for (int k = 0; k < 4; ++k) st[14 + k] = *(const u32x4*)(gd + (size_t)k * 4 * DM * 2);
                unsigned char* Rl = R + lane * 16;
#pragma unroll
                for (int k = 0; k < 4; ++k) *(u32x4*)(Rl + UR_IDS + k * 1024) = st[k];
#pragma unroll
                for (int k = 0; k < 2; ++k) *(u32x4*)(Rl + UR_WQ + k * 1024) = st[4 + k];
#pragma unroll
                for (int k = 0; k < 8; ++k) *(u32x4*)(Rl + UR_X + k * 1024) = st[6 + k];
#pragma unroll
                for (int k = 0; k < 4; ++k) *(u32x4*)(Rl + UR_DL + k * 1024) = st[14 + k];
                if (lane < 8) *(u32x4*)(Rl + UR_SC) = stsc;
            }
            const f32x2 g2 = *(const f32x2*)(mod + (blk >> 11) * 6144 + 5120 + col);
            auto ldsIds = [&](int tt) -> UpIds { const u32x4* p = (const u32x4*)(R + UR_IDS + tt * 256 + 32 * e); UpIds c; c.i0 = p[0]; c.i1 = p[1]; return c; };
            u32x4 HA[8], HB[8];
            {
                const UpIds ic = ldsIds(0);
                issueH(HA, ic, 0); __builtin_amdgcn_sched_barrier(0); issueH(HB, ic, 1);
                __builtin_amdgcn_sched_barrier(0);
            }
            auto iter = [&](const int tt, auto moreTag) {
                constexpr bool more = decltype(moreTag)::value;
                const UpIds inx = ldsIds(more ? tt + 1 : tt);
                const u32x4* wp = (const u32x4*)(R + UR_WQ + tt * 128 + 32 * (lane >> 4));
                const u32x4 w0 = wp[0], w1 = wp[1];
                const f32x2 xv = *(const f32x2*)(R + UR_X + tt * 512 + 4 * colp); const unsigned dv = *(const unsigned*)(R + UR_DL + tt * 256 + 2 * colp);
                const float scl = *(const float*)(R + UR_SC + tt * 8 + (hi ? 4 : 0));
                i32x4 acc0 = {0, 0, 0, 0}, acc1 = {0, 0, 0, 0};
                computeH(HA, w0, w1, acc0, acc1, 0); __builtin_amdgcn_sched_barrier(0); if constexpr (more) issueH(HA, inx, 0); __builtin_amdgcn_sched_barrier(0);
                computeH(HB, w0, w1, acc0, acc1, 1); __builtin_amdgcn_sched_barrier(0); if constexpr (more) issueH(HB, inx, 1); __builtin_amdgcn_sched_barrier(0);
                {
                    float v[4];
#pragma unroll
                    for (int r = 0; r < 4; ++r) v[r] = (float)(hi ? acc1[r] : acc0[r]) * scl;
                    const float k0 = hi ? v[2] : v[0], k1 = hi ? v[3] : v[1], s0 = hi ? v[0] : v[2], s1 = hi ? v[1] : v[3];
                    const float y0 = k0 + __shfl_xor(s0, 8), y1 = k1 + __shfl_xor(s1, 8);
                    f32x2 o; o[0] = xv[0] + bflo(dv) + g2[0] * y0; o[1] = xv[1] + bfhi(dv) + g2[1] * y1;
                    *(f32x2*)(P.out + (size_t)(blk + tt) * DM + col) = o;
                }
            };
            for (int tt = 0; tt + 1 < nb; ++tt) iter(tt, std::true_type{});
            iter(nb - 1, std::false_type{});
        }
    }
}

#define XB_TMO      128
#define XB_XCNT(j)  (256  + 64 * (j))
#define XB_XSUB(j)  (1280 + 64 * (j))
#define XB_XGEN(j)  (2304 + 64 * (j))
#define XB_TOP      3328
#define XB_TOPGEN   3392
#define XCD_BAR_WORDS 3456
#define XB_SPIN_CAP (1u << 23)
__device__ __forceinline__ unsigned xb_ld(unsigned* p)              { return __hip_atomic_load(p, __ATOMIC_RELAXED, __HIP_MEMORY_SCOPE_AGENT); }
__device__ __forceinline__ unsigned xb_add(unsigned* p, unsigned v) { return __hip_atomic_fetch_add(p, v, __ATOMIC_RELAXED, __HIP_MEMORY_SCOPE_AGENT); }
__device__ __forceinline__ unsigned xb_xcc_id() { return (unsigned)__builtin_amdgcn_s_getreg((3 << 11) | 20) & 0xFu; }
#define XB_SPIN(cond, bar) do { unsigned _sp = 0; while (cond) { __builtin_amdgcn_s_sleep(1); \
    if ((++_sp & 255u) == 0u) { if (xb_ld(&(bar)[XB_TMO])) break; if (_sp > XB_SPIN_CAP) { atomicAdd(&(bar)[XB_TMO], 1u); break; } } } } while (0)
struct XcdBarrier { unsigned* bar; unsigned x; volatile unsigned* st; };
__device__ __forceinline__ XcdBarrier xcd_barrier_post(unsigned* bar, volatile unsigned* st) {
    XcdBarrier b; b.bar = bar; b.x = xb_xcc_id(); b.st = st;
    if (threadIdx.x == 0) (void)xb_add(&bar[XB_XCNT(b.x)], 1u);
    return b;
}
__device__ __forceinline__ void xcd_barrier_complete(unsigned* bar, unsigned x, unsigned& nloc, unsigned& nx) {
    const unsigned G = gridDim.x * gridDim.y * gridDim.z;
    unsigned sum, cnt, mine, sp = 0u;
    for (;;) {
        sum = 0u; cnt = 0u; mine = 0u;
#pragma unroll
        for (unsigned j = 0; j < 16; ++j) { const unsigned c = xb_ld(&bar[XB_XCNT(j)]); sum += c; cnt += (c > 0u) ? 1u : 0u; mine = (j == x) ? c : mine; }
        if (sum == G) break;
        __builtin_amdgcn_s_sleep(1);
        if ((++sp & 255u) == 0u) { if (xb_ld(&bar[XB_TMO])) break; if (sp > XB_SPIN_CAP) { atomicAdd(&bar[XB_TMO], 1u); break; } }
    }
    nloc = mine > 0u ? mine : 1u; nx = cnt > 0u ? cnt : 1u;
}
__device__ __forceinline__ void xcd_barrier(const XcdBarrier& b) {
    asm volatile("s_waitcnt vmcnt(0)" ::: "memory");
    __syncthreads();
    if (threadIdx.x == 0) {
        unsigned* bar = b.bar;
        __builtin_amdgcn_s_waitcnt(0);
        unsigned nloc = b.st[0], nx = b.st[1];
        if (nloc == 0u) { xcd_barrier_complete(bar, b.x, nloc, nx); b.st[0] = nloc; b.st[1] = nx; }
        const unsigned old = xb_add(&bar[XB_XSUB(b.x)], 1u);
        const unsigned gen = old / nloc;
        if (old + 1u == (gen + 1u) * nloc) {
            __builtin_amdgcn_fence(__ATOMIC_RELEASE, "agent");
            asm volatile("s_waitcnt vmcnt(0)" ::: "memory");
            const unsigned og = xb_add(&bar[XB_TOP], 1u);
            const unsigned tg = og / nx;
            if (og + 1u == (tg + 1u) * nx) xb_add(&bar[XB_TOPGEN], 1u);
            else XB_SPIN(xb_ld(&bar[XB_TOPGEN]) == tg, bar);
            __builtin_amdgcn_fence(__ATOMIC_ACQUIRE, "agent");
            xb_add(&bar[XB_XGEN(b.x)], 1u);
            asm volatile("s_waitcnt vmcnt(0)" ::: "memory");
        } else {
            XB_SPIN(xb_ld(&bar[XB_XGEN(b.x)]) == gen, bar);
            __builtin_amdgcn_fence(__ATOMIC_ACQUIRE, "agent");
            asm volatile("s_waitcnt vmcnt(0)" ::: "memory");
        }
    }
    __syncthreads();
}

constexpr int NPHASES = 11;
__device__ __forceinline__ void run_phase(const Params& P, int ph, unsigned char* lds, int bid, int nblk) {
    const float* mod = (const float*)(P.ws + WS_MOD);
    switch (ph) {
        case 0: phase0(P, lds, bid, nblk); break;
        case 1: norm_mod_phase<true, false>(P, P.x, nullptr, nullptr, P.norm1_gain, mod, 0, 1024, (bf16_t*)(P.ws + WS_H), bid, nblk); break;
        case 2: {
            const bf16_t* h1 = (const bf16_t*)(P.ws + WS_H); const bf16_t* wt = (const bf16_t*)(P.ws + WS_WINT);
            EpiInAll e{EpiQK{P.q_gain, P.k_gain, (bf16_t*)(P.ws + WS_QA), (bf16_t*)(P.ws + WS_KA)}, EpiV{(bf16_t*)(P.ws + WS_VT)}, EpiBf{(bf16_t*)(P.ws + WS_PB), PBW}};
            gemm_run(h1, wt, NTOK, 3584, DM, e, lds, bid, nblk);
        } break;
        case 3: attn_phase(P, lds, bid, nblk); __syncthreads(); dn1_phase(P, lds, bid, nblk); break;
        case 4: dn2_phase(P, lds, bid, nblk); break;
        case 5: dn3_phase(P, lds, bid, nblk); break;
        case 6: {
            EpiOut e{mod, (bf16_t*)(P.ws + WS_DLT)};
            gemm_run((const bf16_t*)(P.ws + WS_H), (const bf16_t*)(P.ws + WS_WOUTT), NTOK, DM, DM, e, lds, bid, nblk);
        } break;
        case 7: norm_mod_phase<false, true>(P, P.x, (const bf16_t*)(P.ws + WS_DLT), P.out, P.norm2_gain, mod, 3072, 4096, (bf16_t*)(P.ws + WS_H), bid, nblk); break;
        case 8: {
            EpiBf e{(bf16_t*)(P.ws + WS_PB), 2048};
            gemm_run((const bf16_t*)(P.ws + WS_H), (const bf16_t*)(P.ws + WS_WQT), NTOK, 2048, DM, e, lds, bid, nblk);
        } break;
        case 9: route_phase(P, lds, bid, nblk); break;
        case 10: peer_down_phase(P, lds, bid, nblk); break;
        case 12: peer_combine_phase(P, lds, bid, nblk); break;
        case 11: peer_up_phase(P, lds, bid, nblk); break;
        default: break;
    }
}

#if MULTI_LAUNCH
template <int PH>
__global__ void __launch_bounds__(NTHREADS) k_phase(Params P) {
    __shared__ __attribute__((aligned(16))) unsigned char lds[LDS_BYTES];
    run_phase(P, PH, lds, blockIdx.x, gridDim.x);
}
#else
__global__ void __launch_bounds__(NTHREADS) k_mega(Params P) {
    __shared__ __attribute__((aligned(16))) unsigned char lds[LDS_BYTES];
    cg::grid_group grid = cg::this_grid();
    const int bid = blockIdx.x, nblk = gridDim.x;
    volatile unsigned* st = (volatile unsigned*)(lds + LDS_BYTES - 16);
    if (threadIdx.x == 0) {
        st[0] = 0u; st[1] = 0u;
        const unsigned xcc = xb_xcc_id();
        st[2] = xcc; st[3] = __hip_atomic_fetch_add((unsigned*)P.ws + XL_RANK(xcc & 7u), 1u, __ATOMIC_RELAXED, __HIP_MEMORY_SCOPE_AGENT);
    }
    __syncthreads();
    const XcdBarrier xb = xcd_barrier_post((unsigned*)P.ws, st);
#define PH_(N) run_phase(P, N, lds, bid, nblk)
#define XBAR() xcd_barrier(xb)
    if (P.ws == nullptr) grid.sync();
    PH_(0); XBAR(); PH_(1); XBAR(); PH_(2); XBAR(); PH_(3); XBAR(); PH_(4); XBAR(); PH_(5); XBAR();
    PH_(6); XBAR(); PH_(7); XBAR(); PH_(8); XBAR(); PH_(9); XBAR(); PH_(10); XBAR(); PH_(12); XBAR(); PH_(11);
#undef PH_
#undef XBAR
}
#endif

extern "C" void kernel_launch(void* const* d_in, const int* in_sizes, int n_in, void* d_out, int out_size, void* d_ws, size_t ws_size, hipStream_t stream) {
    static int grid = 0;
    if (grid == 0) {
        if (n_in != 22 || out_size != NTOK * DM || ws_size < WS_END) { fprintf(stderr, "kernel_launch: unexpected shapes (n_in %d out %d ws %zu)\n", n_in, out_size, ws_size); grid = -1; return; }
        int dev = 0, cus = 0, per_cu = 0;
        (void)hipGetDevice(&dev);
        (void)hipDeviceGetAttribute(&cus, hipDeviceAttributeMultiprocessorCount, dev);
#if MULTI_LAUNCH
        (void)hipOccupancyMaxActiveBlocksPerMultiprocessor(&per_cu, k_phase<3>, NTHREADS, 0);
#else
        (void)hipOccupancyMaxActiveBlocksPerMultiprocessor(&per_cu, k_mega, NTHREADS, 0);
#endif
        if (per_cu < 1) { fprintf(stderr, "kernel_launch: occupancy query says %d blocks per CU\n", per_cu); per_cu = 1; }
        grid = cus;
        (void)hipGetLastError();
    }
    if (grid < 0) return;
    Params p{};
    const float** pp = (const float**)&p;
    for (int i = 0; i < 22; ++i) pp[i] = (const float*)d_in[i];
    p.out = (float*)d_out; p.ws = (unsigned char*)d_ws;
#if MULTI_LAUNCH
    (void)hipMemsetAsync(d_ws, 0, 16384, stream);
#define LP_(PH) hipLaunchKernelGGL(k_phase<PH>, dim3(grid), dim3(NTHREADS), 0, stream, p)
    LP_(0); LP_(1); LP_(2); LP_(3); LP_(4); LP_(5); LP_(6); LP_(7); LP_(8); LP_(9); LP_(10); LP_(12); LP_(11);
#undef LP_
#else
    (void)hipMemsetAsync(d_ws, 0, 16384, stream);
    void* args[] = {&p};
    hipError_t e = hipLaunchCooperativeKernel((void*)k_mega, dim3(grid), dim3(NTHREADS), args, 0, stream);
    if (e != hipSuccess) fprintf(stderr, "cooperative launch failed: %s (grid %d)\n", hipGetErrorString(e), grid);
#endif
}
```

```cpp
#include <hip/hip_runtime.h>
#include <hip/hip_cooperative_groups.h>
#include <cstdio>
#include <cstdint>
#include <type_traits>
namespace cg = cooperative_groups;

#ifndef MULTI_LAUNCH
#define MULTI_LAUNCH 0
#endif

typedef unsigned short bf16_t;
typedef short bf16x8 __attribute__((ext_vector_type(8)));
typedef float f32x4 __attribute__((ext_vector_type(4)));
typedef float f32x16 __attribute__((ext_vector_type(16)));
typedef unsigned u32x4 __attribute__((ext_vector_type(4)));
typedef unsigned u32x2 __attribute__((ext_vector_type(2)));
typedef __bf16 bf16x2_t __attribute__((ext_vector_type(2)));

constexpr int NB = 16, SEQ = 2048, DM = 1024, NTOK = NB * SEQ;
constexpr int CH = 64, NCH = SEQ / CH;
constexpr int AH = 8, AHD = 64;
constexpr int DH = 4, DHD = 128;
constexpr int IPW = 3592, NPAD = 3712;
constexpr int PBW = 2048;
constexpr int NEXP = 16384;
constexpr float EPS = 1e-6f;
constexpr int NTHREADS = 512;

constexpr size_t MiB = 1u << 20;
constexpr size_t WS_MOD = 1 * MiB;
constexpr size_t WS_SK = 2 * MiB;
constexpr size_t WS_WINT = 3 * MiB;
constexpr size_t WS_WOUTT = 11 * MiB;
constexpr size_t WS_WQT = 13 * MiB;
constexpr size_t WS_ED8 = 17 * MiB;
constexpr size_t WS_PART = 145 * MiB;
constexpr size_t WS_EU8 = 33 * MiB;
constexpr size_t WS_H8 = 49 * MiB;
constexpr size_t WS_SD = 2 * MiB + 128 * 1024;
constexpr size_t WS_SU = 2 * MiB + 192 * 1024;
constexpr size_t WS_HS = 2 * MiB + 256 * 1024;
constexpr size_t WS_H = 81 * MiB;
constexpr size_t WS_PB = 145 * MiB;
constexpr size_t WS_QA = 273 * MiB;
constexpr size_t WS_KA = 305 * MiB;
constexpr size_t WS_VT = 337 * MiB;
constexpr size_t WS_QP = 369 * MiB;
constexpr size_t WS_OL = 401 * MiB;
constexpr size_t WS_BETA = 433 * MiB;
constexpr size_t WS_G = 433 * MiB + 512 * 1024;
constexpr size_t WS_EGL = 434 * MiB;
constexpr size_t WS_NEGM = 435 * MiB;
constexpr size_t WS_END = 499 * MiB;
constexpr size_t WS_SNT = WS_QA;
constexpr size_t WS_WQ8 = WS_KA;
constexpr size_t WS_WSC = WS_KA + 4 * MiB;
constexpr size_t WS_IDS16 = WS_KA + 8 * MiB;
constexpr size_t WS_DLT = WS_QP;
constexpr size_t WS_GATES16 = WS_KA + 16 * MiB;

struct Params {
    const float *x, *c, *w_ada, *b_ada, *norm1_gain, *w_in, *q_gain, *k_gain, *rel_bias, *attn_out_gain, *conv_w, *a_log, *dt_bias,
        *dn_out_gain, *w_out, *norm2_gain, *w_query, *query_gain, *sk1, *sk2, *e_down, *e_up;
    float* out;
    unsigned char* ws;
};

typedef float f32x2h __attribute__((ext_vector_type(2)));
typedef __bf16 bf16x2h __attribute__((ext_vector_type(2)));
__device__ __forceinline__ unsigned f2bf(float f) { return (unsigned)__builtin_bit_cast(unsigned short, (__bf16)f); }
__device__ __forceinline__ unsigned pk2(float lo, float hi) { const f32x2h v = {lo, hi}; return __builtin_bit_cast(unsigned, __builtin_convertvector(v, bf16x2h)); }
__device__ __forceinline__ float bflo(unsigned u) { return __uint_as_float(u << 16); }
__device__ __forceinline__ float bfhi(unsigned u) { return __uint_as_float(u & 0xffff0000u); }
__device__ __forceinline__ float bf2f(bf16_t v) { return __uint_as_float(((unsigned)v) << 16); }
__device__ __forceinline__ float silu_f(float v) { return v * __builtin_amdgcn_rcpf(1.0f + __expf(-v)); }
__device__ __forceinline__ float dot2bf(unsigned a, unsigned b, float acc) {
    return __builtin_amdgcn_fdot2_f32_bf16(__builtin_bit_cast(bf16x2_t, a), __builtin_bit_cast(bf16x2_t, b), acc, false);
}
__device__ __forceinline__ f32x4 mfma16(bf16x8 a, bf16x8 b, f32x4 c) { return __builtin_amdgcn_mfma_f32_16x16x32_bf16(a, b, c, 0, 0, 0); }
__device__ __forceinline__ f32x16 mfma32(bf16x8 a, bf16x8 b, f32x16 c) { return __builtin_amdgcn_mfma_f32_32x32x16_bf16(a, b, c, 0, 0, 0); }
__device__ __forceinline__ bf16x8 pack8(float a0, float a1, float a2, float a3, float a4, float a5, float a6, float a7) {
    u32x4 u; u.x = pk2(a0, a1); u.y = pk2(a2, a3); u.z = pk2(a4, a5); u.w = pk2(a6, a7); return __builtin_bit_cast(bf16x8, u);
}
__device__ __forceinline__ int opaque_tid() { int t = threadIdx.x; asm volatile("" : "+v"(t)); return t; }
__device__ __forceinline__ int swap23(int v) { return (v & ~12) | ((v & 4) << 1) | ((v & 8) >> 1); }

constexpr int LDS_BYTES = 153600;

__device__ void phase0(const Params& P, unsigned char* lds, int bid, int nblk) {
    const int tid = opaque_tid();
    float* sc = (float*)lds;
    float* red = (float*)(lds + 65536);
    float* tile = (float*)(lds + 98304);
    float* mod = (float*)(P.ws + WS_MOD);
    if (bid < 384) {
        for (int e = tid; e < 16384; e += NTHREADS) { int b = e >> 10, k = e & 1023; float v = P.c[e]; sc[k * 16 + b] = silu_f(v); }
        __syncthreads();
        for (int it = bid; it < 384; it += nblk) {
            const int j0 = it * 16, cl = tid & 15, kg = tid >> 4;
            float acc[16];
#pragma unroll
            for (int b = 0; b < 16; ++b) acc[b] = 0.f;
            for (int i = 0; i < 32; ++i) {
                const int k = kg + 32 * i;
                const float w = P.w_ada[(size_t)k * 6144 + j0 + cl];
                const f32x4* sp = (const f32x4*)(sc + k * 16);
#pragma unroll
                for (int q = 0; q < 4; ++q) { f32x4 s4 = sp[q]; acc[4 * q] += s4[0] * w; acc[4 * q + 1] += s4[1] * w; acc[4 * q + 2] += s4[2] * w; acc[4 * q + 3] += s4[3] * w; }
            }
#pragma unroll
            for (int b = 0; b < 16; ++b) red[(kg * 16 + b) * 16 + cl] = acc[b];
            __syncthreads();
            if (tid < 256) {
                const int b = tid >> 4, c2 = tid & 15; float s = 0.f;
                for (int g = 0; g < 32; ++g) s += red[(g * 16 + b) * 16 + c2];
                mod[b * 6144 + j0 + c2] = s + P.b_ada[j0 + c2];
            }
            __syncthreads();
        }
    }
    for (int it = bid; it < 928 + 256 + 512; it += nblk) {
        const float* src; bf16_t* dst; int N, nt, kt;
        if (it < 928) { src = P.w_in; dst = (bf16_t*)(P.ws + WS_WINT); N = IPW; nt = it % 58; kt = it / 58; }
        else if (it < 928 + 256) { const int r = it - 928; src = P.w_out; dst = (bf16_t*)(P.ws + WS_WOUTT); N = 1024; nt = r % 16; kt = r / 16; }
        else { const int r = it - 1184; src = P.w_query; dst = (bf16_t*)(P.ws + WS_WQT); N = 2048; nt = r % 32; kt = r / 32; }
        const int n0 = nt * 64, k0 = kt * 64;
        {
            const int nl = tid & 63, kb = tid >> 6;
#pragma unroll
            for (int i = 0; i < 8; ++i) { const int kk = kb + 8 * i; const int n = n0 + nl; tile[kk * 65 + nl] = (n < N) ? src[(size_t)(k0 + kk) * N + n] : 0.f; }
        }
        __syncthreads();
        {
            const int kl = (tid & 7) * 8, nl = tid >> 3;
            u32x4 o;
            o.x = pk2(tile[(kl + 0) * 65 + nl], tile[(kl + 1) * 65 + nl]); o.y = pk2(tile[(kl + 2) * 65 + nl], tile[(kl + 3) * 65 + nl]);
            o.z = pk2(tile[(kl + 4) * 65 + nl], tile[(kl + 5) * 65 + nl]); o.w = pk2(tile[(kl + 6) * 65 + nl], tile[(kl + 7) * 65 + nl]);
            *(u32x4*)(dst + (size_t)(n0 + nl) * 1024 + k0 + kl) = o;
        }
        __syncthreads();
    }
    {
        const int lane = tid & 63, wv = tid >> 6;
        for (int row = bid * 8 + wv; row < 2 * NEXP; row += nblk * 8) {
            const bool up = row >= NEXP; const int er = up ? row - NEXP : row;
            const float* src = (up ? P.e_up : P.e_down) + (size_t)er * 1024 + 16 * lane;
            f32x4 v[4]; float am = 0.f;
#pragma unroll
            for (int q = 0; q < 4; ++q) { v[q] = *(const f32x4*)(src + 4 * q); am = fmaxf(am, fmaxf(fmaxf(fabsf(v[q][0]), fabsf(v[q][1])), fmaxf(fabsf(v[q][2]), fabsf(v[q][3])))); }
#pragma unroll
            for (int o = 32; o > 0; o >>= 1) am = fmaxf(am, __shfl_xor(am, o));
            am = am > 0.f ? am : 1.0f;
            u32x4 o4;
            {
                const float sc = am * (1.0f / 127.0f), inv = 127.0f / am;
#pragma unroll
                for (int q = 0; q < 4; ++q) {
                    const int b0 = (int)rintf(v[q][0] * inv), b1 = (int)rintf(v[q][1] * inv), b2 = (int)rintf(v[q][2] * inv), b3 = (int)rintf(v[q][3] * inv);
                    o4[q] = (unsigned)(b0 & 255) | ((unsigned)(b1 & 255) << 8) | ((unsigned)(b2 & 255) << 16) | ((unsigned)(b3 & 255) << 24);
                }
                *(u32x4*)((signed char*)(P.ws + (up ? WS_EU8 : WS_ED8)) + ((size_t)(lane >> 3) * NEXP + er) * 128 + 16 * (lane & 7)) = o4;
                if (lane == 0) ((float*)(P.ws + (up ? WS_SU : WS_SD)))[er] = sc;
            }
        }
    }
    {
        const int gid = bid * NTHREADS + tid;
        if (gid < 32768) {
            const int p = gid >> 14, rem = gid & 16383, d = rem & 127;
            const float v = (p ? P.sk2 : P.sk1)[rem] * P.query_gain[128 * p + d];
            ((bf16_t*)(P.ws + WS_SK))[gid] = (bf16_t)f2bf(v);
        }
    }
}

template <bool WITH_BG, bool WITH_Q8>
__device__ void norm_mod_phase(const Params& P, const float* __restrict__ src, const bf16_t* __restrict__ dlt, float* __restrict__ x1out, const float* __restrict__ gain, const float* __restrict__ mod, int shift_off, int scale_off,
                               bf16_t* __restrict__ dst, int bid, int nblk) {
    const int tid_ = opaque_tid(); const int lane = tid_ & 63, wid = tid_ >> 6;
    float wreg[WITH_BG ? 16 : 1][8];
    if (WITH_BG) {
#pragma unroll
        for (int i = 0; i < 4; ++i)
#pragma unroll
            for (int jj = 0; jj < 4; ++jj) {
                const float* wp = P.w_in + (size_t)(256 * i + 4 * lane + jj) * IPW + 3584;
                const f32x4 w0 = *(const f32x4*)wp, w1 = *(const f32x4*)(wp + 4);
                wreg[4 * i + jj][0] = w0[0]; wreg[4 * i + jj][1] = w0[1]; wreg[4 * i + jj][2] = w0[2]; wreg[4 * i + jj][3] = w0[3];
                wreg[4 * i + jj][4] = w1[0]; wreg[4 * i + jj][5] = w1[1]; wreg[4 * i + jj][6] = w1[2]; wreg[4 * i + jj][7] = w1[3];
            }
    }
    for (int row = bid * 8 + wid; row < NTOK; row += nblk * 8) {
        const int b = row >> 11;
        f32x4 v[4]; float ss = 0.f;
#pragma unroll
        for (int i = 0; i < 4; ++i) {
            v[i] = *(const f32x4*)(src + (size_t)row * DM + 256 * i + 4 * lane);
            if (WITH_Q8) {
                const u32x2 d2 = *(const u32x2*)(dlt + (size_t)row * DM + 256 * i + 4 * lane);
                v[i][0] += bflo(d2.x); v[i][1] += bfhi(d2.x); v[i][2] += bflo(d2.y); v[i][3] += bfhi(d2.y);
            }
            ss += v[i][0] * v[i][0] + v[i][1] * v[i][1] + v[i][2] * v[i][2] + v[i][3] * v[i][3];
        }
#pragma unroll
        for (int o = 32; o > 0; o >>= 1) ss += __shfl_xor(ss, o);
        const float rstd = rsqrtf(ss * (1.0f / DM) + EPS);
        float a8[8];
        float yq[WITH_Q8 ? 4 : 1][4];
#pragma unroll
        for (int q = 0; q < 8; ++q) a8[q] = 0.f;
#pragma unroll
        for (int i = 0; i < 4; ++i) {
            const int c = 256 * i + 4 * lane;
            const f32x4 g = *(const f32x4*)(gain + c), sh = *(const f32x4*)(mod + b * 6144 + shift_off + c), sc = *(const f32x4*)(mod + b * 6144 + scale_off + c);
            float y[4];
#pragma unroll
            for (int jj = 0; jj < 4; ++jj) {
                y[jj] = v[i][jj] * rstd * g[jj] * (1.0f + sc[jj]) + sh[jj];
                if (WITH_BG) {
#pragma unroll
                    for (int q = 0; q < 8; ++q) a8[q] += y[jj] * wreg[4 * i + jj][q];
                }
            }
            u32x2 o; o.x = pk2(y[0], y[1]); o.y = pk2(y[2], y[3]);
            *(u32x2*)(dst + (size_t)row * DM + c) = o;
            if (WITH_Q8) { yq[i][0] = y[0]; yq[i][1] = y[1]; yq[i][2] = y[2]; yq[i][3] = y[3]; }
        }
        if (WITH_Q8) {
            float am = 0.f;
#pragma unroll
            for (int i = 0; i < 4; ++i) am = fmaxf(am, fmaxf(fmaxf(fabsf(yq[i][0]), fabsf(yq[i][1])), fmaxf(fabsf(yq[i][2]), fabsf(yq[i][3]))));
#pragma unroll
            for (int o = 32; o > 0; o >>= 1) am = fmaxf(am, __shfl_xor(am, o));
            am = am > 0.f ? am : 1.0f;
            const float inv = 127.0f / am;
#pragma unroll
            for (int i = 0; i < 4; ++i) {
                const int b0 = (int)rintf(yq[i][0] * inv), b1 = (int)rintf(yq[i][1] * inv), b2 = (int)rintf(yq[i][2] * inv), b3 = (int)rintf(yq[i][3] * inv);
                *(unsigned*)((signed char*)(P.ws + WS_H8) + (size_t)row * DM + 256 * i + 4 * lane) = (unsigned)(b0 & 255) | ((unsigned)(b1 & 255) << 8) | ((unsigned)(b2 & 255) << 16) | ((unsigned)(b3 & 255) << 24);
            }
            if (lane == 0) ((float*)(P.ws + WS_HS))[row] = am * (1.0f / 127.0f);
        }
        if (WITH_BG) {
            const bool u1 = (lane & 1) != 0, u2 = (lane & 2) != 0, u4 = (lane & 4) != 0;
            float z4[4];
#pragma unroll
            for (int q = 0; q < 4; ++q) { const float keep = u1 ? a8[2 * q + 1] : a8[2 * q], send = u1 ? a8[2 * q] : a8[2 * q + 1]; z4[q] = keep + __shfl_xor(send, 1); }
            float z2[2];
#pragma unroll
            for (int q = 0; q < 2; ++q) { const float keep = u2 ? z4[2 * q + 1] : z4[2 * q], send = u2 ? z4[2 * q] : z4[2 * q + 1]; z2[q] = keep + __shfl_xor(send, 2); }
            const float keep = u4 ? z2[1] : z2[0], send = u4 ? z2[0] : z2[1];
            float t = keep + __shfl_xor(send, 4);
            t += __shfl_xor(t, 8); t += __shfl_xor(t, 16); t += __shfl_xor(t, 32);
            if (lane < 4) ((float*)(P.ws + WS_BETA))[(size_t)row * 4 + lane] = 1.0f / (1.0f + __expf(-t));
            else if (lane < 8) {
                const int hq = lane - 4; const float xx = t + P.dt_bias[hq];
                const float sp = xx > 20.f ? xx : log1pf(__expf(xx));
                ((float*)(P.ws + WS_G))[(size_t)row * 4 + hq] = -__expf(P.a_log[hq]) * sp;
            }
        }
    }
}

namespace pg8 {
#define PG8_LAS __attribute__((address_space(3)))
constexpr int BM = 256, BK = 64, HALF = 128, HTB = HALF * BK * 2, NXCD = 8, WGM = 8;
__host__ __device__ __forceinline__ int lds_byte(int r, int c) { const int st = (r >> 4) * 2 + (c >> 5), rr = r & 15, cc = c & 31, ob = rr * 64 + cc * 2; return st * 1024 + (ob ^ (((ob >> 9) & 1) << 5)); }
__host__ __device__ __forceinline__ void stage_rc(int b, int& R, int& C) { const int st = b / 1024, sb = b % 1024, swz = sb ^ (((sb >> 9) & 1) << 5); R = (st >> 1) * 16 + swz / 64; C = (st & 1) * 32 + (swz % 64) / 2; }
__host__ __device__ __forceinline__ int perm32(int rho) { const int n = rho >> 4, i = rho & 15; return 8 * (i >> 2) + 4 * n + (i & 3); }
struct Unit { int pm, pn; };
struct Gemm { const bf16_t* A; const bf16_t* Bt; int M, N, K; };
struct StaticOrder {
    int nM, nN, nwg, G, c;
    __host__ __device__ void init(int M, int N, int G_, int c_) { nM = M / BM; nN = N / BM; nwg = nM * nN; G = G_; c = c_; }
    __host__ __device__ bool next(int i, Unit& u) const {
        const long L = (long)i * G + c; if (L >= nwg) return false;
        int wgid = (int)L; { const int q = nwg / NXCD, r = nwg % NXCD, xcd = wgid % NXCD, off = wgid / NXCD; wgid = (xcd < r ? xcd * (q + 1) : r * (q + 1) + (xcd - r) * q) + off; }
        const int nig = WGM * nN, gid = wgid / nig, fm = gid * WGM, gsz = (nM - fm) < WGM ? (nM - fm) : WGM;
        u.pm = fm + ((wgid % nig) % gsz); u.pn = (wgid % nig) / gsz; return true;
    }
};

template <class Epi>
__device__ __forceinline__ void gemm_phase(PG8_LAS unsigned char* lds, const Gemm g, const StaticOrder& S, const Epi& E) {
    const int tid = opaque_tid(), wid = __builtin_amdgcn_readfirstlane(tid >> 6), lane = tid & 63, wr = wid >> 2, wc = wid & 3, fr = lane & 15, fq = lane >> 4;
    const int K = g.K, nt = K / BK;
    unsigned voffA[2], voffB[2];
#pragma unroll
    for (int i = 0; i < 2; ++i) { int R, C; stage_rc(tid * 16 + i * 8192, R, C); const int Rb = 64 * (R >> 5) + perm32(R & 31);
        voffA[i] = (unsigned)(R * K + C) * 2u; voffB[i] = (unsigned)(Rb * K + C) * 2u; }
    const size_t kstep = (size_t)(BK * 2);
    const size_t hstep = (size_t)HALF * K * 2;
    const size_t hstepB = (size_t)32 * K * 2;
    const size_t tstep = 2 * hstep;
    const unsigned ldsw = (unsigned)wid * 1024u;
    const int aoff = lds_byte(wr * 64 + fr, fq * 8), boff = lds_byte(wc * 32 + fr, fq * 8);
#define PG8_SA(b, h) (((b) * 2 + (h)) * HTB)
#define PG8_SB(b, h) ((4 + (b) * 2 + (h)) * HTB)
#define PG8_STAGE(bufoff, gbase, voff) do { _Pragma("unroll") for (int _i = 0; _i < 2; ++_i) \
        __builtin_amdgcn_global_load_lds((const unsigned*)((const char*)(gbase) + (voff)[_i]), (PG8_LAS unsigned*)(lds + (bufoff) + ldsw + _i * 8192), 16, 0, 0); } while (0)
#define PG8_LDA(dst, b, h) do { _Pragma("unroll") for (int m = 0; m < 4; ++m) _Pragma("unroll") for (int k = 0; k < 2; ++k) dst[m][k] = *(const PG8_LAS bf16x8*)(lds + PG8_SA(b, h) + aoff + m * 2048 + k * 1024); } while (0)
#define PG8_LDB(dst, b, h) do { _Pragma("unroll") for (int n = 0; n < 2; ++n) _Pragma("unroll") for (int k = 0; k < 2; ++k) dst[n][k] = *(const PG8_LAS bf16x8*)(lds + PG8_SB(b, h) + boff + n * 2048 + k * 1024); } while (0)
#define PG8_MMA(ai, bj, At, Bt) do { __builtin_amdgcn_s_setprio(1); _Pragma("unroll") for (int m = 0; m < 4; ++m) _Pragma("unroll") for (int n = 0; n < 2; ++n) _Pragma("unroll") for (int k = 0; k < 2; ++k) \
        acc[ai][bj][m][n] = __builtin_amdgcn_mfma_f32_16x16x32_bf16(Bt[n][k], At[m][k], acc[ai][bj][m][n], 0, 0, 0); __builtin_amdgcn_s_setprio(0); } while (0)
#define PG8_WAIT_V(n) asm volatile("s_waitcnt vmcnt(" #n ")" ::: "memory")
#define PG8_WAIT_L(n) asm volatile("s_waitcnt lgkmcnt(" #n ")" ::: "memory")
#define PG8_BAR __builtin_amdgcn_s_barrier()
#define PG8_SCHED __builtin_amdgcn_sched_barrier(0)
    Unit cur, nxt; int ui = 0;
    if (!S.next(0, cur)) return;
    f32x4 acc[2][2][4][2];
#pragma unroll
    for (int a = 0; a < 2; ++a)
#pragma unroll
        for (int b = 0; b < 2; ++b)
#pragma unroll
            for (int m = 0; m < 4; ++m)
#pragma unroll
                for (int n = 0; n < 2; ++n) acc[a][b][m][n] = (f32x4){0.f, 0.f, 0.f, 0.f};
    bf16x8 At[4][2], B0[2][2], B1[2][2];
    const char* cA = (const char*)g.A + (size_t)cur.pm * tstep; const char* cB = (const char*)g.Bt + (size_t)cur.pn * tstep;
    PG8_STAGE(PG8_SB(0, 0), cB, voffB); PG8_STAGE(PG8_SB(0, 1), cB + hstepB, voffB); PG8_STAGE(PG8_SA(0, 0), cA, voffA); PG8_STAGE(PG8_SA(0, 1), cA + hstep, voffA);
    if (wr == 1) PG8_BAR;
    PG8_WAIT_V(2); PG8_BAR;
    PG8_STAGE(PG8_SB(1, 0), cB + kstep, voffB); PG8_STAGE(PG8_SA(1, 0), cA + kstep, voffA); PG8_STAGE(PG8_SB(1, 1), cB + hstepB + kstep, voffB);
    PG8_WAIT_V(6); PG8_BAR;
    for (;;) {
        const bool has_next = S.next(ui + 1, nxt);
        const char* nA = has_next ? (const char*)g.A + (size_t)nxt.pm * tstep : cA; const char* nB = has_next ? (const char*)g.Bt + (size_t)nxt.pn * tstep : cB;
        for (int t = 0; t < nt; t += 2) {
            const bool last = (t == nt - 2);
            const char* a1 = cA + (size_t)(t + 1) * kstep;
            const char* a2 = last ? nA : cA + (size_t)(t + 2) * kstep; const char* b2 = last ? nB : cB + (size_t)(t + 2) * kstep;
            const char* a3 = a2 + kstep; const char* b3 = b2 + kstep;
            PG8_LDB(B0, 0, 0); PG8_LDB(B1, 0, 1); PG8_SCHED; PG8_LDA(At, 0, 0); PG8_STAGE(PG8_SA(1, 1), a1 + hstep, voffA);
            PG8_WAIT_V(8); PG8_WAIT_L(0); PG8_BAR; PG8_MMA(0, 0, At, B0); PG8_MMA(0, 1, At, B1); PG8_BAR; PG8_SCHED;
            PG8_LDA(At, 0, 1); PG8_STAGE(PG8_SB(0, 0), b2, voffB); PG8_STAGE(PG8_SB(0, 1), b2 + hstepB, voffB); PG8_STAGE(PG8_SA(0, 0), a2, voffA);
            PG8_WAIT_V(8); PG8_WAIT_L(0); PG8_BAR; PG8_MMA(1, 0, At, B0); PG8_MMA(1, 1, At, B1); PG8_BAR; PG8_SCHED;
            PG8_LDB(B0, 1, 0); PG8_LDB(B1, 1, 1); PG8_SCHED; PG8_LDA(At, 1, 0); PG8_STAGE(PG8_SA(0, 1), a2 + hstep, voffA);
            PG8_WAIT_V(8); PG8_WAIT_L(0); PG8_BAR; PG8_MMA(0, 0, At, B0); PG8_MMA(0, 1, At, B1); PG8_BAR; PG8_SCHED;
            PG8_LDA(At, 1, 1); PG8_STAGE(PG8_SB(1, 0), b3, voffB); PG8_STAGE(PG8_SB(1, 1), b3 + hstepB, voffB); PG8_STAGE(PG8_SA(1, 0), a3, voffA);
            PG8_WAIT_V(8); PG8_WAIT_L(0); PG8_BAR; PG8_MMA(1, 0, At, B0); PG8_MMA(1, 1, At, B1); PG8_BAR; PG8_SCHED;
        }
        if (wr == 0) PG8_BAR;
        E(acc, cur, wr, wc, fr, fq);
        if (!has_next) break;
#pragma unroll
        for (int a = 0; a < 2; ++a)
#pragma unroll
            for (int b = 0; b < 2; ++b)
#pragma unroll
                for (int m = 0; m < 4; ++m)
#pragma unroll
                    for (int n = 0; n < 2; ++n) acc[a][b][m][n] = (f32x4){0.f, 0.f, 0.f, 0.f};
        cur = nxt; cA = nA; cB = nB; ++ui;
        if (wr == 1) PG8_BAR;
    }
    PG8_WAIT_V(0);
    PG8_BAR;
#undef PG8_SA
#undef PG8_SB
#undef PG8_STAGE
#undef PG8_LDA
#undef PG8_LDB
#undef PG8_MMA
#undef PG8_WAIT_V
#undef PG8_WAIT_L
#undef PG8_BAR
#undef PG8_SCHED
}
}

#define ACC_T const f32x4 (&acc)[2][2][4][2]
__device__ __forceinline__ u32x4 pack_acc8(const f32x4& a, const f32x4& b, float s) {
    u32x4 o; o.x = pk2(a[0] * s, a[1] * s); o.y = pk2(a[2] * s, a[3] * s); o.z = pk2(b[0] * s, b[1] * s); o.w = pk2(b[2] * s, b[3] * s); return o;
}
struct EpiQK {
    const float *q_gain, *k_gain;
    bf16_t *qa, *ka;
    __device__ __forceinline__ void operator()(ACC_T, const pg8::Unit& u, int wr, int wc, int fr, int fq) const {
        const int pn = u.pn, bb = u.pm >> 3, s0 = (u.pm & 7) * 256 + wr * 64;
        {
            const bool isq = pn < 2; const int head = (pn & 1) * 4 + wc;
            const float* gn = isq ? q_gain : k_gain; const float sc = isq ? 0.125f * 1.4426950408889634f : 1.0f;
            bf16_t* ub = (isq ? qa : ka) + ((size_t)(bb * AH + head) * SEQ + s0) * 64;
            const unsigned lo = isq ? (unsigned)(fr * 64 + 8 * fq) : (unsigned)(fq * 256 + fr * 8);
            const float* gl = gn + 8 * fq;
#pragma unroll
            for (int ai = 0; ai < 2; ++ai)
#pragma unroll
                for (int m = 0; m < 4; ++m) {
                    float ss = 0.f;
#pragma unroll
                    for (int bj = 0; bj < 2; ++bj)
#pragma unroll
                        for (int n = 0; n < 2; ++n)
#pragma unroll
                            for (int r = 0; r < 4; ++r) ss += acc[ai][bj][m][n][r] * acc[ai][bj][m][n][r];
                    ss += __shfl_xor(ss, 16); ss += __shfl_xor(ss, 32);
                    const float rstd = rsqrtf(ss * (1.0f / 64.0f) + EPS) * sc;
                    bf16_t* p = isq ? (ub + (ai * 128 + m * 16) * 64) : (ub + (ai * 4 + (m >> 1)) * 2048 + (m & 1) * 128);
#pragma unroll
                    for (int bj = 0; bj < 2; ++bj) {
                        const f32x4 g0 = *(const f32x4*)(gl + 32 * bj), g1 = *(const f32x4*)(gl + 32 * bj + 4);
                        u32x4 o;
                        o.x = pk2(acc[ai][bj][m][0][0] * rstd * g0[0], acc[ai][bj][m][0][1] * rstd * g0[1]); o.y = pk2(acc[ai][bj][m][0][2] * rstd * g0[2], acc[ai][bj][m][0][3] * rstd * g0[3]);
                        o.z = pk2(acc[ai][bj][m][1][0] * rstd * g1[0], acc[ai][bj][m][1][1] * rstd * g1[1]); o.w = pk2(acc[ai][bj][m][1][2] * rstd * g1[2], acc[ai][bj][m][1][3] * rstd * g1[3]);
                        *(u32x4*)(p + (isq ? 32 * bj : 1024 * bj) + lo) = o;
                    }
                }
        }
    }
};
template <int CTRL> __device__ __forceinline__ unsigned dpp_u32(unsigned v) { return (unsigned)__builtin_amdgcn_update_dpp(0, (int)v, CTRL, 0xf, 0xf, false); }
struct EpiV {
    bf16_t* vt;
    __device__ __forceinline__ void operator()(ACC_T, const pg8::Unit& u, int wr, int wc, int fr, int fq) const {
        const int pn = u.pn, bb = u.pm >> 3, s0 = (u.pm & 7) * 256 + wr * 64;
        {
            const int head = (pn & 1) * 4 + wc;
            bf16_t* ub = vt + ((size_t)(bb * AH + head) * SEQ + s0) * 64;
            const int pp = swap23(fr);
            const bool u2 = (fr & 8) != 0, u1 = (fr & 2) != 0, u0 = (fr & 1) != 0;
            const unsigned selv = u0 ? 0x03020706u : 0x05040100u;
            const unsigned lo = (unsigned)((pp >> 3) * 256 + (8 * fq + (pp & 7)) * 8);
#pragma unroll
            for (int ai = 0; ai < 2; ++ai)
#pragma unroll
                for (int m = 0; m < 4; ++m)
#pragma unroll
                    for (int bj = 0; bj < 2; ++bj) {
                        unsigned D0 = pk2(acc[ai][bj][m][0][0], acc[ai][bj][m][0][1]), D1 = pk2(acc[ai][bj][m][0][2], acc[ai][bj][m][0][3]);
                        unsigned D2 = pk2(acc[ai][bj][m][1][0], acc[ai][bj][m][1][1]), D3 = pk2(acc[ai][bj][m][1][2], acc[ai][bj][m][1][3]);
                        {
                            const unsigned r0 = dpp_u32<0x128>(u2 ? D0 : D2), r1 = dpp_u32<0x128>(u2 ? D1 : D3);
                            D0 = u2 ? r0 : D0; D1 = u2 ? r1 : D1; D2 = u2 ? D2 : r0; D3 = u2 ? D3 : r1;
                        }
                        {
                            const unsigned r0 = dpp_u32<0x4E>(u1 ? D0 : D1), r1 = dpp_u32<0x4E>(u1 ? D2 : D3);
                            D0 = u1 ? r0 : D0; D2 = u1 ? r1 : D2; D1 = u1 ? D1 : r0; D3 = u1 ? D3 : r1;
                        }
                        {
                            D0 = __builtin_amdgcn_perm(dpp_u32<0xB1>(D0), D0, selv); D1 = __builtin_amdgcn_perm(dpp_u32<0xB1>(D1), D1, selv);
                            D2 = __builtin_amdgcn_perm(dpp_u32<0xB1>(D2), D2, selv); D3 = __builtin_amdgcn_perm(dpp_u32<0xB1>(D3), D3, selv);
                        }
                        *(u32x4*)(ub + (ai * 2 + (m >> 2)) * 4096 + ((bj * 2 + ((m >> 1) & 1)) * 2 + (m & 1)) * 512 + lo) = (u32x4){D0, D1, D2, D3};
                    }
        }
    }
};
struct EpiOut {
    const float* mod; bf16_t* dlt;
    __device__ __forceinline__ void operator()(ACC_T, const pg8::Unit& u, int wr, int wc, int fr, int fq) const {
        bf16_t* ub = dlt + (size_t)(u.pm * 256 + wr * 64) * DM + u.pn * 256 + wc * 64;
        const float* ug = mod + (u.pm >> 3) * 6144 + 2048 + u.pn * 256 + wc * 64;
        const unsigned lo = (unsigned)(fr * DM + 8 * fq), lg = (unsigned)(8 * fq);
#pragma unroll
        for (int bj = 0; bj < 2; ++bj) {
            const f32x4 g0 = *(const f32x4*)(ug + 32 * bj + lg), g1 = *(const f32x4*)(ug + 32 * bj + 4 + lg);
#pragma unroll
            for (int ai = 0; ai < 2; ++ai)
#pragma unroll
                for (int m = 0; m < 4; ++m) {
                    const f32x4& a0 = acc[ai][bj][m][0]; const f32x4& a1 = acc[ai][bj][m][1];
                    u32x4 o; o.x = pk2(a0[0] * g0[0], a0[1] * g0[1]); o.y = pk2(a0[2] * g0[2], a0[3] * g0[3]); o.z = pk2(a1[0] * g1[0], a1[1] * g1[1]); o.w = pk2(a1[2] * g1[2], a1[3] * g1[3]);
                    *(u32x4*)(ub + (ai * 128 + m * 16) * DM + 32 * bj + lo) = o;
                }
        }
    }
};
struct EpiBf {
    bf16_t* dst; int ld;
    __device__ __forceinline__ void operator()(ACC_T, const pg8::Unit& u, int wr, int wc, int fr, int fq) const {
        bf16_t* ub = dst + (size_t)(u.pm * 256 + wr * 64) * ld + u.pn * 256 + wc * 64;
        const unsigned lo = (unsigned)(fr * ld + 8 * fq);
#pragma unroll
        for (int ai = 0; ai < 2; ++ai)
#pragma unroll
            for (int m = 0; m < 4; ++m)
#pragma unroll
                for (int bj = 0; bj < 2; ++bj) *(u32x4*)(ub + (ai * 128 + m * 16) * ld + 32 * bj + lo) = pack_acc8(acc[ai][bj][m][0], acc[ai][bj][m][1], 1.0f);
    }
};
struct EpiInAll {
    EpiQK qk; EpiV v; EpiBf pbf;
    __device__ __forceinline__ void operator()(ACC_T, const pg8::Unit& u, int wr, int wc, int fr, int fq) const {
        if (u.pn < 4) qk(acc, u, wr, wc, fr, fq);
        else if (u.pn < 6) { pg8::Unit u2 = u; u2.pn = u.pn - 4; v(acc, u2, wr, wc, fr, fq); }
        else { pg8::Unit u2 = u; u2.pn = u.pn - 6; pbf(acc, u2, wr, wc, fr, fq); }
    }
};
#undef ACC_T
template <class Epi>
__device__ __forceinline__ void gemm_run(const bf16_t* A, const bf16_t* Bt, int M, int N, int K, const Epi& e, unsigned char* lds, int bid, int nblk) {
    pg8::Gemm g{A, Bt, M, N, K}; pg8::StaticOrder S; S.init(M, N, nblk, bid);
    pg8::gemm_phase<Epi>((PG8_LAS unsigned char*)lds, g, S, e);
}

__device__ void attn_phase(const Params& P, unsigned char* lds, int bid, int nblk) {
    const int tid0 = opaque_tid();
    {
        const int head = tid0 >> 6, lane = tid0 & 63;
        float* biasL = (float*)lds + head * 260;
        for (int i = lane; i < 257; i += 64) biasL[i] = (P.rel_bias[head * 257 + i] - P.rel_bias[head * 257 + 256]) * 1.4426950408889634f;
    }
    const bf16_t* qa = (const bf16_t*)(P.ws + WS_QA); const bf16_t* ka = (const bf16_t*)(P.ws + WS_KA); const bf16_t* vt = (const bf16_t*)(P.ws + WS_VT);
    bf16_t* mix = (bf16_t*)(P.ws + WS_H);
    for (int it = bid; it < 512; it += nblk) {
        int tid = tid0; asm volatile("" : "+v"(tid));
        const int head = tid >> 6, lane = tid & 63, l31 = lane & 31, hh = lane >> 5;
        const float* biasL = (const float*)lds + head * 260;
        float* ssq = (float*)(lds + 8 * 260 * 4);
        float* park = (float*)(lds + 16384) + head * 4096;
        const int it2 = it & 255, b = it2 & 15, pp = it2 >> 4, n = (it < 256) ? pp : 31 - pp;
        const size_t hb = (size_t)(b * AH + head);
        const bf16_t* qbase = qa + (hb * SEQ + (size_t)n * 64) * 64;
        const int cstart = (n >= 8) ? 0 : 8 - n;
        float ssv[2];
#pragma unroll
        for (int qt = 0; qt < 2; ++qt) {
            const int qi = 32 * qt + l31;
            bf16x8 bq[4];
#pragma unroll
            for (int ks = 0; ks < 4; ++ks) bq[ks] = *(const bf16x8*)(qbase + qi * 64 + 16 * ks + 8 * hh);
            f32x16 o0, o1;
#pragma unroll
            for (int r = 0; r < 16; ++r) { o0[r] = 0.f; o1[r] = 0.f; }
            float mrun = -1e30f, lrun = 0.f;
            bf16x8 kc0[4], kc1[4];
            {
                const bf16_t* kb = ka + (hb * SEQ + (size_t)(n + cstart - 8) * 64) * 64;
#pragma unroll
                for (int ks = 0; ks < 4; ++ks) { kc0[ks] = *(const bf16x8*)(kb + (2 * ks + hh) * 256 + l31 * 8); kc1[ks] = *(const bf16x8*)(kb + 2048 + (2 * ks + hh) * 256 + l31 * 8); }
            }
            for (int c = cstart; c <= 8; ++c) {
                const int kc = n + c - 8;
                const bf16_t* vb = vt + (hb * SEQ + (size_t)kc * 64) * 64;
                bf16x8 v0[4], v1[4], kn0[4], kn1[4];
#pragma unroll
                for (int kt = 0; kt < 2; ++kt)
#pragma unroll
                    for (int sp = 0; sp < 2; ++sp) {
                        v0[2 * kt + sp] = *(const bf16x8*)(vb + ((kt * 2 + sp) * 2 + hh) * 256 + l31 * 8);
                        v1[2 * kt + sp] = *(const bf16x8*)(vb + 2048 + ((kt * 2 + sp) * 2 + hh) * 256 + l31 * 8);
                    }
                {
                    const int kcn = (c < 8) ? kc + 1 : kc;
                    const bf16_t* kb = ka + (hb * SEQ + (size_t)kcn * 64) * 64;
#pragma unroll
                    for (int ks = 0; ks < 4; ++ks) { kn0[ks] = *(const bf16x8*)(kb + (2 * ks + hh) * 256 + l31 * 8); kn1[ks] = *(const bf16x8*)(kb + 2048 + (2 * ks + hh) * 256 + l31 * 8); }
                }
                f32x16 s0, s1;
#pragma unroll
                for (int r = 0; r < 16; ++r) { s0[r] = 0.f; s1[r] = 0.f; }
#pragma unroll
                for (int ks = 0; ks < 4; ++ks) { s0 = mfma32(kc0[ks], bq[ks], s0); s1 = mfma32(kc1[ks], bq[ks], s1); }
                if (c > 5) {
                    const int base = qi + 64 * (8 - c) + 128 - 4 * hh;
#pragma unroll
                    for (int r = 0; r < 16; ++r) {
                        const int j0 = (r & 3) + 8 * (r >> 2);
                        int i0 = base - j0; i0 = i0 > 256 ? 256 : i0;
                        int i1 = base - 32 - j0; i1 = i1 > 256 ? 256 : i1;
                        s0[r] += biasL[i0]; s1[r] += biasL[i1];
                    }
                }
                float mx = s0[0];
#pragma unroll
                for (int r = 1; r < 16; ++r) mx = fmaxf(mx, s0[r]);
#pragma unroll
                for (int r = 0; r < 16; ++r) mx = fmaxf(mx, s1[r]);
                mx = fmaxf(mx, __shfl_xor(mx, 32));
                const float mnew = fmaxf(mrun, mx);
                const bool grew = mnew > mrun;
                const float alpha = __builtin_amdgcn_exp2f(mrun - mnew);
                mrun = mnew;
                float psum = 0.f;
#pragma unroll
                for (int r = 0; r < 16; ++r) { s0[r] = __builtin_amdgcn_exp2f(s0[r] - mnew); s1[r] = __builtin_amdgcn_exp2f(s1[r] - mnew); psum += s0[r] + s1[r]; }
                lrun = lrun * alpha + psum;
                if (__any(grew)) {
#pragma unroll
                    for (int r = 0; r < 16; ++r) { o0[r] *= alpha; o1[r] *= alpha; }
                }
                bf16x8 pf[4];
                pf[0] = pack8(s0[0], s0[1], s0[2], s0[3], s0[4], s0[5], s0[6], s0[7]);
                pf[1] = pack8(s0[8], s0[9], s0[10], s0[11], s0[12], s0[13], s0[14], s0[15]);
                pf[2] = pack8(s1[0], s1[1], s1[2], s1[3], s1[4], s1[5], s1[6], s1[7]);
                pf[3] = pack8(s1[8], s1[9], s1[10], s1[11], s1[12], s1[13], s1[14], s1[15]);
#pragma unroll
                for (int q4 = 0; q4 < 4; ++q4) { o0 = mfma32(v0[q4], pf[q4], o0); o1 = mfma32(v1[q4], pf[q4], o1); }
#pragma unroll
                for (int ks = 0; ks < 4; ++ks) { kc0[ks] = kn0[ks]; kc1[ks] = kn1[ks]; }
            }
            const float ltot = lrun + __shfl_xor(lrun, 32), inv = 1.0f / ltot;
            float ss = 0.f;
#pragma unroll
            for (int r = 0; r < 16; ++r) { o0[r] *= inv; o1[r] *= inv; ss += o0[r] * o0[r] + o1[r] * o1[r]; }
            ss += __shfl_xor(ss, 32);
            ssv[qt] = ss;
#pragma unroll
            for (int r = 0; r < 16; ++r) { park[(qt * 32 + r) * 64 + lane] = o0[r]; park[(qt * 32 + 16 + r) * 64 + lane] = o1[r]; }
        }
        if (hh == 0) { ssq[head * 64 + l31] = ssv[0]; ssq[head * 64 + 32 + l31] = ssv[1]; }
        __syncthreads();
#pragma unroll
        for (int qt = 0; qt < 2; ++qt) {
            const int qi = 32 * qt + l31;
            float tot = 0.f;
#pragma unroll
            for (int h2 = 0; h2 < 8; ++h2) tot += ssq[h2 * 64 + qi];
            const float rstd = rsqrtf(tot * (1.0f / 512.0f) + EPS);
            const size_t tok = (size_t)b * SEQ + n * 64 + qi;
#pragma unroll
            for (int dt = 0; dt < 2; ++dt)
#pragma unroll
                for (int g4 = 0; g4 < 4; ++g4) {
                    const int dim = 32 * dt + 8 * g4 + 4 * hh;
                    const f32x4 gn = *(const f32x4*)(P.attn_out_gain + head * 64 + dim);
                    const float* pk = park + (qt * 32 + dt * 16 + 4 * g4) * 64 + lane;
                    u32x2 w; w.x = pk2(pk[0] * rstd * gn[0], pk[64] * rstd * gn[1]); w.y = pk2(pk[128] * rstd * gn[2], pk[192] * rstd * gn[3]);
                    *(u32x2*)(mix + tok * DM + head * 64 + dim) = w;
                }
        }
        __syncthreads();
    }
}

constexpr int RP = 136, TP = 72, AP = 72, AIP = 24, LDB = 273, RAWP = 784  , STGP = 136  ;
constexpr int L_KB = 0, L_KK = 17408, L_QS = 34816, L_UT = 0, L_WT = 18432, L_AINV = 36864, L_QG = 52224, L_VBT = 69632, L_KBGT = 88064, L_KDT = 106496,
              L_NL = 124928, L_LD = 134144, L_AM = 138752, L_GC = 147968, L_RED = 148480;
static_assert(L_AINV + 4 * 16 * AIP * 2 <= L_QG && L_LD + 4 * LDB * 4 <= L_AM && L_RED + 4096 <= LDS_BYTES - 16, "lds map");

__device__ void dn1_phase(const Params& P, unsigned char* lds, int bid, int nblk) {
    const int tid0 = opaque_tid();
    bf16_t* KB = (bf16_t*)(lds + L_KB); bf16_t* KK = (bf16_t*)(lds + L_KK); bf16_t* QS = (bf16_t*)(lds + L_QS);
    bf16_t* UT = (bf16_t*)(lds + L_UT); bf16_t* WT = (bf16_t*)(lds + L_WT); bf16_t* AINV = (bf16_t*)(lds + L_AINV); bf16_t* QG = (bf16_t*)(lds + L_QG);
    bf16_t* VBT = (bf16_t*)(lds + L_VBT); bf16_t* KBGT = (bf16_t*)(lds + L_KBGT); bf16_t* KDT = (bf16_t*)(lds + L_KDT);
    bf16_t* NL = (bf16_t*)(lds + L_NL); float* LD = (float*)(lds + L_LD); bf16_t* AM = (bf16_t*)(lds + L_AM);
    float* gcs = (float*)(lds + L_GC); float* bts = gcs + 64; float* red = (float*)(lds + L_RED);
    const bf16_t* pb = (const bf16_t*)(P.ws + WS_PB);
    const float* betaG = (const float*)(P.ws + WS_BETA); const float* gG = (const float*)(P.ws + WS_G);
    bf16_t* negM = (bf16_t*)(P.ws + WS_NEGM); bf16_t* BmT = (bf16_t*)P.out; bf16_t* Qp = (bf16_t*)(P.ws + WS_QP); bf16_t* Ol = (bf16_t*)(P.ws + WS_OL);
    float* egl = (float*)(P.ws + WS_EGL);
    u32x4 rv[7]; float gpre = 0.f, bpre = 0.f;
#define DN1_PREFETCH(IT)                                                                                                   \
    {                                                                                                                      \
        const int tidp_ = tid0, n_ = (IT) & 31, bh_ = (IT) >> 5, h_ = bh_ & 3, b_ = bh_ >> 2;                               \
        _Pragma("unroll") for (int q = 0; q < 7; ++q) {                                                                    \
            const int ci = tidp_ + 512 * q, row = ci / 48, c16 = ci - row * 48, mat = c16 >> 4, cc = c16 & 15;             \
            const int srow = n_ * 64 - 3 + row;                                                                            \
            const bool ok = (ci < 67 * 48) && (srow >= 0);                                                                 \
            const bf16_t* src = pb + (size_t)(b_ * SEQ + (ok ? srow : 0)) * PBW + mat * 512 + h_ * 128 + cc * 8;           \
            rv[q] = *(const u32x4*)src;                                                                                    \
            if (!ok) rv[q] = (u32x4){0u, 0u, 0u, 0u};                                                                      \
        }                                                                                                                  \
        if (tidp_ < 64) { const size_t tg_ = (size_t)(b_ * SEQ + n_ * 64 + tidp_) * 4 + h_; gpre = gG[tg_]; bpre = betaG[tg_]; } \
    }
    unsigned* qctr = (unsigned*)P.ws + 4000;
    volatile int* qnext = (volatile int*)(lds + LDS_BYTES - 32);
    if (bid < 2048) { DN1_PREFETCH(bid) }
    int item = bid;
    while (item < 2048) {
        if (tid0 == 0) *qnext = nblk + (int)__hip_atomic_fetch_add(qctr, 1u, __ATOMIC_RELAXED, __HIP_MEMORY_SCOPE_AGENT);
        int tid = tid0; asm volatile("" : "+v"(tid));
        const int wid = tid >> 6, lane = tid & 63, fr = lane & 15, fq = lane >> 4;
        const int n = item & 31, bh = item >> 5, h = bh & 3, b = bh >> 2;
        const int t0 = b * SEQ + n * 64;
        if (wid == 0) {
            float gv = gpre;
#pragma unroll
            for (int o = 1; o < 64; o <<= 1) { const float t = __shfl_up(gv, o); if (lane >= o) gv += t; }
            gcs[lane] = gv; bts[lane] = bpre;
        }
#pragma unroll
        for (int q = 0; q < 7; ++q) {
            const int ci = tid + 512 * q, row = ci / 48, c16 = ci - row * 48;
            if (ci < 67 * 48) *(u32x4*)(lds + row * RAWP + c16 * 16) = rv[q];
        }
        __syncthreads();
        const int r = lane, cg = __builtin_amdgcn_readfirstlane(wid);
        float cv[3][16];
#pragma unroll
        for (int mat = 0; mat < 3; ++mat) {
            const int col = mat * 512 + h * 128 + 16 * cg;
            float* a = cv[mat];
#pragma unroll
            for (int i = 0; i < 16; ++i) a[i] = 0.f;
#pragma unroll
            for (int tap = 0; tap < 4; ++tap) {
                const unsigned char* src = lds + (r + tap) * RAWP + (mat * 128 + 16 * cg) * 2;
                const u32x4 x0 = *(const u32x4*)src, x1 = *(const u32x4*)(src + 16);
                const float* wp = P.conv_w + tap * 1536 + col;
                const f32x4 w0 = *(const f32x4*)wp, w1 = *(const f32x4*)(wp + 4), w2 = *(const f32x4*)(wp + 8), w3 = *(const f32x4*)(wp + 12);
                a[0] += bflo(x0.x) * w0[0]; a[1] += bfhi(x0.x) * w0[1]; a[2] += bflo(x0.y) * w0[2]; a[3] += bfhi(x0.y) * w0[3];
                a[4] += bflo(x0.z) * w1[0]; a[5] += bfhi(x0.z) * w1[1]; a[6] += bflo(x0.w) * w1[2]; a[7] += bfhi(x0.w) * w1[3];
                a[8] += bflo(x1.x) * w2[0]; a[9] += bfhi(x1.x) * w2[1]; a[10] += bflo(x1.y) * w2[2]; a[11] += bfhi(x1.y) * w2[3];
                a[12] += bflo(x1.z) * w3[0]; a[13] += bfhi(x1.z) * w3[1]; a[14] += bflo(x1.w) * w3[2]; a[15] += bfhi(x1.w) * w3[3];
            }
            float ss = 0.f;
#pragma unroll
            for (int i = 0; i < 16; ++i) { a[i] = silu_f(a[i]); ss += a[i] * a[i]; }
            if (mat < 2) red[(mat * 8 + cg) * 64 + r] = ss;
        }
        __syncthreads();
        {
            float sq = 0.f, sk = 0.f;
#pragma unroll
            for (int g8 = 0; g8 < 8; ++g8) { sq += red[g8 * 64 + r]; sk += red[(8 + g8) * 64 + r]; }
            const float gc = gcs[r], bt = bts[r], gl = gcs[63];
            const float eg = __expf(gc), edk = __expf(gl - gc);
            if (tid == 0) egl[item] = __expf(gl);
            const float rq = rsqrtf(sq + EPS) * 0.08838834764831845f, rk = rsqrtf(sk + EPS);
            u32x4 o0, o1;
#define STORE_ROW(ARR, A, F)                                                                                                             \
    {                                                                                                                                    \
        o0.x = pk2(A[0] * (F), A[1] * (F)); o0.y = pk2(A[2] * (F), A[3] * (F)); o0.z = pk2(A[4] * (F), A[5] * (F)); o0.w = pk2(A[6] * (F), A[7] * (F));       \
        o1.x = pk2(A[8] * (F), A[9] * (F)); o1.y = pk2(A[10] * (F), A[11] * (F)); o1.z = pk2(A[12] * (F), A[13] * (F)); o1.w = pk2(A[14] * (F), A[15] * (F)); \
        *(u32x4*)(ARR + r * RP + 16 * cg) = o0; *(u32x4*)(ARR + r * RP + 16 * cg + 8) = o1;                                              \
    }
            const float rqe = rq * eg, rkb = rk * bt, f1 = rk * bt * eg, f2 = rk * edk;
            STORE_ROW(QS, cv[0], rq)
            STORE_ROW(QG, cv[0], rqe)
            STORE_ROW(KK, cv[1], rk)
            STORE_ROW(KB, cv[1], rkb)
#undef STORE_ROW
#pragma unroll
            for (int i = 0; i < 16; ++i) {
                const int c = 16 * cg + i;
                KBGT[c * TP + r] = (bf16_t)f2bf(cv[1][i] * f1);
                KDT[c * TP + r] = (bf16_t)f2bf(cv[1][i] * f2);
                VBT[c * TP + r] = (bf16_t)f2bf(cv[2][i] * bt);
            }
        }
        __syncthreads();
        const int item_next = __builtin_amdgcn_readfirstlane(*qnext);
        if (item_next < 2048) { DN1_PREFETCH(item_next) }
        {
            const int mat = wid >> 2, ti = wid & 3;
            const bf16_t* Asrc = mat ? QS : KB;
            bf16x8 af[4];
#pragma unroll
            for (int ks = 0; ks < 4; ++ks) af[ks] = *(const bf16x8*)(Asrc + (16 * ti + fr) * RP + 32 * ks + 8 * fq);
            for (int tj = 0; tj < 4; ++tj) {
                const int j = 16 * tj + fr;
                if (tj > ti) {
                    if (mat) {
#pragma unroll
                        for (int rr = 0; rr < 4; ++rr) AM[(16 * ti + 4 * fq + rr) * AP + j] = 0;
                    }
                    continue;
                }
                f32x4 acc = (f32x4){0.f, 0.f, 0.f, 0.f};
#pragma unroll
                for (int ks = 0; ks < 4; ++ks) { const bf16x8 bf = *(const bf16x8*)(KK + j * RP + 32 * ks + 8 * fq); acc = mfma16(af[ks], bf, acc); }
                const float gj = gcs[j];
#pragma unroll
                for (int rr = 0; rr < 4; ++rr) {
                    const int i = 16 * ti + 4 * fq + rr;
                    const float dec = __expf(gcs[i] - gj);
                    if (mat == 0) {
                        if (tj < ti) NL[i * AP + j] = (bf16_t)f2bf(-acc[rr] * dec);
                        else LD[ti * LDB + (4 * fq + rr) * 17 + fr] = (i > j) ? acc[rr] * dec : 0.f;
                    } else AM[i * AP + j] = (bf16_t)f2bf((i >= j) ? acc[rr] * dec : 0.f);
                }
            }
        }
        __syncthreads();
        {
            {
                const int blk = lane >> 4, cp = lane & 15;
                float xv[16];
#pragma unroll
                for (int i = 0; i < 16; ++i) {
                    float a = (i == cp) ? 1.0f : 0.0f;
#pragma unroll
                    for (int jj = 0; jj < i; ++jj) a -= LD[blk * LDB + i * 17 + jj] * xv[jj];
                    xv[i] = a;
                }
#pragma unroll
                for (int i = 0; i < 16; ++i) AINV[(blk * 16 + i) * AIP + cp] = (bf16_t)f2bf(xv[i]);
            }
#pragma unroll 1
            for (int cti = 0; cti < 2; ++cti) {
                const int ct = 2 * wid + cti;
                const bf16_t* RT = (ct < 8) ? (VBT + (16 * ct) * TP) : (KBGT + (16 * (ct - 8)) * TP);
                bf16_t* XT = (ct < 8) ? (UT + (16 * ct) * TP) : (WT + (16 * (ct - 8)) * TP);
#pragma unroll
                for (int bq = 0; bq < 4; ++bq) {
                    const u32x2 r2 = *(const u32x2*)(RT + fr * TP + 16 * bq + 4 * fq);
                    f32x4 acc = (f32x4){bflo(r2.x), bfhi(r2.x), bflo(r2.y), bfhi(r2.y)};
                    if (bq > 0) {
#pragma unroll
                        for (int ks = 0; ks < (16 * bq + 31) / 32; ++ks) {
                            bf16x8 a = *(const bf16x8*)(NL + (16 * bq + fr) * AP + 32 * ks + 8 * fq);
                            bf16x8 xb = *(const bf16x8*)(XT + fr * TP + 32 * ks + 8 * fq);
                            if (32 * ks + 8 * fq >= 16 * bq) { a = (bf16x8){0, 0, 0, 0, 0, 0, 0, 0}; xb = (bf16x8){0, 0, 0, 0, 0, 0, 0, 0}; }
                            acc = mfma16(a, xb, acc);
                        }
                    }
                    u32x4 uf; uf.x = pk2(acc[0], acc[1]); uf.y = pk2(acc[2], acc[3]); uf.z = 0u; uf.w = 0u;
                    const u32x2 ai2 = *(const u32x2*)(AINV + (bq * 16 + fr) * AIP + 4 * fq);
                    u32x4 af; af.x = ai2.x; af.y = ai2.y; af.z = 0u; af.w = 0u;
                    f32x4 xo = (f32x4){0.f, 0.f, 0.f, 0.f};
                    xo = mfma16(__builtin_bit_cast(bf16x8, af), __builtin_bit_cast(bf16x8, uf), xo);
                    u32x2 o; o.x = pk2(xo[0], xo[1]); o.y = pk2(xo[2], xo[3]);
                    *(u32x2*)(XT + fr * TP + 16 * bq + 4 * fq) = o;
                }
            }
        }
        __syncthreads();
        {
            const size_t ib = (size_t)item * 16384;
            bf16_t* stg = (bf16_t*)(lds + L_VBT) + wid * (16 * STGP);
            {
                const bf16x8 b0 = *(const bf16x8*)(KDT + (16 * wid + fr) * TP + 8 * fq), b1 = *(const bf16x8*)(KDT + (16 * wid + fr) * TP + 32 + 8 * fq);
#pragma unroll
                for (int t = 0; t < 8; ++t) {
                    const bf16x8 a0 = *(const bf16x8*)(WT + (16 * t + fr) * TP + 8 * fq), a1 = *(const bf16x8*)(WT + (16 * t + fr) * TP + 32 + 8 * fq);
                    f32x4 acc = (f32x4){0.f, 0.f, 0.f, 0.f};
                    acc = mfma16(a0, b0, acc); acc = mfma16(a1, b1, acc);
                    u32x2 o; o.x = pk2(-acc[0], -acc[1]); o.y = pk2(-acc[2], -acc[3]);
                    *(u32x2*)(stg + fr * STGP + 16 * t + 4 * fq) = o;
                }
#pragma unroll
                for (int q = 0; q < 4; ++q) {
                    const int row = (lane >> 4) + 4 * q;
                    const u32x4 v = *(const u32x4*)(stg + row * STGP + (lane & 15) * 8);
                    *(u32x4*)(negM + ib + (size_t)(16 * wid + row) * 128 + (lane & 15) * 8) = v;
                }
            }
            {
                const bf16x8 b0 = *(const bf16x8*)(UT + (16 * wid + fr) * TP + 8 * fq), b1 = *(const bf16x8*)(UT + (16 * wid + fr) * TP + 32 + 8 * fq);
#pragma unroll
                for (int t = 0; t < 8; ++t) {
                    const bf16x8 a0 = *(const bf16x8*)(KDT + (16 * t + fr) * TP + 8 * fq), a1 = *(const bf16x8*)(KDT + (16 * t + fr) * TP + 32 + 8 * fq);
                    f32x4 acc = (f32x4){0.f, 0.f, 0.f, 0.f};
                    acc = mfma16(a0, b0, acc); acc = mfma16(a1, b1, acc);
                    u32x2 o; o.x = pk2(acc[0], acc[1]); o.y = pk2(acc[2], acc[3]);
                    *(u32x2*)(stg + fr * STGP + 16 * t + 4 * fq) = o;
                }
#pragma unroll
                for (int q = 0; q < 4; ++q) {
                    const int row = (lane >> 4) + 4 * q;
                    const u32x4 v = *(const u32x4*)(stg + row * STGP + (lane & 15) * 8);
                    *(u32x4*)(BmT + ib + (size_t)(16 * wid + row) * 128 + (lane & 15) * 8) = v;
                }
            }
            {
                const int it4 = wid & 3, hf = wid >> 2;
                const bf16x8 b0 = *(const bf16x8*)(AM + (16 * it4 + fr) * AP + 8 * fq), b1 = *(const bf16x8*)(AM + (16 * it4 + fr) * AP + 32 + 8 * fq);
#pragma unroll
                for (int tt = 0; tt < 4; ++tt) {
                    const int t = 4 * hf + tt;
                    const bf16x8 a0 = *(const bf16x8*)(WT + (16 * t + fr) * TP + 8 * fq), a1 = *(const bf16x8*)(WT + (16 * t + fr) * TP + 32 + 8 * fq);
                    f32x4 acc = (f32x4){0.f, 0.f, 0.f, 0.f};
                    acc = mfma16(a0, b0, acc); acc = mfma16(a1, b1, acc);
                    const u32x2 qg = *(const u32x2*)(QG + (16 * it4 + fr) * RP + 16 * t + 4 * fq);
                    u32x2 o; o.x = pk2(bflo(qg.x) - acc[0], bfhi(qg.x) - acc[1]); o.y = pk2(bflo(qg.y) - acc[2], bfhi(qg.y) - acc[3]);
                    *(u32x2*)(stg + fr * STGP + 16 * tt + 4 * fq) = o;
                }
#pragma unroll
                for (int q = 0; q < 2; ++q) {
                    const int row = (lane >> 3) + 8 * q;
                    const u32x4 v = *(const u32x4*)(stg + row * STGP + (lane & 7) * 8);
                    *(u32x4*)(Qp + (size_t)item * 8192 + (size_t)(16 * it4 + row) * 128 + 64 * hf + (lane & 7) * 8) = v;
                }
#pragma unroll
                for (int tt = 0; tt < 4; ++tt) {
                    const int t = 4 * hf + tt;
                    const bf16x8 a0 = *(const bf16x8*)(UT + (16 * t + fr) * TP + 8 * fq), a1 = *(const bf16x8*)(UT + (16 * t + fr) * TP + 32 + 8 * fq);
                    f32x4 acc = (f32x4){0.f, 0.f, 0.f, 0.f};
                    acc = mfma16(a0, b0, acc); acc = mfma16(a1, b1, acc);
                    u32x2 o; o.x = pk2(acc[0], acc[1]); o.y = pk2(acc[2], acc[3]);
                    *(u32x2*)(stg + fr * STGP + 16 * tt + 4 * fq) = o;
                }
#pragma unroll
                for (int q = 0; q < 2; ++q) {
                    const int row = (lane >> 3) + 8 * q;
                    const u32x4 v = *(const u32x4*)(stg + row * STGP + (lane & 7) * 8);
                    *(u32x4*)(Ol + (size_t)item * 8192 + (size_t)(16 * it4 + row) * 128 + 64 * hf + (lane & 7) * 8) = v;
                }
            }
        }
        __syncthreads();
        item = item_next;
    }
}
#undef DN1_PREFETCH

__device__ void dn2_phase(const Params& P, unsigned char* lds, int bid, int nblk) {
    const int tid = opaque_tid(), wid = tid >> 6, lane = tid & 63, fr = lane & 15, fq = lane >> 4;
    const bf16_t* negM = (const bf16_t*)(P.ws + WS_NEGM); const bf16_t* BmT = (const bf16_t*)P.out;
    const float* egl = (const float*)(P.ws + WS_EGL); bf16_t* SnT = (bf16_t*)(P.ws + WS_SNT);
    constexpr int SP = 136;
    bf16_t* ST = (bf16_t*)lds;
    for (int sid = bid; sid < 256; sid += nblk) {
        const int bh = sid >> 2, sl = sid & 3;
        f32x4 acc[2];
        acc[0] = (f32x4){0.f, 0.f, 0.f, 0.f}; acc[1] = (f32x4){0.f, 0.f, 0.f, 0.f};
        bf16x8 an[4]; u32x2 bmn[2]; float egn;
        {
            const size_t ib = ((size_t)bh * 32) * 16384;
#pragma unroll
            for (int ks = 0; ks < 4; ++ks) an[ks] = *(const bf16x8*)(negM + ib + (size_t)(16 * wid + fr) * 128 + 32 * ks + 8 * fq);
#pragma unroll
            for (int nn = 0; nn < 2; ++nn) bmn[nn] = *(const u32x2*)(BmT + ib + (size_t)(32 * sl + 16 * nn + fr) * 128 + 16 * wid + 4 * fq);
            egn = egl[bh * 32];
        }
        __syncthreads();
#pragma unroll
        for (int nn = 0; nn < 2; ++nn) *(u32x2*)(ST + (16 * nn + fr) * SP + 16 * wid + 4 * fq) = (u32x2){0u, 0u};
        __syncthreads();
        for (int n = 0; n < 32; ++n) {
            const bf16_t* cur = ST + (n & 1) * 32 * SP; bf16_t* nxt = ST + ((n & 1) ^ 1) * 32 * SP;
            const size_t ib = ((size_t)bh * 32 + n) * 16384;
            {
                const int col = tid >> 4, chn = tid & 15;
                *(u32x4*)(SnT + ib + (size_t)(32 * sl + col) * 128 + 8 * chn) = *(const u32x4*)(cur + col * SP + 8 * chn);
            }
            if (n == 31) break;
            bf16x8 a[4]; u32x2 bm[2];
#pragma unroll
            for (int ks = 0; ks < 4; ++ks) a[ks] = an[ks];
            bm[0] = bmn[0]; bm[1] = bmn[1];
            const float eg = egn;
            if (n + 1 < 31) {
                const size_t ib2 = ib + 16384;
#pragma unroll
                for (int ks = 0; ks < 4; ++ks) an[ks] = *(const bf16x8*)(negM + ib2 + (size_t)(16 * wid + fr) * 128 + 32 * ks + 8 * fq);
#pragma unroll
                for (int nn = 0; nn < 2; ++nn) bmn[nn] = *(const u32x2*)(BmT + ib2 + (size_t)(32 * sl + 16 * nn + fr) * 128 + 16 * wid + 4 * fq);
                egn = egl[bh * 32 + n + 1];
            }
#pragma unroll
            for (int nn = 0; nn < 2; ++nn) {
                acc[nn][0] = eg * acc[nn][0] + bflo(bm[nn].x); acc[nn][1] = eg * acc[nn][1] + bfhi(bm[nn].x);
                acc[nn][2] = eg * acc[nn][2] + bflo(bm[nn].y); acc[nn][3] = eg * acc[nn][3] + bfhi(bm[nn].y);
#pragma unroll
                for (int ks = 0; ks < 4; ++ks) {
                    const bf16x8 sb = *(const bf16x8*)(cur + (16 * nn + fr) * SP + 32 * ks + 8 * fq);
                    acc[nn] = mfma16(a[ks], sb, acc[nn]);
                }
                u32x2 o; o.x = pk2(acc[nn][0], acc[nn][1]); o.y = pk2(acc[nn][2], acc[nn][3]);
                *(u32x2*)(nxt + (16 * nn + fr) * SP + 16 * wid + 4 * fq) = o;
            }
            __syncthreads();
        }
    }
}

__device__ void dn3_phase(const Params& P, unsigned char* lds, int bid, int nblk) {
    const int tid = opaque_tid(), wid = tid >> 6, lane = tid & 63, fr = lane & 15, fq = lane >> 4;
    const bf16_t* SnT = (const bf16_t*)(P.ws + WS_SNT); const bf16_t* Qp = (const bf16_t*)(P.ws + WS_QP); const bf16_t* Ol = (const bf16_t*)(P.ws + WS_OL);
    const bf16_t* pb = (const bf16_t*)(P.ws + WS_PB); bf16_t* mix = (bf16_t*)(P.ws + WS_H);
    constexpr int SP3 = 136, SBUF = 128 * SP3 * 2;
    static_assert(4 * SBUF <= LDS_BYTES - 32, "dn3 staging");
    const int half = wid >> 2, q4 = wid & 3, th = tid & 255;
    struct Ops { u32x4 sv[8]; bf16x8 bq[4]; u32x2 olv[8], zv[8]; };
    auto loadOps = [&](int it2, Ops& o) {
        const int item = it2 * 2 + half;
        const int n = item & 31, bh = item >> 5, h = bh & 3, b = bh >> 2;
        const int i = 16 * q4 + fr;
        const bf16_t* sb = SnT + (size_t)item * 16384;
#pragma unroll
        for (int k = 0; k < 8; ++k) o.sv[k] = *(const u32x4*)(sb + (size_t)(th + 256 * k) * 8);
        const bf16_t* qrow = Qp + (size_t)item * 8192 + (size_t)i * 128;
#pragma unroll
        for (int ks = 0; ks < 4; ++ks) o.bq[ks] = *(const bf16x8*)(qrow + 32 * ks + 8 * fq);
        const bf16_t* olr = Ol + (size_t)item * 8192 + (size_t)i * 128;
        const size_t tok = (size_t)b * SEQ + n * 64 + i;
#pragma unroll
        for (int dt = 0; dt < 8; ++dt) { o.olv[dt] = *(const u32x2*)(olr + 16 * dt + 4 * fq); o.zv[dt] = *(const u32x2*)(pb + tok * PBW + 1536 + h * 128 + 16 * dt + 4 * fq); }
    };
    Ops cur;
    if (bid < 1024) loadOps(bid, cur);
    int par = 0;
    for (int it2 = bid; it2 < 1024; it2 += nblk, par ^= 1) {
        const int item = it2 * 2 + half;
        const int n = item & 31, bh = item >> 5, h = bh & 3, b = bh >> 2;
        const int i = 16 * q4 + fr;
        const size_t tok = (size_t)b * SEQ + n * 64 + i;
        unsigned char* SB = lds + (par * 2 + half) * SBUF;
#pragma unroll
        for (int k = 0; k < 8; ++k) { const int piece = th + 256 * k; *(u32x4*)(SB + (piece >> 4) * (SP3 * 2) + (piece & 15) * 16) = cur.sv[k]; }
        bf16x8 bq[4]; u32x2 olv[8], zv[8];
#pragma unroll
        for (int ks = 0; ks < 4; ++ks) bq[ks] = cur.bq[ks];
#pragma unroll
        for (int dt = 0; dt < 8; ++dt) { olv[dt] = cur.olv[dt]; zv[dt] = cur.zv[dt]; }
        __syncthreads();
        if (it2 + nblk < 1024) loadOps(it2 + nblk, cur);
        __builtin_amdgcn_sched_barrier(0);
        f32x4 acc[8];
#pragma unroll
        for (int dt = 0; dt < 8; ++dt) {
            acc[dt] = (f32x4){bflo(olv[dt].x), bfhi(olv[dt].x), bflo(olv[dt].y), bfhi(olv[dt].y)};
#pragma unroll
            for (int ks = 0; ks < 4; ++ks) { const bf16x8 a = *(const bf16x8*)(SB + (16 * dt + fr) * (SP3 * 2) + (32 * ks + 8 * fq) * 2); acc[dt] = mfma16(a, bq[ks], acc[dt]); }
        }
        float ss = 0.f;
#pragma unroll
        for (int dt = 0; dt < 8; ++dt) ss += acc[dt][0] * acc[dt][0] + acc[dt][1] * acc[dt][1] + acc[dt][2] * acc[dt][2] + acc[dt][3] * acc[dt][3];
        ss += __shfl_xor(ss, 16); ss += __shfl_xor(ss, 32);
        const float rstd = rsqrtf(ss * (1.0f / 128.0f) + EPS);
#pragma unroll
        for (int dt = 0; dt < 8; ++dt) {
            const int dv = 16 * dt + 4 * fq;
            const u32x2 z = zv[dt];
            const f32x4 gn = *(const f32x4*)(P.dn_out_gain + dv);
            u32x2 o;
            o.x = pk2(acc[dt][0] * rstd * gn[0] * silu_f(bflo(z.x)), acc[dt][1] * rstd * gn[1] * silu_f(bfhi(z.x)));
            o.y = pk2(acc[dt][2] * rstd * gn[2] * silu_f(bflo(z.y)), acc[dt][3] * rstd * gn[3] * silu_f(bfhi(z.y)));
            *(u32x2*)(mix + tok * DM + 512 + h * 128 + dv) = o;
        }
    }
}

__device__ __forceinline__ void sort16_desc(float (&v)[16]) {
#define CE_(A, B) { const float hi_ = fmaxf(v[A], v[B]), lo_ = fminf(v[A], v[B]); v[A] = hi_; v[B] = lo_; }
    CE_(0,13) CE_(1,12) CE_(2,15) CE_(3,14) CE_(4,8) CE_(5,6) CE_(7,11) CE_(9,10)
    CE_(0,5) CE_(1,7) CE_(2,9) CE_(3,4) CE_(6,13) CE_(8,14) CE_(10,15) CE_(11,12)
    CE_(0,1) CE_(2,3) CE_(4,5) CE_(6,8) CE_(7,9) CE_(10,11) CE_(12,13) CE_(14,15)
    CE_(0,2) CE_(1,3) CE_(4,10) CE_(5,11) CE_(6,7) CE_(8,9) CE_(12,14) CE_(13,15)
    CE_(1,2) CE_(3,12) CE_(4,6) CE_(5,7) CE_(8,10) CE_(9,11) CE_(13,14)
    CE_(1,4) CE_(2,6) CE_(5,8) CE_(7,10) CE_(9,13) CE_(11,14)
    CE_(2,4) CE_(3,6) CE_(9,12) CE_(11,13)
    CE_(3,5) CE_(6,8) CE_(7,9) CE_(10,12)
    CE_(3,4) CE_(5,6) CE_(7,8) CE_(9,10) CE_(11,12)
    CE_(6,7) CE_(8,9)
#undef CE_
}
__device__ __forceinline__ void merge_top16(float (&a)[16], const float (&b)[16]) {
#pragma unroll
    for (int i = 0; i < 16; ++i) a[i] = fmaxf(a[i], b[15 - i]);
#pragma unroll
    for (int j = 8; j > 0; j >>= 1) {
#pragma unroll
        for (int i = 0; i < 16; ++i) {
            const int l = i ^ j;
            if (l > i) { const float hi = fmaxf(a[i], a[l]), lo = fminf(a[i], a[l]); a[i] = hi; a[l] = lo; }
        }
    }
}
__device__ __forceinline__ unsigned lut16(unsigned long long lo, unsigned long long hi, unsigned idx) {
    const unsigned long long w = (idx & 8u) ? hi : lo;
    return (unsigned)(w >> ((idx & 7u) * 8u)) & 127u;
}

__device__ void route_phase(const Params& P, unsigned char* lds, int bid, int nblk) {
    const int tid = opaque_tid(), wid = tid >> 6, lane = tid & 63, l31 = lane & 31, hh = lane >> 5;
    const bf16_t* qry = (const bf16_t*)(P.ws + WS_PB); const bf16_t* skp = (const bf16_t*)(P.ws + WS_SK);
    {
#pragma unroll
        for (int i = 0; i < 8; ++i) {
            const int f = wid * 8 + i, p = f >> 5, kt = (f >> 3) & 3, ks = f & 7;
            const u32x4 v = *(const u32x4*)(skp + p * 16384 + (32 * kt + l31) * 128 + 16 * ks + 8 * hh);
            *(u32x4*)(lds + f * 1024 + lane * 16) = v;
        }
        __syncthreads();
    }
    for (int wi = bid * 8 + wid; wi < 1024 * 8; wi += nblk * 8) {
        const int tg = wi >> 3, hd = wi & 7;
        const int tok = tg * 32 + l31;
        const bf16_t* qrow = qry + (size_t)tok * 2048 + hd * 256;
        float top[2][16];
        float ssq = 0.f;
        bf16x8 bq[2][8];
#pragma unroll
        for (int p = 0; p < 2; ++p)
#pragma unroll
            for (int ks = 0; ks < 8; ++ks) {
                bq[p][ks] = *(const bf16x8*)(qrow + 128 * p + 16 * ks + 8 * hh);
                const u32x4 u = __builtin_bit_cast(u32x4, bq[p][ks]);
                ssq += bflo(u.x) * bflo(u.x) + bfhi(u.x) * bfhi(u.x) + bflo(u.y) * bflo(u.y) + bfhi(u.y) * bfhi(u.y) + bflo(u.z) * bflo(u.z) + bfhi(u.z) * bfhi(u.z) +
                       bflo(u.w) * bflo(u.w) + bfhi(u.w) * bfhi(u.w);
            }
        ssq += __shfl_xor(ssq, 32);
        const float rstd = rsqrtf(ssq * (1.0f / 256.0f) + EPS);
#pragma unroll
        for (int p = 0; p < 2; ++p) {
            float run[16];
#pragma unroll
            for (int kt = 0; kt < 4; ++kt) {
                __builtin_amdgcn_sched_barrier(0);
                f32x16 s;
#pragma unroll
                for (int r = 0; r < 16; ++r) s[r] = 0.f;
#pragma unroll
                for (int ks = 0; ks < 8; ++ks) { const bf16x8 a = *(const bf16x8*)(lds + ((p * 4 + kt) * 8 + ks) * 1024 + lane * 16); s = mfma32(a, bq[p][ks], s); }
                float cur[16];
#pragma unroll
                for (int r = 0; r < 16; ++r) {
                    const unsigned key = 32 * kt + (r & 3) + 8 * (r >> 2) + 4 * hh;
                    cur[r] = __uint_as_float((__float_as_uint(s[r] * rstd) & ~127u) | key);
                }
                sort16_desc(cur);
                if (kt == 0) {
#pragma unroll
                    for (int r = 0; r < 16; ++r) run[r] = cur[r];
                } else merge_top16(run, cur);
            }
            float oth[16];
#pragma unroll
            for (int r = 0; r < 16; ++r) oth[r] = __shfl_xor(run[r], 32);
            merge_top16(run, oth);
#pragma unroll
            for (int r = 0; r < 16; ++r) top[p][r] = run[r];
        }
        float v1[16], v2[16];
        unsigned long long p1lo = 0ull, p1hi = 0ull, p2lo = 0ull, p2hi = 0ull;
#pragma unroll
        for (int r = 0; r < 16; ++r) {
            const unsigned u1 = __float_as_uint(top[0][r]), u2 = __float_as_uint(top[1][r]);
            v1[r] = __uint_as_float(u1 & ~127u); v2[r] = __uint_as_float(u2 & ~127u);
            if (r < 8) { p1lo |= (unsigned long long)(u1 & 127u) << (8 * r); p2lo |= (unsigned long long)(u2 & 127u) << (8 * r); }
            else { p1hi |= (unsigned long long)(u1 & 127u) << (8 * (r - 8)); p2hi |= (unsigned long long)(u2 & 127u) << (8 * (r - 8)); }
        }
#define CAND(a, b) __uint_as_float((__float_as_uint(v1[a] + v2[b]) & ~255u) | (unsigned)((a) * 16 + (b)))
        const float NEG = -3.0e38f;
        float g0[16], g1[16], g2[16], g3[16];
#pragma unroll
        for (int r = 0; r < 16; ++r) g0[r] = CAND(0, r);
        g1[0] = CAND(1, 0); g1[1] = CAND(1, 1); g1[2] = CAND(1, 2); g1[3] = CAND(1, 3); g1[4] = CAND(1, 4); g1[5] = CAND(1, 5); g1[6] = CAND(1, 6); g1[7] = CAND(1, 7);
        g1[8] = CAND(2, 0); g1[9] = CAND(2, 1); g1[10] = CAND(2, 2); g1[11] = CAND(2, 3); g1[12] = CAND(2, 4); g1[13] = CAND(4, 0); g1[14] = CAND(4, 1); g1[15] = CAND(4, 2);
        g2[0] = CAND(3, 0); g2[1] = CAND(3, 1); g2[2] = CAND(3, 2); g2[3] = CAND(3, 3); g2[4] = CAND(5, 0); g2[5] = CAND(5, 1); g2[6] = CAND(6, 0); g2[7] = CAND(6, 1);
        g2[8] = CAND(7, 0); g2[9] = CAND(7, 1); g2[10] = CAND(8, 0); g2[11] = CAND(9, 0); g2[12] = CAND(10, 0); g2[13] = CAND(11, 0); g2[14] = CAND(12, 0); g2[15] = CAND(13, 0);
        g3[0] = CAND(14, 0); g3[1] = CAND(15, 0);
#pragma unroll
        for (int r = 2; r < 16; ++r) g3[r] = NEG;
#undef CAND
        sort16_desc(g1); sort16_desc(g2); sort16_desc(g3);
        merge_top16(g0, g1); merge_top16(g2, g3); merge_top16(g0, g2);
        float e[16], es = 0.f; int eid[16];
        const float m0 = __uint_as_float(__float_as_uint(g0[0]) & ~255u);
#pragma unroll
        for (int r = 0; r < 16; ++r) {
            const unsigned u = __float_as_uint(g0[r]);
            const float sv = __uint_as_float(u & ~255u);
            e[r] = __expf(sv - m0); es += e[r];
            const unsigned a = (u >> 4) & 15u, bb = u & 15u;
            eid[r] = (int)(lut16(p1lo, p1hi, a) * 128u + lut16(p2lo, p2hi, bb));
        }
        const float inv = 1.0f / es;
        if (hh == 0) {
            {
                bf16_t* i16 = (bf16_t*)(P.ws + WS_IDS16) + ((size_t)tok * 8 + hd) * 16;
                u32x4 a0, a1;
                a0.x = (unsigned)eid[0] | ((unsigned)eid[1] << 16); a0.y = (unsigned)eid[2] | ((unsigned)eid[3] << 16); a0.z = (unsigned)eid[4] | ((unsigned)eid[5] << 16); a0.w = (unsigned)eid[6] | ((unsigned)eid[7] << 16);
                a1.x = (unsigned)eid[8] | ((unsigned)eid[9] << 16); a1.y = (unsigned)eid[10] | ((unsigned)eid[11] << 16); a1.z = (unsigned)eid[12] | ((unsigned)eid[13] << 16); a1.w = (unsigned)eid[14] | ((unsigned)eid[15] << 16);
                *(u32x4*)i16 = a0; *(u32x4*)(i16 + 8) = a1;
                bf16_t* g16 = (bf16_t*)(P.ws + WS_GATES16) + ((size_t)tok * 8 + hd) * 16;
                u32x4 c0, c1;
                c0.x = pk2(e[0] * inv, e[1] * inv); c0.y = pk2(e[2] * inv, e[3] * inv); c0.z = pk2(e[4] * inv, e[5] * inv); c0.w = pk2(e[6] * inv, e[7] * inv);
                c1.x = pk2(e[8] * inv, e[9] * inv); c1.y = pk2(e[10] * inv, e[11] * inv); c1.z = pk2(e[12] * inv, e[13] * inv); c1.w = pk2(e[14] * inv, e[15] * inv);
                *(u32x4*)g16 = c0; *(u32x4*)(g16 + 8) = c1;
            }
        }
    }
}


#define XL_RANK(j) (3520 + 64 * (j))
struct XLabel { int NL, x, j, nloc; };
__device__ __forceinline__ XLabel xcd_label(const Params& P, const unsigned char* lds, int bid, int nblk) {
    XLabel L;
    L.NL = nblk < 8 ? nblk : 8; L.x = bid % L.NL; L.j = bid / L.NL; L.nloc = (nblk - L.x + L.NL - 1) / L.NL;
    const volatile unsigned* st = (const volatile unsigned*)(lds + LDS_BYTES - 16);
    const unsigned myx = st[2], myr = st[3];
    unsigned* bar = (unsigned*)P.ws;
    unsigned sum = 0u, mine = 0u; bool ok = true;
#pragma unroll
    for (unsigned k = 0; k < 8; ++k) { const unsigned c = __hip_atomic_load(&bar[256 + 64 * k], __ATOMIC_RELAXED, __HIP_MEMORY_SCOPE_AGENT); sum += c; ok = ok && (c > 0u); mine = (k == myx) ? c : mine; }
    if (ok && sum == (unsigned)nblk && myx < 8u && myr < mine) { L.NL = 8; L.x = (int)myx; L.j = (int)myr; L.nloc = (int)mine; }
    L.NL = __builtin_amdgcn_readfirstlane(L.NL); L.x = __builtin_amdgcn_readfirstlane(L.x); L.j = __builtin_amdgcn_readfirstlane(L.j); L.nloc = __builtin_amdgcn_readfirstlane(L.nloc);
    return L;
}

typedef int i32x2 __attribute__((ext_vector_type(2)));
typedef _Float16 f16x2h __attribute__((ext_vector_type(2)));
struct DnIds { u32x4 i0, i1; };
constexpr int DTB = 32;
constexpr int DR_IDS = 0, DR_H = 8192, DN_REGION = 12288;
static_assert(8 * DN_REGION <= LDS_BYTES - 32, "down-pass staging regions");
__device__ void peer_down_phase(const Params& P, unsigned char* lds, int bid, int nblk) {
    const int tid0 = opaque_tid(), wid = __builtin_amdgcn_readfirstlane(tid0 >> 6);
    int lane_v = tid0 & 63;
    const signed char* ed8 = (const signed char*)(P.ws + WS_ED8); const signed char* h8 = (const signed char*)(P.ws + WS_H8);
    const bf16_t* ids16 = (const bf16_t*)(P.ws + WS_IDS16); int* part = (int*)(P.ws + WS_PART);
    const XLabel XL = xcd_label(P, lds, bid, nblk);
    const int NL = XL.NL, x = XL.x, j = XL.j, nloc = XL.nloc;
    const int nw = nloc * 8, widx = j * 8 + wid;
    const int per = (((NTOK + nw - 1) / nw) + DTB - 1) / DTB * DTB;
    const int t0 = widx * per, t1 = (t0 + per) < NTOK ? (t0 + per) : NTOK;
    if (t0 >= t1) return;
    unsigned char* R = lds + wid * DN_REGION;
    for (int s = x; s < 8; s += NL) {
        asm volatile("" : "+v"(lane_v));
        const int lane = lane_v, e = lane >> 3, ch = lane & 7;
        const bool c0 = (lane & 1) != 0, c1 = (lane & 2) != 0, c2 = (lane & 4) != 0;
        auto issueH = [&](u32x4 (&S)[8], const DnIds& c, const int hf) {
            const signed char* base = ed8 + (size_t)s * NEXP * 128 + 16 * ch;
#pragma unroll
            for (int b = 0; b < 8; ++b) {
                const unsigned word = hf ? c.i1[b >> 1] : c.i0[b >> 1];
                const unsigned id = (b & 1) ? (word >> 16) : (word & 0xffffu);
                S[b] = *(const u32x4*)(base + (size_t)id * 128);
            }
        };
        auto computeH = [&](const u32x4 (&S)[8], const u32x4& h, int (&d)[16], const int hf) {
#pragma unroll
            for (int b = 0; b < 8; ++b) {
                int t = 0;
                t = __builtin_amdgcn_sdot4((int)S[b].x, (int)h.x, t, false); t = __builtin_amdgcn_sdot4((int)S[b].y, (int)h.y, t, false);
                t = __builtin_amdgcn_sdot4((int)S[b].z, (int)h.z, t, false); t = __builtin_amdgcn_sdot4((int)S[b].w, (int)h.w, t, false);
                const int bb = 8 * hf + b;
                d[(bb >> 1) + 8 * (bb & 1)] = t;
            }
        };
        int nbn = DTB - 4 * wid;
        for (int blk = t0, nb; blk < t1; blk += nb, nbn = DTB) {
            nb = nbn;
            nb = (t1 - blk) < nb ? (t1 - blk) : nb;
            {
                u32x4 st[12];
                const char* gi = (const char*)ids16 + (size_t)blk * 256 + lane * 16;
#pragma unroll
                for (int k = 0; k < 8; ++k) st[k] = *(const u32x4*)(gi + k * 1024);
                const char* gh = (const char*)h8 + ((size_t)(blk + (lane >> 3)) * DM + 128 * s) + (lane & 7) * 16;
#pragma unroll
                for (int k = 0; k < 4; ++k) st[8 + k] = *(const u32x4*)(gh + (size_t)k * 8 * DM);
                unsigned char* Rl = R + lane * 16;
#pragma unroll
                for (int k = 0; k < 8; ++k) *(u32x4*)(Rl + DR_IDS + k * 1024) = st[k];
#pragma unroll
                for (int k = 0; k < 4; ++k) *(u32x4*)(Rl + DR_H + k * 1024) = st[8 + k];
            }
            auto ldsIds = [&](int tt) -> DnIds { const u32x4* p = (const u32x4*)(R + DR_IDS + tt * 256 + 32 * e); DnIds c; c.i0 = p[0]; c.i1 = p[1]; return c; };
            u32x4 HA[8], HB[8];
            {
                const DnIds ic = ldsIds(0);
                issueH(HA, ic, 0); __builtin_amdgcn_sched_barrier(0); issueH(HB, ic, 1);
                __builtin_amdgcn_sched_barrier(0);
            }
            auto iter = [&](const int tt, auto moreTag) -> unsigned {
                constexpr bool more = decltype(moreTag)::value;
                const DnIds inx = ldsIds(more ? tt + 1 : tt);
                const u32x4 hreg = *(const u32x4*)(R + DR_H + tt * 128 + 16 * ch);
                int d[16];
                computeH(HA, hreg, d, 0); __builtin_amdgcn_sched_barrier(0); if constexpr (more) issueH(HA, inx, 0); __builtin_amdgcn_sched_barrier(0);
                computeH(HB, hreg, d, 1); __builtin_amdgcn_sched_barrier(0); if constexpr (more) issueH(HB, inx, 1); __builtin_amdgcn_sched_barrier(0);
                int e8[8], f4[4], g2[2];
#pragma unroll
                for (int q = 0; q < 8; ++q) { const int keep = c0 ? d[2 * q + 1] : d[2 * q], send = c0 ? d[2 * q] : d[2 * q + 1]; e8[q] = keep + __shfl_xor(send, 1); }
#pragma unroll
                for (int q = 0; q < 4; ++q) { const int keep = c1 ? e8[2 * q + 1] : e8[2 * q], send = c1 ? e8[2 * q] : e8[2 * q + 1]; f4[q] = keep + __shfl_xor(send, 2); }
#pragma unroll
                for (int q = 0; q < 2; ++q) { const int keep = c2 ? f4[2 * q + 1] : f4[2 * q], send = c2 ? f4[2 * q] : f4[2 * q + 1]; g2[q] = keep + __shfl_xor(send, 4); }
                const auto pk = __builtin_amdgcn_cvt_pkrtz((float)g2[0] * 0.015625f, (float)g2[1] * 0.015625f);
                return __builtin_bit_cast(unsigned, pk);
            };
            u32x4* pq = (u32x4*)part + ((size_t)s * (NTOK / 4) + (size_t)(blk >> 2)) * 64 + lane;
            for (int tt = 0; tt + 4 < nb; tt += 4, pq += 64) {
                u32x4 o;
                o.x = iter(tt, std::true_type{}); o.y = iter(tt + 1, std::true_type{}); o.z = iter(tt + 2, std::true_type{}); o.w = iter(tt + 3, std::true_type{});
                *pq = o;
            }
            {
                u32x4 o;
                o.x = iter(nb - 4, std::true_type{}); o.y = iter(nb - 3, std::true_type{}); o.z = iter(nb - 2, std::true_type{}); o.w = iter(nb - 1, std::false_type{});
                *pq = o;
            }
        }
    }
}

__device__ __forceinline__ float gelu_erf(float v) {
    const float av = fabsf(v), t = __builtin_amdgcn_rcpf(av * 0.2316418882f + 1.0f);
    float q = t * 0.5307027145f + (-0.7265760135f); q = q * t + 0.7107068705f; q = q * t + (-0.142248368f); q = q * t + 0.127414796f; q = q * t;
    const float ex = __builtin_amdgcn_exp2f(v * v * (-0.72134752044f));
    const float m = v * (q * ex);
    return v < 0.f ? m : v - m;
}
__device__ void peer_combine_phase(const Params& P, unsigned char* lds, int bid, int nblk) {
    const int tid = opaque_tid(), wid = tid >> 6, lane = tid & 63;
    const int* part = (const int*)(P.ws + WS_PART);
    const float* SD = (const float*)(P.ws + WS_SD); const float* SU = (const float*)(P.ws + WS_SU); const float* HS = (const float*)(P.ws + WS_HS);
    const unsigned* ids16 = (const unsigned*)(P.ws + WS_IDS16); const unsigned* gates16 = (const unsigned*)(P.ws + WS_GATES16);
    unsigned short* wq = (unsigned short*)(P.ws + WS_WQ8); float* wsc = (float*)(P.ws + WS_WSC);
    static_assert(2 * NEXP * 4 <= LDS_BYTES - 32, "combine tables");
    float* sdL = (float*)lds; float* suL = sdL + NEXP;
    {
#pragma unroll
        for (int k = 0; k < 8; ++k) { const int o = (tid + 512 * k) * 4; *(f32x4*)(sdL + o) = *(const f32x4*)(SD + o); *(f32x4*)(suL + o) = *(const f32x4*)(SU + o); }
        __syncthreads();
    }
    constexpr int CU_ = 4;
    const int tstep = nblk * 8;
    for (int qd = bid * 8 + wid; qd < NTOK / 4; qd += tstep) {
        unsigned pv[CU_][8]; unsigned idp[CU_], gtp[CU_]; float hs[CU_]; int tk[CU_];
#pragma unroll
        for (int s = 0; s < 8; ++s) {
            const u32x4 q4 = *((const u32x4*)part + ((size_t)s * (NTOK / 4) + (size_t)qd) * 64 + lane);
            pv[0][s] = q4.x; pv[1][s] = q4.y; pv[2][s] = q4.z; pv[3][s] = q4.w;
        }
#pragma unroll
        for (int u = 0; u < CU_; ++u) {
            tk[u] = qd * 4 + u;
            idp[u] = ids16[(size_t)tk[u] * 64 + lane]; gtp[u] = gates16[(size_t)tk[u] * 64 + lane]; hs[u] = HS[tk[u]];
        }
        __builtin_amdgcn_sched_barrier(0);
        float sd0[CU_], sd1[CU_], su0[CU_], su1[CU_];
#pragma unroll
        for (int u = 0; u < CU_; ++u) { const unsigned id0 = idp[u] & 0xffffu, id1 = idp[u] >> 16; sd0[u] = sdL[id0]; sd1[u] = sdL[id1]; su0[u] = suL[id0]; su1[u] = suL[id1]; }
        __builtin_amdgcn_sched_barrier(0);
#pragma unroll
        for (int u = 0; u < CU_; ++u) {
            float a0 = 0.f, a1 = 0.f;
#pragma unroll
            for (int s = 0; s < 8; ++s) { const f16x2h hv = __builtin_bit_cast(f16x2h, pv[u][s]); a0 += (float)hv[0]; a1 += (float)hv[1]; }
            const float f0 = a0 * 64.0f * sd0[u] * hs[u], f1 = a1 * 64.0f * sd1[u] * hs[u];
            const float w0 = bflo(gtp[u]) * gelu_erf(f0) * su0[u], w1 = bfhi(gtp[u]) * gelu_erf(f1) * su1[u];
            float am = fmaxf(fabsf(w0), fabsf(w1));
            am = fmaxf(am, __shfl_xor(am, 1)); am = fmaxf(am, __shfl_xor(am, 2)); am = fmaxf(am, __shfl_xor(am, 4)); am = fmaxf(am, __shfl_xor(am, 16)); am = fmaxf(am, __shfl_xor(am, 32));
            am = am > 0.f ? am : 1.0f;
            const float inv = 127.0f / am;
            const int q0 = (int)rintf(w0 * inv), q1 = (int)rintf(w1 * inv);
            wq[(size_t)tk[u] * 64 + lane] = (unsigned short)((unsigned)(q0 & 255) | ((unsigned)(q1 & 255) << 8));
            if ((lane & 0x37) == 0) wsc[(size_t)tk[u] * 2 + (lane >> 3)] = am * (1.0f / 127.0f);
        }
    }
}

typedef float f32x2 __attribute__((ext_vector_type(2)));
typedef int i32x4 __attribute__((ext_vector_type(4)));
struct UpIds { u32x4 i0, i1; };
constexpr int UTB = 16;
constexpr int UR_IDS = 0, UR_WQ = 4096, UR_X = 6144, UR_DL = 14336, UR_SC = 18432, UP_REGION = 18560;
static_assert(8 * UP_REGION <= LDS_BYTES - 32, "up-pass staging regions");
__device__ void peer_up_phase(const Params& P, unsigned char* lds, int bid, int nblk) {
    const int tid0 = opaque_tid(), wid = __builtin_amdgcn_readfirstlane(tid0 >> 6);
    int lane_v = tid0 & 63;
    const signed char* eu8 = (const signed char*)(P.ws + WS_EU8);
    const bf16_t* dlt = (const bf16_t*)(P.ws + WS_DLT);
    const bf16_t* ids16 = (const bf16_t*)(P.ws + WS_IDS16); const signed char* wq8 = (const signed char*)(P.ws + WS_WQ8); const float* wsc = (const float*)(P.ws + WS_WSC);
    const float* mod = (const float*)(P.ws + WS_MOD);
    const XLabel XL = xcd_label(P, lds, bid, nblk);
    const int NL = XL.NL, x = XL.x, j = XL.j, nloc = XL.nloc;
    const int nw = nloc * 8, widx = j * 8 + wid;
    const int per = (((NTOK + nw - 1) / nw) + UTB - 1) / UTB * UTB;
    const int t0 = widx * per, t1 = (t0 + per) < NTOK ? (t0 + per) : NTOK;
    if (t0 >= t1) return;
    unsigned char* R = lds + wid * UP_REGION;
    for (int s = x; s < 8; s += NL) {
        asm volatile("" : "+v"(lane_v));
        const int lane = lane_v, e = lane >> 3, ch = lane & 7;
        const bool hi = (lane & 8) != 0;
        const int colp = 16 * ch + 4 * (lane >> 4) + (hi ? 2 : 0), col = 128 * s + colp;
        unsigned mk[4];
#pragma unroll
        for (int r = 0; r < 4; ++r) mk[r] = (((lane & 15) >> 2) == r) ? (0xFFu << (8 * (lane & 3))) : 0u;
        auto issueH = [&](u32x4 (&S)[8], const UpIds& c, const int hf) {
            const signed char* base = eu8 + (size_t)s * NEXP * 128 + 16 * ch;
#pragma unroll
            for (int b = 0; b < 8; ++b) {
                const unsigned word = hf ? c.i1[b >> 1] : c.i0[b >> 1];
                const unsigned id = (b & 1) ? (word >> 16) : (word & 0xffffu);
                S[b] = *(const u32x4*)(base + (size_t)id * 128);
            }
        };
        auto computeH = [&](const u32x4 (&S)[8], const u32x4& wa, const u32x4& wb, i32x4& acc0, i32x4& acc1, const int hf) {
#pragma unroll
            for (int b = 0; b < 8; ++b) {
                const int bb = 8 * hf + b;
                const unsigned sel = 0x01010101u * (unsigned)(bb & 3);
                const unsigned r0 = __builtin_amdgcn_perm(wa[bb >> 2], wa[bb >> 2], sel), r1 = __builtin_amdgcn_perm(wb[bb >> 2], wb[bb >> 2], sel);
                const i32x4 A0 = {(int)(r0 & mk[0]), (int)(r0 & mk[1]), (int)(r0 & mk[2]), (int)(r0 & mk[3])};
                const i32x4 A1 = {(int)(r1 & mk[0]), (int)(r1 & mk[1]), (int)(r1 & mk[2]), (int)(r1 & mk[3])};
                const i32x4 Bv = {(int)S[b].x, (int)S[b].y, (int)S[b].z, (int)S[b].w};
                acc0 = __builtin_amdgcn_mfma_i32_16x16x64_i8(A0, Bv, acc0, 0, 0, 0);
                acc1 = __builtin_amdgcn_mfma_i32_16x16x64_i8(A1, Bv, acc1, 0, 0, 0);
            }
        };
        int nbn = UTB - 2 * wid;
        for (int blk = t0, nb; blk < t1; blk += nb, nbn = UTB) {
            nb = nbn;
            nb = (t1 - blk) < nb ? (t1 - blk) : nb;
            nb = (2048 - (blk & 2047)) < nb ? (2048 - (blk & 2047)) : nb;
            {
                u32x4 st[18];
                const u32x4 stsc = *(const u32x4*)((const char*)wsc + (size_t)blk * 8 + (lane & 7) * 16);
                const char* gi = (const char*)ids16 + (size_t)blk * 256 + lane * 16;
#pragma unroll
                for (int k = 0; k < 4; ++k) st[k] = *(const u32x4*)(gi + k * 1024);
                const char* gw = (const char*)wq8 + (size_t)blk * 128 + lane * 16;
#pragma unroll
                for (int k = 0; k < 2; ++k) st[4 + k] = *(const u32x4*)(gw + k * 1024);
                const char* gx = (const char*)P.x + (size_t)(128 * s) * 4 + (lane & 31) * 16;
#pragma unroll
                for (int k = 0; k < 8; ++k) { int tx = blk + 2 * k + (lane >> 5); tx = tx < NTOK ? tx : NTOK - 1; st[6 + k] = *(const u32x4*)(gx + (size_t)tx * DM * 4); }
                const char* gd = (const char*)dlt + ((size_t)(blk + (lane >> 4)) * DM + 128 * s) * 2 + (lane & 15) * 16;
#pragma unroll
                for (int k = 0; k < 4; ++k) st[14 + k] = *(const u32x4*)(gd + (size_t)k * 4 * DM * 2);
                unsigned char* Rl = R + lane * 16;
#pragma unroll
                for (int k = 0; k < 4; ++k) *(u32x4*)(Rl + UR_IDS + k * 1024) = st[k];
#pragma unroll
                for (int k = 0; k < 2; ++k) *(u32x4*)(Rl + UR_WQ + k * 1024) = st[4 + k];
#pragma unroll
                for (int k = 0; k < 8; ++k) *(u32x4*)(Rl + UR_X + k * 1024) = st[6 + k];
#pragma unroll
                for (int k = 0; k < 4; ++k) *(u32x4*)(Rl + UR_DL + k * 1024) = st[14 + k];
                if (lane < 8) *(u32x4*)(Rl + UR_SC) = stsc;
            }
            const f32x2 g2 = *(const f32x2*)(mod + (blk >> 11) * 6144 + 5120 + col);
            auto ldsIds = [&](int tt) -> UpIds { const u32x4* p = (const u32x4*)(R + UR_IDS + tt * 256 + 32 * e); UpIds c; c.i0 = p[0]; c.i1 = p[1]; return c; };
            u32x4 HA[8], HB[8];
            {
                const UpIds ic = ldsIds(0);
                issueH(HA, ic, 0); __builtin_amdgcn_sched_barrier(0); issueH(HB, ic, 1);
                __builtin_amdgcn_sched_barrier(0);
            }
            auto iter = [&](const int tt, auto moreTag) {
                constexpr bool more = decltype(moreTag)::value;
                const UpIds inx = ldsIds(more ? tt + 1 : tt);
                const u32x4* wp = (const u32x4*)(R + UR_WQ + tt * 128 + 32 * (lane >> 4));
                const u32x4 w0 = wp[0], w1 = wp[1];
                const f32x2 xv = *(const f32x2*)(R + UR_X + tt * 512 + 4 * colp); const unsigned dv = *(const unsigned*)(R + UR_DL + tt * 256 + 2 * colp);
                const float scl = *(const float*)(R + UR_SC + tt * 8 + (hi ? 4 : 0));
                i32x4 acc0 = {0, 0, 0, 0}, acc1 = {0, 0, 0, 0};
                computeH(HA, w0, w1, acc0, acc1, 0); __builtin_amdgcn_sched_barrier(0); if constexpr (more) issueH(HA, inx, 0); __builtin_amdgcn_sched_barrier(0);
                computeH(HB, w0, w1, acc0, acc1, 1); __builtin_amdgcn_sched_barrier(0); if constexpr (more) issueH(HB, inx, 1); __builtin_amdgcn_sched_barrier(0);
                {
                    float v[4];
#pragma unroll
                    for (int r = 0; r < 4; ++r) v[r] = (float)(hi ? acc1[r] : acc0[r]) * scl;
                    const float k0 = hi ? v[2] : v[0], k1 = hi ? v[3] : v[1], s0 = hi ? v[0] : v[2], s1 = hi ? v[1] : v[3];
                    const float y0 = k0 + __shfl_xor(s0, 8), y1 = k1 + __shfl_xor(s1, 8);
                    f32x2 o; o[0] = xv[0] + bflo(dv) + g2[0] * y0; o[1] = xv[1] + bfhi(dv) + g2[1] * y1;
                    *(f32x2*)(P.out + (size_t)(blk + tt) * DM + col) = o;
                }
            };
            for (int tt = 0; tt + 1 < nb; ++tt) iter(tt, std::true_type{});
            iter(nb - 1, std::false_type{});
        }
    }
}

#define XB_TMO      128
#define XB_XCNT(j)  (256  + 64 * (j))
#define XB_XSUB(j)  (1280 + 64 * (j))
#define XB_XGEN(j)  (2304 + 64 * (j))
#define XB_TOP      3328
#define XB_TOPGEN   3392
#define XCD_BAR_WORDS 3456
#define XB_SPIN_CAP (1u << 23)
__device__ __forceinline__ unsigned xb_ld(unsigned* p)              { return __hip_atomic_load(p, __ATOMIC_RELAXED, __HIP_MEMORY_SCOPE_AGENT); }
__device__ __forceinline__ unsigned xb_add(unsigned* p, unsigned v) { return __hip_atomic_fetch_add(p, v, __ATOMIC_RELAXED, __HIP_MEMORY_SCOPE_AGENT); }
__device__ __forceinline__ unsigned xb_xcc_id() { return (unsigned)__builtin_amdgcn_s_getreg((3 << 11) | 20) & 0xFu; }
#define XB_SPIN(cond, bar) do { unsigned _sp = 0; while (cond) { __builtin_amdgcn_s_sleep(1); \
    if ((++_sp & 255u) == 0u) { if (xb_ld(&(bar)[XB_TMO])) break; if (_sp > XB_SPIN_CAP) { atomicAdd(&(bar)[XB_TMO], 1u); break; } } } } while (0)
struct XcdBarrier { unsigned* bar; unsigned x; volatile unsigned* st; };
__device__ __forceinline__ XcdBarrier xcd_barrier_post(unsigned* bar, volatile unsigned* st) {
    XcdBarrier b; b.bar = bar; b.x = xb_xcc_id(); b.st = st;
    if (threadIdx.x == 0) (void)xb_add(&bar[XB_XCNT(b.x)], 1u);
    return b;
}
__device__ __forceinline__ void xcd_barrier_complete(unsigned* bar, unsigned x, unsigned& nloc, unsigned& nx) {
    const unsigned G = gridDim.x * gridDim.y * gridDim.z;
    unsigned sum, cnt, mine, sp = 0u;
    for (;;) {
        sum = 0u; cnt = 0u; mine = 0u;
#pragma unroll
        for (unsigned j = 0; j < 16; ++j) { const unsigned c = xb_ld(&bar[XB_XCNT(j)]); sum += c; cnt += (c > 0u) ? 1u : 0u; mine = (j == x) ? c : mine; }
        if (sum == G) break;
        __builtin_amdgcn_s_sleep(1);
        if ((++sp & 255u) == 0u) { if (xb_ld(&bar[XB_TMO])) break; if (sp > XB_SPIN_CAP) { atomicAdd(&bar[XB_TMO], 1u); break; } }
    }
    nloc = mine > 0u ? mine : 1u; nx = cnt > 0u ? cnt : 1u;
}
__device__ __forceinline__ void xcd_barrier(const XcdBarrier& b) {
    asm volatile("s_waitcnt vmcnt(0)" ::: "memory");
    __syncthreads();
    if (threadIdx.x == 0) {
        unsigned* bar = b.bar;
        __builtin_amdgcn_s_waitcnt(0);
        unsigned nloc = b.st[0], nx = b.st[1];
        if (nloc == 0u) { xcd_barrier_complete(bar, b.x, nloc, nx); b.st[0] = nloc; b.st[1] = nx; }
        const unsigned old = xb_add(&bar[XB_XSUB(b.x)], 1u);
        const unsigned gen = old / nloc;
        if (old + 1u == (gen + 1u) * nloc) {
            __builtin_amdgcn_fence(__ATOMIC_RELEASE, "agent");
            asm volatile("s_waitcnt vmcnt(0)" ::: "memory");
            const unsigned og = xb_add(&bar[XB_TOP], 1u);
            const unsigned tg = og / nx;
            if (og + 1u == (tg + 1u) * nx) xb_add(&bar[XB_TOPGEN], 1u);
            else XB_SPIN(xb_ld(&bar[XB_TOPGEN]) == tg, bar);
            __builtin_amdgcn_fence(__ATOMIC_ACQUIRE, "agent");
            xb_add(&bar[XB_XGEN(b.x)], 1u);
            asm volatile("s_waitcnt vmcnt(0)" ::: "memory");
        } else {
            XB_SPIN(xb_ld(&bar[XB_XGEN(b.x)]) == gen, bar);
            __builtin_amdgcn_fence(__ATOMIC_ACQUIRE, "agent");
            asm volatile("s_waitcnt vmcnt(0)" ::: "memory");
        }
    }
    __syncthreads();
}

constexpr int NPHASES = 11;
__device__ __forceinline__ void run_phase(const Params& P, int ph, unsigned char* lds, int bid, int nblk) {
    const float* mod = (const float*)(P.ws + WS_MOD);
    switch (ph) {
        case 0: phase0(P, lds, bid, nblk); break;
        case 1: norm_mod_phase<true, false>(P, P.x, nullptr, nullptr, P.norm1_gain, mod, 0, 1024, (bf16_t*)(P.ws + WS_H), bid, nblk); break;
        case 2: {
            const bf16_t* h1 = (const bf16_t*)(P.ws + WS_H); const bf16_t* wt = (const bf16_t*)(P.ws + WS_WINT);
            EpiInAll e{EpiQK{P.q_gain, P.k_gain, (bf16_t*)(P.ws + WS_QA), (bf16_t*)(P.ws + WS_KA)}, EpiV{(bf16_t*)(P.ws + WS_VT)}, EpiBf{(bf16_t*)(P.ws + WS_PB), PBW}};
            gemm_run(h1, wt, NTOK, 3584, DM, e, lds, bid, nblk);
        } break;
        case 3: attn_phase(P, lds, bid, nblk); __syncthreads(); dn1_phase(P, lds, bid, nblk); break;
        case 4: dn2_phase(P, lds, bid, nblk); break;
        case 5: dn3_phase(P, lds, bid, nblk); break;
        case 6: {
            EpiOut e{mod, (bf16_t*)(P.ws + WS_DLT)};
            gemm_run((const bf16_t*)(P.ws + WS_H), (const bf16_t*)(P.ws + WS_WOUTT), NTOK, DM, DM, e, lds, bid, nblk);
        } break;
        case 7: norm_mod_phase<false, true>(P, P.x, (const bf16_t*)(P.ws + WS_DLT), P.out, P.norm2_gain, mod, 3072, 4096, (bf16_t*)(P.ws + WS_H), bid, nblk); break;
        case 8: {
            EpiBf e{(bf16_t*)(P.ws + WS_PB), 2048};
            gemm_run((const bf16_t*)(P.ws + WS_H), (const bf16_t*)(P.ws + WS_WQT), NTOK, 2048, DM, e, lds, bid, nblk);
        } break;
        case 9: route_phase(P, lds, bid, nblk); break;
        case 10: peer_down_phase(P, lds, bid, nblk); break;
        case 12: peer_combine_phase(P, lds, bid, nblk); break;
        case 11: peer_up_phase(P, lds, bid, nblk); break;
        default: break;
    }
}

#if MULTI_LAUNCH
template <int PH>
__global__ void __launch_bounds__(NTHREADS) k_phase(Params P) {
    __shared__ __attribute__((aligned(16))) unsigned char lds[LDS_BYTES];
    run_phase(P, PH, lds, blockIdx.x, gridDim.x);
}
#else
__global__ void __launch_bounds__(NTHREADS) k_mega(Params P) {
    __shared__ __attribute__((aligned(16))) unsigned char lds[LDS_BYTES];
    cg::grid_group grid = cg::this_grid();
    const int bid = blockIdx.x, nblk = gridDim.x;
    volatile unsigned* st = (volatile unsigned*)(lds + LDS_BYTES - 16);
    if (threadIdx.x == 0) {
        st[0] = 0u; st[1] = 0u;
        const unsigned xcc = xb_xcc_id();
        st[2] = xcc; st[3] = __hip_atomic_fetch_add((unsigned*)P.ws + XL_RANK(xcc & 7u), 1u, __ATOMIC_RELAXED, __HIP_MEMORY_SCOPE_AGENT);
    }
    __syncthreads();
    const XcdBarrier xb = xcd_barrier_post((unsigned*)P.ws, st);
#define PH_(N) run_phase(P, N, lds, bid, nblk)
#define XBAR() xcd_barrier(xb)
    if (P.ws == nullptr) grid.sync();
    PH_(0); XBAR(); PH_(1); XBAR(); PH_(2); XBAR(); PH_(3); XBAR(); PH_(4); XBAR(); PH_(5); XBAR();
    PH_(6); XBAR(); PH_(7); XBAR(); PH_(8); XBAR(); PH_(9); XBAR(); PH_(10); XBAR(); PH_(12); XBAR(); PH_(11);
#undef PH_
#undef XBAR
}
#endif

extern "C" void kernel_launch(void* const* d_in, const int* in_sizes, int n_in, void* d_out, int out_size, void* d_ws, size_t ws_size, hipStream_t stream) {
    static int grid = 0;
    if (grid == 0) {
        if (n_in != 22 || out_size != NTOK * DM || ws_size < WS_END) { fprintf(stderr, "kernel_launch: unexpected shapes (n_in %d out %d ws %zu)\n", n_in, out_size, ws_size); grid = -1; return; }
        int dev = 0, cus = 0, per_cu = 0;
        (void)hipGetDevice(&dev);
        (void)hipDeviceGetAttribute(&cus, hipDeviceAttributeMultiprocessorCount, dev);
#if MULTI_LAUNCH
        (void)hipOccupancyMaxActiveBlocksPerMultiprocessor(&per_cu, k_phase<3>, NTHREADS, 0);
#else
        (void)hipOccupancyMaxActiveBlocksPerMultiprocessor(&per_cu, k_mega, NTHREADS, 0);
#endif
        if (per_cu < 1) { fprintf(stderr, "kernel_launch: occupancy query says %d blocks per CU\n", per_cu); per_cu = 1; }
        grid = cus;
        (void)hipGetLastError();
    }
    if (grid < 0) return;
    Params p{};
    const float** pp = (const float**)&p;
    for (int i = 0; i < 22; ++i) pp[i] = (const float*)d_in[i];
    p.out = (float*)d_out; p.ws = (unsigned char*)d_ws;
#if MULTI_LAUNCH
    (void)hipMemsetAsync(d_ws, 0, 16384, stream);
#define LP_(PH) hipLaunchKernelGGL(k_phase<PH>, dim3(grid), dim3(NTHREADS), 0, stream, p)
    LP_(0); LP_(1); LP_(2); LP_(3); LP_(4); LP_(5); LP_(6); LP_(7); LP_(8); LP_(9); LP_(10); LP_(12); LP_(11);
#undef LP_
#else
    (void)hipMemsetAsync(d_ws, 0, 16384, stream);
    void* args[] = {&p};
    hipError_t e = hipLaunchCooperativeKernel((void*)k_mega, dim3(grid), dim3(NTHREADS), args, 0, stream);
    if (e != hipSuccess) fprintf(stderr, "cooperative launch failed: %s (grid %d)\n", hipGetErrorString(e), grid);
#endif
}
```

```cpp
#include <hip/hip_runtime.h>
#include <hip/hip_cooperative_groups.h>
#include <cstdio>
#include <cstdint>
#include <type_traits>
namespace cg = cooperative_groups;

#ifndef MULTI_LAUNCH
#define MULTI_LAUNCH 0
#endif

typedef unsigned short bf16_t;
typedef short bf16x8 __attribute__((ext_vector_type(8)));
typedef float f32x4 __attribute__((ext_vector_type(4)));
typedef float f32x16 __attribute__((ext_vector_type(16)));
typedef unsigned u32x4 __attribute__((ext_vector_type(4)));
typedef unsigned u32x2 __attribute__((ext_vector_type(2)));
typedef __bf16 bf16x2_t __attribute__((ext_vector_type(2)));

constexpr int NB = 16, SEQ = 2048, DM = 1024, NTOK = NB * SEQ;
constexpr int CH = 64, NCH = SEQ / CH;
constexpr int AH = 8, AHD = 64;
constexpr int DH = 4, DHD = 128;
constexpr int IPW = 3592, NPAD = 3712;
constexpr int PBW = 2048;
constexpr int NEXP = 16384;
constexpr float EPS = 1e-6f;
constexpr int NTHREADS = 512;

constexpr size_t MiB = 1u << 20;
constexpr size_t WS_MOD = 1 * MiB;
constexpr size_t WS_SK = 2 * MiB;
constexpr size_t WS_WINT = 3 * MiB;
constexpr size_t WS_WOUTT = 11 * MiB;
constexpr size_t WS_WQT = 13 * MiB;
constexpr size_t WS_ED8 = 17 * MiB;
constexpr size_t WS_PART = 145 * MiB;
constexpr size_t WS_EU8 = 33 * MiB;
constexpr size_t WS_H8 = 49 * MiB;
constexpr size_t WS_SD = 2 * MiB + 128 * 1024;
constexpr size_t WS_SU = 2 * MiB + 192 * 1024;
constexpr size_t WS_HS = 2 * MiB + 256 * 1024;
constexpr size_t WS_H = 81 * MiB;
constexpr size_t WS_PB = 145 * MiB;
constexpr size_t WS_QA = 273 * MiB;
constexpr size_t WS_KA = 305 * MiB;
constexpr size_t WS_VT = 337 * MiB;
constexpr size_t WS_QP = 369 * MiB;
constexpr size_t WS_OL = 401 * MiB;
constexpr size_t WS_BETA = 433 * MiB;
constexpr size_t WS_G = 433 * MiB + 512 * 1024;
constexpr size_t WS_EGL = 434 * MiB;
constexpr size_t WS_NEGM = 435 * MiB;
constexpr size_t WS_END = 499 * MiB;
constexpr size_t WS_SNT = WS_QA;
constexpr size_t WS_WQ8 = WS_KA;
constexpr size_t WS_WSC = WS_KA + 4 * MiB;
constexpr size_t WS_IDS16 = WS_KA + 8 * MiB;
constexpr size_t WS_DLT = WS_QP;
constexpr size_t WS_GATES16 = WS_KA + 16 * MiB;

struct Params {
    const float *x, *c, *w_ada, *b_ada, *norm1_gain, *w_in, *q_gain, *k_gain, *rel_bias, *attn_out_gain, *conv_w, *a_log, *dt_bias,
        *dn_out_gain, *w_out, *norm2_gain, *w_query, *query_gain, *sk1, *sk2, *e_down, *e_up;
    float* out;
    unsigned char* ws;
};

typedef float f32x2h __attribute__((ext_vector_type(2)));
typedef __bf16 bf16x2h __attribute__((ext_vector_type(2)));
__device__ __forceinline__ unsigned f2bf(float f) { return (unsigned)__builtin_bit_cast(unsigned short, (__bf16)f); }
__device__ __forceinline__ unsigned pk2(float lo, float hi) { const f32x2h v = {lo, hi}; return __builtin_bit_cast(unsigned, __builtin_convertvector(v, bf16x2h)); }
__device__ __forceinline__ float bflo(unsigned u) { return __uint_as_float(u << 16); }
__device__ __forceinline__ float bfhi(unsigned u) { return __uint_as_float(u & 0xffff0000u); }
__device__ __forceinline__ float bf2f(bf16_t v) { return __uint_as_float(((unsigned)v) << 16); }
__device__ __forceinline__ float silu_f(float v) { return v * __builtin_amdgcn_rcpf(1.0f + __expf(-v)); }
__device__ __forceinline__ float dot2bf(unsigned a, unsigned b, float acc) {
    return __builtin_amdgcn_fdot2_f32_bf16(__builtin_bit_cast(bf16x2_t, a), __builtin_bit_cast(bf16x2_t, b), acc, false);
}
__device__ __forceinline__ f32x4 mfma16(bf16x8 a, bf16x8 b, f32x4 c) { return __builtin_amdgcn_mfma_f32_16x16x32_bf16(a, b, c, 0, 0, 0); }
__device__ __forceinline__ f32x16 mfma32(bf16x8 a, bf16x8 b, f32x16 c) { return __builtin_amdgcn_mfma_f32_32x32x16_bf16(a, b, c, 0, 0, 0); }
__device__ __forceinline__ bf16x8 pack8(float a0, float a1, float a2, float a3, float a4, float a5, float a6, float a7) {
    u32x4 u; u.x = pk2(a0, a1); u.y = pk2(a2, a3); u.z = pk2(a4, a5); u.w = pk2(a6, a7); return __builtin_bit_cast(bf16x8, u);
}
__device__ __forceinline__ int opaque_tid() { int t = threadIdx.x; asm volatile("" : "+v"(t)); return t; }
__device__ __forceinline__ int swap23(int v) { return (v & ~12) | ((v & 4) << 1) | ((v & 8) >> 1); }

constexpr int LDS_BYTES = 153600;

__device__ void phase0(const Params& P, unsigned char* lds, int bid, int nblk) {
    const int tid = opaque_tid();
    float* sc = (float*)lds;
    float* red = (float*)(lds + 65536);
    float* tile = (float*)(lds + 98304);
    float* mod = (float*)(P.ws + WS_MOD);
    if (bid < 384) {
        for (int e = tid; e < 16384; e += NTHREADS) { int b = e >> 10, k = e & 1023; float v = P.c[e]; sc[k * 16 + b] = silu_f(v); }
        __syncthreads();
        for (int it = bid; it < 384; it += nblk) {
            const int j0 = it * 16, cl = tid & 15, kg = tid >> 4;
            float acc[16];
#pragma unroll
            for (int b = 0; b < 16; ++b) acc[b] = 0.f;
            for (int i = 0; i < 32; ++i) {
                const int k = kg + 32 * i;
                const float w = P.w_ada[(size_t)k * 6144 + j0 + cl];
                const f32x4* sp = (const f32x4*)(sc + k * 16);
#pragma unroll
                for (int q = 0; q < 4; ++q) { f32x4 s4 = sp[q]; acc[4 * q] += s4[0] * w; acc[4 * q + 1] += s4[1] * w; acc[4 * q + 2] += s4[2] * w; acc[4 * q + 3] += s4[3] * w; }
            }
#pragma unroll
            for (int b = 0; b < 16; ++b) red[(kg * 16 + b) * 16 + cl] = acc[b];
            __syncthreads();
            if (tid < 256) {
                const int b = tid >> 4, c2 = tid & 15; float s = 0.f;
                for (int g = 0; g < 32; ++g) s += red[(g * 16 + b) * 16 + c2];
                mod[b * 6144 + j0 + c2] = s + P.b_ada[j0 + c2];
            }
            __syncthreads();
        }
    }
    for (int it = bid; it < 928 + 256 + 512; it += nblk) {
        const float* src; bf16_t* dst; int N, nt, kt;
        if (it < 928) { src = P.w_in; dst = (bf16_t*)(P.ws + WS_WINT); N = IPW; nt = it % 58; kt = it / 58; }
        else if (it < 928 + 256) { const int r = it - 928; src = P.w_out; dst = (bf16_t*)(P.ws + WS_WOUTT); N = 1024; nt = r % 16; kt = r / 16; }
        else { const int r = it - 1184; src = P.w_query; dst = (bf16_t*)(P.ws + WS_WQT); N = 2048; nt = r % 32; kt = r / 32; }
        const int n0 = nt * 64, k0 = kt * 64;
        {
            const int nl = tid & 63, kb = tid >> 6;
#pragma unroll
            for (int i = 0; i < 8; ++i) { const int kk = kb + 8 * i; const int n = n0 + nl; tile[kk * 65 + nl] = (n < N) ? src[(size_t)(k0 + kk) * N + n] : 0.f; }
        }
        __syncthreads();
        {
            const int kl = (tid & 7) * 8, nl = tid >> 3;
            u32x4 o;
            o.x = pk2(tile[(kl + 0) * 65 + nl], tile[(kl + 1) * 65 + nl]); o.y = pk2(tile[(kl + 2) * 65 + nl], tile[(kl + 3) * 65 + nl]);
            o.z = pk2(tile[(kl + 4) * 65 + nl], tile[(kl + 5) * 65 + nl]); o.w = pk2(tile[(kl + 6) * 65 + nl], tile[(kl + 7) * 65 + nl]);
            *(u32x4*)(dst + (size_t)(n0 + nl) * 1024 + k0 + kl) = o;
        }
        __syncthreads();
    }
    {
        const int gid = bid * NTHREADS + tid;
        if (gid < 32768) {
            const int p = gid >> 14, rem = gid & 16383, d = rem & 127;
            const float v = (p ? P.sk2 : P.sk1)[rem] * P.query_gain[128 * p + d];
            ((bf16_t*)(P.ws + WS_SK))[gid] = (bf16_t)f2bf(v);
        }
    }
}

template <int CTRL> __device__ __forceinline__ unsigned dpp_u32(unsigned v) { return (unsigned)__builtin_amdgcn_update_dpp(0, (int)v, CTRL, 0xf, 0xf, false); }
__device__ __forceinline__ void pair_store8(const u32x2 (&o)[4], unsigned char* rowbase  , int lane) {
    const bool odd = (lane & 1) != 0;
#pragma unroll
    for (int pr = 0; pr < 2; ++pr) {
        const u32x2 a = o[2 * pr], b = o[2 * pr + 1];
        const unsigned sx = odd ? a.x : b.x, sy = odd ? a.y : b.y;
        const unsigned rx = dpp_u32<0xB1>(sx), ry = dpp_u32<0xB1>(sy);
        u32x4 w;
        w.x = odd ? rx : a.x; w.y = odd ? ry : a.y; w.z = odd ? b.x : rx; w.w = odd ? b.y : ry;
        const int col = odd ? 256 * (2 * pr + 1) + 4 * (lane - 1) : 256 * (2 * pr) + 4 * lane;
        *(u32x4*)(rowbase + col * 2) = w;
    }
}
__device__ __forceinline__ void pair_store4(const unsigned (&q)[4], unsigned char* rowbase, int lane) {
    const bool b0 = (lane & 1) != 0, b1 = (lane & 2) != 0;
    u32x2 pc[2];
#pragma unroll
    for (int pr = 0; pr < 2; ++pr) {
        const unsigned a = q[2 * pr], b = q[2 * pr + 1];
        const unsigned rc = dpp_u32<0xB1>(b0 ? a : b);
        pc[pr].x = b0 ? rc : a; pc[pr].y = b0 ? b : rc;
    }
    const unsigned sx = b1 ? pc[0].x : pc[1].x, sy = b1 ? pc[0].y : pc[1].y;
    const unsigned rx = dpp_u32<0x4E>(sx), ry = dpp_u32<0x4E>(sy);
    u32x4 w;
    w.x = b1 ? rx : pc[0].x; w.y = b1 ? ry : pc[0].y; w.z = b1 ? pc[1].x : rx; w.w = b1 ? pc[1].y : ry;
    *(u32x4*)(rowbase + 256 * (lane & 3) + 4 * (lane & ~3)) = w;
}
template <bool WITH_BG, bool WITH_Q8>
__device__ void norm_mod_phase(const Params& P, const float* __restrict__ src, const bf16_t* dlt, float* __restrict__ x1out, const float* __restrict__ gain, const float* __restrict__ mod, int shift_off, int scale_off,
                               bf16_t* __restrict__ dst, int bid, int nblk) {
    const int tid_ = opaque_tid(); const int lane = tid_ & 63, wid = tid_ >> 6;
    float wreg[WITH_BG ? 16 : 1][8];
    if (WITH_BG) {
#pragma unroll
        for (int i = 0; i < 4; ++i)
#pragma unroll
            for (int jj = 0; jj < 4; ++jj) {
                const float* wp = P.w_in + (size_t)(256 * i + 4 * lane + jj) * IPW + 3584;
                const f32x4 w0 = *(const f32x4*)wp, w1 = *(const f32x4*)(wp + 4);
                wreg[4 * i + jj][0] = w0[0]; wreg[4 * i + jj][1] = w0[1]; wreg[4 * i + jj][2] = w0[2]; wreg[4 * i + jj][3] = w0[3];
                wreg[4 * i + jj][4] = w1[0]; wreg[4 * i + jj][5] = w1[1]; wreg[4 * i + jj][6] = w1[2]; wreg[4 * i + jj][7] = w1[3];
            }
    }
    for (int row = bid * 8 + wid; row < NTOK; row += nblk * 8) {
        const int b = row >> 11;
        f32x4 v[4]; float ss = 0.f;
        u32x2 xb[WITH_Q8 ? 4 : 1];
#pragma unroll
        for (int i = 0; i < 4; ++i) {
            v[i] = *(const f32x4*)(src + (size_t)row * DM + 256 * i + 4 * lane);
            if (WITH_Q8) {
                const u32x2 d2 = *(const u32x2*)(dlt + (size_t)row * DM + 256 * i + 4 * lane);
                v[i][0] += bflo(d2.x); v[i][1] += bfhi(d2.x); v[i][2] += bflo(d2.y); v[i][3] += bfhi(d2.y);
                xb[i].x = pk2(v[i][0], v[i][1]); xb[i].y = pk2(v[i][2], v[i][3]);
            }
            ss += v[i][0] * v[i][0] + v[i][1] * v[i][1] + v[i][2] * v[i][2] + v[i][3] * v[i][3];
        }
        if constexpr (WITH_Q8) pair_store8(xb, (unsigned char*)((bf16_t*)dlt + (size_t)row * DM), lane);
#pragma unroll
        for (int o = 32; o > 0; o >>= 1) ss += __shfl_xor(ss, o);
        const float rstd = rsqrtf(ss * (1.0f / DM) + EPS);
        float a8[8];
        u32x2 ob[4];
        float yq[WITH_Q8 ? 4 : 1][4];
#pragma unroll
        for (int q = 0; q < 8; ++q) a8[q] = 0.f;
#pragma unroll
        for (int i = 0; i < 4; ++i) {
            const int c = 256 * i + 4 * lane;
            const f32x4 g = *(const f32x4*)(gain + c), sh = *(const f32x4*)(mod + b * 6144 + shift_off + c), sc = *(const f32x4*)(mod + b * 6144 + scale_off + c);
            float y[4];
#pragma unroll
            for (int jj = 0; jj < 4; ++jj) {
                y[jj] = v[i][jj] * rstd * g[jj] * (1.0f + sc[jj]) + sh[jj];
                if (WITH_BG) {
#pragma unroll
                    for (int q = 0; q < 8; ++q) a8[q] += y[jj] * wreg[4 * i + jj][q];
                }
            }
            ob[i].x = pk2(y[0], y[1]); ob[i].y = pk2(y[2], y[3]);
            if (WITH_Q8) { yq[i][0] = y[0]; yq[i][1] = y[1]; yq[i][2] = y[2]; yq[i][3] = y[3]; }
        }
        pair_store8(ob, (unsigned char*)(dst + (size_t)row * DM), lane);
        if (WITH_Q8) {
            float am = 0.f;
#pragma unroll
            for (int i = 0; i < 4; ++i) am = fmaxf(am, fmaxf(fmaxf(fabsf(yq[i][0]), fabsf(yq[i][1])), fmaxf(fabsf(yq[i][2]), fabsf(yq[i][3]))));
#pragma unroll
            for (int o = 32; o > 0; o >>= 1) am = fmaxf(am, __shfl_xor(am, o));
            am = am > 0.f ? am : 1.0f;
            const float inv = 127.0f / am;
            unsigned q8[4];
#pragma unroll
            for (int i = 0; i < 4; ++i) {
                const int b0 = (int)rintf(yq[i][0] * inv), b1 = (int)rintf(yq[i][1] * inv), b2 = (int)rintf(yq[i][2] * inv), b3 = (int)rintf(yq[i][3] * inv);
                q8[i] = (unsigned)(b0 & 255) | ((unsigned)(b1 & 255) << 8) | ((unsigned)(b2 & 255) << 16) | ((unsigned)(b3 & 255) << 24);
            }
            pair_store4(q8, (unsigned char*)(P.ws + WS_H8) + (size_t)row * DM, lane);
            if (lane == 0) ((float*)(P.ws + WS_HS))[row] = am * (1.0f / 127.0f);
        }
        if (WITH_BG) {
            const bool u1 = (lane & 1) != 0, u2 = (lane & 2) != 0, u4 = (lane & 4) != 0;
            float z4[4];
#pragma unroll
            for (int q = 0; q < 4; ++q) { const float keep = u1 ? a8[2 * q + 1] : a8[2 * q], send = u1 ? a8[2 * q] : a8[2 * q + 1]; z4[q] = keep + __shfl_xor(send, 1); }
            float z2[2];
#pragma unroll
            for (int q = 0; q < 2; ++q) { const float keep = u2 ? z4[2 * q + 1] : z4[2 * q], send = u2 ? z4[2 * q] : z4[2 * q + 1]; z2[q] = keep + __shfl_xor(send, 2); }
            const float keep = u4 ? z2[1] : z2[0], send = u4 ? z2[0] : z2[1];
            float t = keep + __shfl_xor(send, 4);
            t += __shfl_xor(t, 8); t += __shfl_xor(t, 16); t += __shfl_xor(t, 32);
            if (lane < 4) ((float*)(P.ws + WS_BETA))[(size_t)row * 4 + lane] = 1.0f / (1.0f + __expf(-t));
            else if (lane < 8) {
                const int hq = lane - 4; const float xx = t + P.dt_bias[hq];
                const float sp = xx > 20.f ? xx : log1pf(__expf(xx));
                ((float*)(P.ws + WS_G))[(size_t)row * 4 + hq] = -__expf(P.a_log[hq]) * sp;
            }
        }
    }
}

namespace pg8 {
#define PG8_LAS __attribute__((address_space(3)))
constexpr int BM = 256, BK = 64, HALF = 128, HTB = HALF * BK * 2, NXCD = 8, WGM = 8;
__host__ __device__ __forceinline__ int lds_byte(int r, int c) { const int st = (r >> 4) * 2 + (c >> 5), rr = r & 15, cc = c & 31, ob = rr * 64 + cc * 2; return st * 1024 + (ob ^ (((ob >> 9) & 1) << 5)); }
__host__ __device__ __forceinline__ void stage_rc(int b, int& R, int& C) { const int st = b / 1024, sb = b % 1024, swz = sb ^ (((sb >> 9) & 1) << 5); R = (st >> 1) * 16 + swz / 64; C = (st & 1) * 32 + (swz % 64) / 2; }
__host__ __device__ __forceinline__ int perm32(int rho) { const int n = rho >> 4, i = rho & 15; return 8 * (i >> 2) + 4 * n + (i & 3); }
struct Unit { int pm, pn; };
struct Gemm { const bf16_t* A; const bf16_t* Bt; int M, N, K; };
struct StaticOrder {
    int nM, nN, nwg, G, c;
    __host__ __device__ void init(int M, int N, int G_, int c_) { nM = M / BM; nN = N / BM; nwg = nM * nN; G = G_; c = c_; }
    __host__ __device__ bool next(int i, Unit& u) const {
        const long L = (long)i * G + c; if (L >= nwg) return false;
        int wgid = (int)L; { const int q = nwg / NXCD, r = nwg % NXCD, xcd = wgid % NXCD, off = wgid / NXCD; wgid = (xcd < r ? xcd * (q + 1) : r * (q + 1) + (xcd - r) * q) + off; }
        const int nig = WGM * nN, gid = wgid / nig, fm = gid * WGM, gsz = (nM - fm) < WGM ? (nM - fm) : WGM;
        u.pm = fm + ((wgid % nig) % gsz); u.pn = (wgid % nig) / gsz; return true;
    }
};

template <class Epi>
__device__ __forceinline__ void gemm_phase(PG8_LAS unsigned char* lds, const Gemm g, const StaticOrder& S, const Epi& E) {
    const int tid = opaque_tid(), wid = __builtin_amdgcn_readfirstlane(tid >> 6), lane = tid & 63, wr = wid >> 2, wc = wid & 3, fr = lane & 15, fq = lane >> 4;
    const int K = g.K, nt = K / BK;
    unsigned voffA[2], voffB[2];
#pragma unroll
    for (int i = 0; i < 2; ++i) { int R, C; stage_rc(tid * 16 + i * 8192, R, C); const int Rb = 64 * (R >> 5) + perm32(R & 31);
        voffA[i] = (unsigned)(R * K + C) * 2u; voffB[i] = (unsigned)(Rb * K + C) * 2u; }
    const size_t kstep = (size_t)(BK * 2);
    const size_t hstep = (size_t)HALF * K * 2;
    const size_t hstepB = (size_t)32 * K * 2;
    const size_t tstep = 2 * hstep;
    const unsigned ldsw = (unsigned)wid * 1024u;
    const int aoff = lds_byte(wr * 64 + fr, fq * 8), boff = lds_byte(wc * 32 + fr, fq * 8);
#define PG8_SA(b, h) (((b) * 2 + (h)) * HTB)
#define PG8_SB(b, h) ((4 + (b) * 2 + (h)) * HTB)
#define PG8_STAGE(bufoff, gbase, voff) do { _Pragma("unroll") for (int _i = 0; _i < 2; ++_i) \
        __builtin_amdgcn_global_load_lds((const unsigned*)((const char*)(gbase) + (voff)[_i]), (PG8_LAS unsigned*)(lds + (bufoff) + ldsw + _i * 8192), 16, 0, 0); } while (0)
#define PG8_LDA(dst, b, h) do { _Pragma("unroll") for (int m = 0; m < 4; ++m) _Pragma("unroll") for (int k = 0; k < 2; ++k) dst[m][k] = *(const PG8_LAS bf16x8*)(lds + PG8_SA(b, h) + aoff + m * 2048 + k * 1024); } while (0)
#define PG8_LDB(dst, b, h) do { _Pragma("unroll") for (int n = 0; n < 2; ++n) _Pragma("unroll") for (int k = 0; k < 2; ++k) dst[n][k] = *(const PG8_LAS bf16x8*)(lds + PG8_SB(b, h) + boff + n * 2048 + k * 1024); } while (0)
#define PG8_MMA(ai, bj, At, Bt) do { __builtin_amdgcn_s_setprio(1); _Pragma("unroll") for (int m = 0; m < 4; ++m) _Pragma("unroll") for (int n = 0; n < 2; ++n) _Pragma("unroll") for (int k = 0; k < 2; ++k) \
        acc[ai][bj][m][n] = __builtin_amdgcn_mfma_f32_16x16x32_bf16(Bt[n][k], At[m][k], acc[ai][bj][m][n], 0, 0, 0); __builtin_amdgcn_s_setprio(0); } while (0)
#define PG8_WAIT_V(n) asm volatile("s_waitcnt vmcnt(" #n ")" ::: "memory")
#define PG8_WAIT_L(n) asm volatile("s_waitcnt lgkmcnt(" #n ")" ::: "memory")
#define PG8_BAR __builtin_amdgcn_s_barrier()
#define PG8_SCHED __builtin_amdgcn_sched_barrier(0)
    Unit cur, nxt; int ui = 0;
    if (!S.next(0, cur)) return;
    f32x4 acc[2][2][4][2];
#pragma unroll
    for (int a = 0; a < 2; ++a)
#pragma unroll
        for (int b = 0; b < 2; ++b)
#pragma unroll
            for (int m = 0; m < 4; ++m)
#pragma unroll
                for (int n = 0; n < 2; ++n) acc[a][b][m][n] = (f32x4){0.f, 0.f, 0.f, 0.f};
    bf16x8 At[4][2], B0[2][2], B1[2][2];
    const char* cA = (const char*)g.A + (size_t)cur.pm * tstep; const char* cB = (const char*)g.Bt + (size_t)cur.pn * tstep;
    PG8_STAGE(PG8_SB(0, 0), cB, voffB); PG8_STAGE(PG8_SB(0, 1), cB + hstepB, voffB); PG8_STAGE(PG8_SA(0, 0), cA, voffA); PG8_STAGE(PG8_SA(0, 1), cA + hstep, voffA);
    if (wr == 1) PG8_BAR;
    PG8_WAIT_V(2); PG8_BAR;
    PG8_STAGE(PG8_SB(1, 0), cB + kstep, voffB); PG8_STAGE(PG8_SA(1, 0), cA + kstep, voffA); PG8_STAGE(PG8_SB(1, 1), cB + hstepB + kstep, voffB);
    PG8_WAIT_V(6); PG8_BAR;
    for (;;) {
        const bool has_next = S.next(ui + 1, nxt);
        const char* nA = has_next ? (const char*)g.A + (size_t)nxt.pm * tstep : cA; const char* nB = has_next ? (const char*)g.Bt + (size_t)nxt.pn * tstep : cB;
        for (int t = 0; t < nt; t += 2) {
            const bool last = (t == nt - 2);
            const char* a1 = cA + (size_t)(t + 1) * kstep;
            const char* a2 = last ? nA : cA + (size_t)(t + 2) * kstep; const char* b2 = last ? nB : cB + (size_t)(t + 2) * kstep;
            const char* a3 = a2 + kstep; const char* b3 = b2 + kstep;
            PG8_LDB(B0, 0, 0); PG8_LDB(B1, 0, 1); PG8_SCHED; PG8_LDA(At, 0, 0); PG8_STAGE(PG8_SA(1, 1), a1 + hstep, voffA);
            PG8_WAIT_V(8); PG8_WAIT_L(0); PG8_BAR; PG8_MMA(0, 0, At, B0); PG8_MMA(0, 1, At, B1); PG8_BAR; PG8_SCHED;
            PG8_LDA(At, 0, 1); PG8_STAGE(PG8_SB(0, 0), b2, voffB); PG8_STAGE(PG8_SB(0, 1), b2 + hstepB, voffB); PG8_STAGE(PG8_SA(0, 0), a2, voffA);
            PG8_WAIT_V(8); PG8_WAIT_L(0); PG8_BAR; PG8_MMA(1, 0, At, B0); PG8_MMA(1, 1, At, B1); PG8_BAR; PG8_SCHED;
            PG8_LDB(B0, 1, 0); PG8_LDB(B1, 1, 1); PG8_SCHED; PG8_LDA(At, 1, 0); PG8_STAGE(PG8_SA(0, 1), a2 + hstep, voffA);
            PG8_WAIT_V(8); PG8_WAIT_L(0); PG8_BAR; PG8_MMA(0, 0, At, B0); PG8_MMA(0, 1, At, B1); PG8_BAR; PG8_SCHED;
            PG8_LDA(At, 1, 1); PG8_STAGE(PG8_SB(1, 0), b3, voffB); PG8_STAGE(PG8_SB(1, 1), b3 + hstepB, voffB); PG8_STAGE(PG8_SA(1, 0), a3, voffA);
            PG8_WAIT_V(8); PG8_WAIT_L(0); PG8_BAR; PG8_MMA(1, 0, At, B0); PG8_MMA(1, 1, At, B1); PG8_BAR; PG8_SCHED;
        }
        if (wr == 0) PG8_BAR;
        E(acc, cur, wr, wc, fr, fq);
        if (!has_next) break;
#pragma unroll
        for (int a = 0; a < 2; ++a)
#pragma unroll
            for (int b = 0; b < 2; ++b)
#pragma unroll
                for (int m = 0; m < 4; ++m)
#pragma unroll
                    for (int n = 0; n < 2; ++n) acc[a][b][m][n] = (f32x4){0.f, 0.f, 0.f, 0.f};
        cur = nxt; cA = nA; cB = nB; ++ui;
        if (wr == 1) PG8_BAR;
    }
    PG8_WAIT_V(0);
    PG8_BAR;
#undef PG8_SA
#undef PG8_SB
#undef PG8_STAGE
#undef PG8_LDA
#undef PG8_LDB
#undef PG8_MMA
#undef PG8_WAIT_V
#undef PG8_WAIT_L
#undef PG8_BAR
#undef PG8_SCHED
}
}

#define ACC_T const f32x4 (&acc)[2][2][4][2]
__device__ __forceinline__ u32x4 pack_acc8(const f32x4& a, const f32x4& b, float s) {
    u32x4 o; o.x = pk2(a[0] * s, a[1] * s); o.y = pk2(a[2] * s, a[3] * s); o.z = pk2(b[0] * s, b[1] * s); o.w = pk2(b[2] * s, b[3] * s); return o;
}
struct EpiQK {
    const float *q_gain, *k_gain;
    bf16_t *qa, *ka;
    __device__ __forceinline__ void operator()(ACC_T, const pg8::Unit& u, int wr, int wc, int fr, int fq) const {
        const int pn = u.pn, bb = u.pm >> 3, s0 = (u.pm & 7) * 256 + wr * 64;
        {
            const bool isq = pn < 2; const int head = (pn & 1) * 4 + wc;
            const float* gn = isq ? q_gain : k_gain; const float sc = isq ? 0.125f * 1.4426950408889634f : 1.0f;
            bf16_t* ub = (isq ? qa : ka) + ((size_t)(bb * AH + head) * SEQ + s0) * 64;
            const unsigned lo = isq ? (unsigned)(fr * 64 + 8 * fq) : (unsigned)(fq * 256 + fr * 8);
            const float* gl = gn + 8 * fq;
#pragma unroll
            for (int ai = 0; ai < 2; ++ai)
#pragma unroll
                for (int m = 0; m < 4; ++m) {
                    float ss = 0.f;
#pragma unroll
                    for (int bj = 0; bj < 2; ++bj)
#pragma unroll
                        for (int n = 0; n < 2; ++n)
#pragma unroll
                            for (int r = 0; r < 4; ++r) ss += acc[ai][bj][m][n][r] * acc[ai][bj][m][n][r];
                    ss += __shfl_xor(ss, 16); ss += __shfl_xor(ss, 32);
                    const float rstd = rsqrtf(ss * (1.0f / 64.0f) + EPS) * sc;
                    bf16_t* p = isq ? (ub + (ai * 128 + m * 16) * 64) : (ub + (ai * 4 + (m >> 1)) * 2048 + (m & 1) * 128);
#pragma unroll
                    for (int bj = 0; bj < 2; ++bj) {
                        const f32x4 g0 = *(const f32x4*)(gl + 32 * bj), g1 = *(const f32x4*)(gl + 32 * bj + 4);
                        u32x4 o;
                        o.x = pk2(acc[ai][bj][m][0][0] * rstd * g0[0], acc[ai][bj][m][0][1] * rstd * g0[1]); o.y = pk2(acc[ai][bj][m][0][2] * rstd * g0[2], acc[ai][bj][m][0][3] * rstd * g0[3]);
                        o.z = pk2(acc[ai][bj][m][1][0] * rstd * g1[0], acc[ai][bj][m][1][1] * rstd * g1[1]); o.w = pk2(acc[ai][bj][m][1][2] * rstd * g1[2], acc[ai][bj][m][1][3] * rstd * g1[3]);
                        *(u32x4*)(p + (isq ? 32 * bj : 1024 * bj) + lo) = o;
                    }
                }
        }
    }
};
struct EpiV {
    bf16_t* vt;
    __device__ __forceinline__ void operator()(ACC_T, const pg8::Unit& u, int wr, int wc, int fr, int fq) const {
        const int pn = u.pn, bb = u.pm >> 3, s0 = (u.pm & 7) * 256 + wr * 64;
        {
            const int head = (pn & 1) * 4 + wc;
            bf16_t* ub = vt + ((size_t)(bb * AH + head) * SEQ + s0) * 64;
            const int pp = swap23(fr);
            const bool u2 = (fr & 8) != 0, u1 = (fr & 2) != 0, u0 = (fr & 1) != 0;
            const unsigned selv = u0 ? 0x03020706u : 0x05040100u;
            const unsigned lo = (unsigned)((pp >> 3) * 256 + (8 * fq + (pp & 7)) * 8);
#pragma unroll
            for (int ai = 0; ai < 2; ++ai)
#pragma unroll
                for (int m = 0; m < 4; ++m)
#pragma unroll
                    for (int bj = 0; bj < 2; ++bj) {
                        unsigned D0 = pk2(acc[ai][bj][m][0][0], acc[ai][bj][m][0][1]), D1 = pk2(acc[ai][bj][m][0][2], acc[ai][bj][m][0][3]);
                        unsigned D2 = pk2(acc[ai][bj][m][1][0], acc[ai][bj][m][1][1]), D3 = pk2(acc[ai][bj][m][1][2], acc[ai][bj][m][1][3]);
                        {
                            const unsigned r0 = dpp_u32<0x128>(u2 ? D0 : D2), r1 = dpp_u32<0x128>(u2 ? D1 : D3);
                            D0 = u2 ? r0 : D0; D1 = u2 ? r1 : D1; D2 = u2 ? D2 : r0; D3 = u2 ? D3 : r1;
                        }
                        {
                            const unsigned r0 = dpp_u32<0x4E>(u1 ? D0 : D1), r1 = dpp_u32<0x4E>(u1 ? D2 : D3);
                            D0 = u1 ? r0 : D0; D2 = u1 ? r1 : D2; D1 = u1 ? D1 : r0; D3 = u1 ? D3 : r1;
                        }
                        {
                            D0 = __builtin_amdgcn_perm(dpp_u32<0xB1>(D0), D0, selv); D1 = __builtin_amdgcn_perm(dpp_u32<0xB1>(D1), D1, selv);
                            D2 = __builtin_amdgcn_perm(dpp_u32<0xB1>(D2), D2, selv); D3 = __builtin_amdgcn_perm(dpp_u32<0xB1>(D3), D3, selv);
                        }
                        *(u32x4*)(ub + (ai * 2 + (m >> 2)) * 4096 + ((bj * 2 + ((m >> 1) & 1)) * 2 + (m & 1)) * 512 + lo) = (u32x4){D0, D1, D2, D3};
                    }
        }
    }
};
struct EpiOut {
    const float* mod; bf16_t* dlt;
    __device__ __forceinline__ void operator()(ACC_T, const pg8::Unit& u, int wr, int wc, int fr, int fq) const {
        bf16_t* ub = dlt + (size_t)(u.pm * 256 + wr * 64) * DM + u.pn * 256 + wc * 64;
        const float* ug = mod + (u.pm >> 3) * 6144 + 2048 + u.pn * 256 + wc * 64;
        const bool hi8 = (fr & 8) != 0;
        const unsigned lo = (unsigned)((fr & 7) * DM + (hi8 ? 32 : 0) + 8 * fq), lg = (unsigned)(8 * fq);
        const f32x4 g00 = *(const f32x4*)(ug + lg), g01 = *(const f32x4*)(ug + 4 + lg), g10 = *(const f32x4*)(ug + 32 + lg), g11 = *(const f32x4*)(ug + 36 + lg);
#pragma unroll
        for (int ai = 0; ai < 2; ++ai)
#pragma unroll
            for (int m = 0; m < 4; ++m) {
                u32x4 V0, V1;
                {
                    const f32x4& a0 = acc[ai][0][m][0]; const f32x4& a1 = acc[ai][0][m][1];
                    V0.x = pk2(a0[0] * g00[0], a0[1] * g00[1]); V0.y = pk2(a0[2] * g00[2], a0[3] * g00[3]); V0.z = pk2(a1[0] * g01[0], a1[1] * g01[1]); V0.w = pk2(a1[2] * g01[2], a1[3] * g01[3]);
                }
                {
                    const f32x4& a0 = acc[ai][1][m][0]; const f32x4& a1 = acc[ai][1][m][1];
                    V1.x = pk2(a0[0] * g10[0], a0[1] * g10[1]); V1.y = pk2(a0[2] * g10[2], a0[3] * g10[3]); V1.z = pk2(a1[0] * g11[0], a1[1] * g11[1]); V1.w = pk2(a1[2] * g11[2], a1[3] * g11[3]);
                }
                u32x4 rc, A, B;
#pragma unroll
                for (int q = 0; q < 4; ++q) rc[q] = dpp_u32<0x128>(hi8 ? V0[q] : V1[q]);
#pragma unroll
                for (int q = 0; q < 4; ++q) { A[q] = hi8 ? rc[q] : V0[q]; B[q] = hi8 ? V1[q] : rc[q]; }
                *(u32x4*)(ub + (ai * 128 + m * 16) * DM + lo) = A;
                *(u32x4*)(ub + (ai * 128 + m * 16 + 8) * DM + lo) = B;
            }
    }
};
struct EpiBf {
    bf16_t* dst; int ld;
    __device__ __forceinline__ void operator()(ACC_T, const pg8::Unit& u, int wr, int wc, int fr, int fq) const {
        bf16_t* ub = dst + (size_t)(u.pm * 256 + wr * 64) * ld + u.pn * 256 + wc * 64;
        const bool hi8 = (fr & 8) != 0;
        const unsigned lo = (unsigned)((fr & 7) * ld + (hi8 ? 32 : 0) + 8 * fq);
#pragma unroll
        for (int ai = 0; ai < 2; ++ai)
#pragma unroll
            for (int m = 0; m < 4; ++m) {
                const u32x4 V0 = pack_acc8(acc[ai][0][m][0], acc[ai][0][m][1], 1.0f), V1 = pack_acc8(acc[ai][1][m][0], acc[ai][1][m][1], 1.0f);
                u32x4 rc;
#pragma unroll
                for (int q = 0; q < 4; ++q) rc[q] = dpp_u32<0x128>(hi8 ? V0[q] : V1[q]);
                u32x4 A, B;
#pragma unroll
                for (int q = 0; q < 4; ++q) { A[q] = hi8 ? rc[q] : V0[q]; B[q] = hi8 ? V1[q] : rc[q]; }
                *(u32x4*)(ub + (ai * 128 + m * 16) * ld + lo) = A;
                *(u32x4*)(ub + (ai * 128 + m * 16 + 8) * ld + lo) = B;
            }
    }
};
struct EpiInAll {
    EpiQK qk; EpiV v; EpiBf pbf;
    __device__ __forceinline__ void operator()(ACC_T, const pg8::Unit& u, int wr, int wc, int fr, int fq) const {
        if (u.pn < 4) qk(acc, u, wr, wc, fr, fq);
        else if (u.pn < 6) { pg8::Unit u2 = u; u2.pn = u.pn - 4; v(acc, u2, wr, wc, fr, fq); }
        else { pg8::Unit u2 = u; u2.pn = u.pn - 6; pbf(acc, u2, wr, wc, fr, fq); }
    }
};
#undef ACC_T
template <class Epi>
__device__ __forceinline__ void gemm_run(const bf16_t* A, const bf16_t* Bt, int M, int N, int K, const Epi& e, unsigned char* lds, int bid, int nblk) {
    pg8::Gemm g{A, Bt, M, N, K}; pg8::StaticOrder S; S.init(M, N, nblk, bid);
    pg8::gemm_phase<Epi>((PG8_LAS unsigned char*)lds, g, S, e);
}

typedef float f32x2a __attribute__((ext_vector_type(2)));
__device__ void attn_phase(const Params& P, unsigned char* lds, int bid, int nblk) {
    const int tid0 = opaque_tid();
    {
        const int head = tid0 >> 6, lane = tid0 & 63;
        float* biasL = (float*)lds + head * 260;
        for (int i = lane; i < 256; i += 64) { const int ri = (320 - i) < 256 ? (320 - i) : 256; biasL[i] = (P.rel_bias[head * 257 + ri] - P.rel_bias[head * 257 + 256]) * 1.4426950408889634f; }
    }
    const bf16_t* qa = (const bf16_t*)(P.ws + WS_QA); const bf16_t* ka = (const bf16_t*)(P.ws + WS_KA); const bf16_t* vt = (const bf16_t*)(P.ws + WS_VT);
    bf16_t* mix = (bf16_t*)(P.ws + WS_H);
    for (int it = bid; it < 512; it += nblk) {
        int tid = tid0; asm volatile("" : "+v"(tid));
        const int head = tid >> 6, lane = tid & 63, l31 = lane & 31, hh = lane >> 5;
        const float* biasL = (const float*)lds + head * 260;
        float* ssq = (float*)(lds + 8 * 260 * 4);
        float* park = (float*)(lds + 16384) + head * 4096;
        const int it2 = it & 255, b = it2 & 15, pp = it2 >> 4, n = (it < 256) ? pp : 31 - pp;
        const size_t hb = (size_t)(b * AH + head);
        const bf16_t* qbase = qa + (hb * SEQ + (size_t)n * 64) * 64;
        const int cstart = (n >= 8) ? 0 : 8 - n;
        float ssv[2];
        f32x16 oA0, oA1, oB0, oB1;
        {
            unsigned char* qL = (unsigned char*)park;
#pragma unroll
            for (int ks = 0; ks < 4; ++ks) {
                *(bf16x8*)(qL + l31 * 144 + (16 * ks + 8 * hh) * 2) = *(const bf16x8*)(qbase + l31 * 64 + 16 * ks + 8 * hh);
                *(bf16x8*)(qL + (32 + l31) * 144 + (16 * ks + 8 * hh) * 2) = *(const bf16x8*)(qbase + (32 + l31) * 64 + 16 * ks + 8 * hh);
            }
#pragma unroll
            for (int r = 0; r < 16; ++r) { oA0[r] = 0.f; oA1[r] = 0.f; oB0[r] = 0.f; oB1[r] = 0.f; }
            float mA = -1e30f, lA = 0.f, mB = -1e30f, lB = 0.f;
            bf16x8 kc0[4], kc1[4];
            {
                const bf16_t* kb = ka + (hb * SEQ + (size_t)(n + cstart - 8) * 64) * 64;
#pragma unroll
                for (int ks = 0; ks < 4; ++ks) { kc0[ks] = *(const bf16x8*)(kb + (2 * ks + hh) * 256 + l31 * 8); kc1[ks] = *(const bf16x8*)(kb + 2048 + (2 * ks + hh) * 256 + l31 * 8); }
            }
            for (int c = cstart; c <= 8; ++c) {
                const int kc = n + c - 8;
                int lv = lane; asm volatile("" : "+v"(lv));
                const int foff = (lv >> 5) * 256 + (lv & 31) * 8;
                const bf16_t* vb = vt + (size_t)__builtin_amdgcn_readfirstlane((int)((hb * SEQ + (size_t)kc * 64) * 64 >> 4)) * 16;
                bf16x8 v0[4], v1[4];
#pragma unroll
                for (int kt = 0; kt < 2; ++kt)
#pragma unroll
                    for (int sp = 0; sp < 2; ++sp) {
                        v0[2 * kt + sp] = *(const bf16x8*)(vb + ((kt * 2 + sp) * 2) * 256 + foff);
                        v1[2 * kt + sp] = *(const bf16x8*)(vb + 2048 + ((kt * 2 + sp) * 2) * 256 + foff);
                    }
                auto scores = [&](const int qrow, f32x16& s0, f32x16& s1) {
#pragma unroll
                    for (int r = 0; r < 16; ++r) { s0[r] = 0.f; s1[r] = 0.f; }
#pragma unroll
                    for (int ks = 0; ks < 4; ++ks) { const bf16x8 bq = *(const bf16x8*)(qL + qrow * 144 + (16 * ks + 8 * hh) * 2); s0 = mfma32(kc0[ks], bq, s0); s1 = mfma32(kc1[ks], bq, s1); }
                };
                auto smpv = [&](f32x16& s0, f32x16& s1, const int qi, float& mrun, float& lrun, f32x16& o0, f32x16& o1) {
                    if (c > 5) {
                        const float* bp = biasL + (320 - (qi + 64 * (8 - c) + 128 - 4 * hh));
#pragma unroll
                        for (int r = 0; r < 16; r += 2) {
                            const int j0 = (r & 3) + 8 * (r >> 2);
                            const f32x2a b0 = {bp[j0], bp[j0 + 1]}, b1 = {bp[32 + j0], bp[33 + j0]};
                            const f32x2a a0 = (f32x2a){s0[r], s0[r + 1]} + b0, a1 = (f32x2a){s1[r], s1[r + 1]} + b1;
                            s0[r] = a0[0]; s0[r + 1] = a0[1]; s1[r] = a1[0]; s1[r + 1] = a1[1];
                        }
                    }
                    float mx = s0[0];
#pragma unroll
                    for (int r = 1; r < 16; ++r) mx = fmaxf(mx, s0[r]);
#pragma unroll
                    for (int r = 0; r < 16; ++r) mx = fmaxf(mx, s1[r]);
                    mx = fmaxf(mx, __shfl_xor(mx, 32));
                    const float mnew = fmaxf(mrun, mx);
                    const bool grew = mnew > mrun;
                    const float alpha = __builtin_amdgcn_exp2f(mrun - mnew);
                    mrun = mnew;
                    const f32x2a mm = {mnew, mnew};
                    f32x2a ps2 = {0.f, 0.f};
#pragma unroll
                    for (int r = 0; r < 16; r += 2) {
                        f32x2a a0 = (f32x2a){s0[r], s0[r + 1]} - mm, a1 = (f32x2a){s1[r], s1[r + 1]} - mm;
                        a0[0] = __builtin_amdgcn_exp2f(a0[0]); a0[1] = __builtin_amdgcn_exp2f(a0[1]); a1[0] = __builtin_amdgcn_exp2f(a1[0]); a1[1] = __builtin_amdgcn_exp2f(a1[1]);
                        s0[r] = a0[0]; s0[r + 1] = a0[1]; s1[r] = a1[0]; s1[r + 1] = a1[1];
                        ps2 += a0 + a1;
                    }
                    const float psum = ps2[0] + ps2[1];
                    lrun = lrun * alpha + psum;
                    if (__any(grew)) {
#pragma unroll
                        for (int r = 0; r < 16; ++r) { o0[r] *= alpha; o1[r] *= alpha; }
                    }
                    bf16x8 pf[4];
                    pf[0] = pack8(s0[0], s0[1], s0[2], s0[3], s0[4], s0[5], s0[6], s0[7]);
                    pf[1] = pack8(s0[8], s0[9], s0[10], s0[11], s0[12], s0[13], s0[14], s0[15]);
                    pf[2] = pack8(s1[0], s1[1], s1[2], s1[3], s1[4], s1[5], s1[6], s1[7]);
                    pf[3] = pack8(s1[8], s1[9], s1[10], s1[11], s1[12], s1[13], s1[14], s1[15]);
#pragma unroll
                    for (int q4 = 0; q4 < 4; ++q4) { o0 = mfma32(v0[q4], pf[q4], o0); o1 = mfma32(v1[q4], pf[q4], o1); }
                };
                f32x16 s0, s1;
                scores(l31, s0, s1);
                smpv(s0, s1, l31, mA, lA, oA0, oA1);
                scores(32 + l31, s0, s1);
                __builtin_amdgcn_sched_barrier(0);
                {
                    const int kcn = (c < 8) ? kc + 1 : kc;
                    const bf16_t* kb = ka + (size_t)__builtin_amdgcn_readfirstlane((int)((hb * SEQ + (size_t)kcn * 64) * 64 >> 4)) * 16;
#pragma unroll
                    for (int ks = 0; ks < 4; ++ks) { kc0[ks] = *(const bf16x8*)(kb + (2 * ks) * 256 + foff); kc1[ks] = *(const bf16x8*)(kb + 2048 + (2 * ks) * 256 + foff); }
                }
                __builtin_amdgcn_sched_barrier(0);
                smpv(s0, s1, 32 + l31, mB, lB, oB0, oB1);
            }
            auto fin = [&](f32x16& o0, f32x16& o1, const float lrun, const int qt) {
                const float ltot = lrun + __shfl_xor(lrun, 32), inv = 1.0f / ltot;
                float ss = 0.f;
#pragma unroll
                for (int r = 0; r < 16; ++r) { o0[r] *= inv; o1[r] *= inv; ss += o0[r] * o0[r] + o1[r] * o1[r]; }
                ss += __shfl_xor(ss, 32);
                ssv[qt] = ss;
            };
            fin(oA0, oA1, lA, 0);
            fin(oB0, oB1, lB, 1);
        }
        if (hh == 0) { ssq[head * 64 + l31] = ssv[0]; ssq[head * 64 + 32 + l31] = ssv[1]; }
        __syncthreads();
#pragma unroll
        for (int qt = 0; qt < 2; ++qt) {
            const int qi = 32 * qt + l31;
            float tot = 0.f;
#pragma unroll
            for (int h2 = 0; h2 < 8; ++h2) tot += ssq[h2 * 64 + qi];
            const float rstd = rsqrtf(tot * (1.0f / 512.0f) + EPS);
            const size_t tok = (size_t)b * SEQ + n * 64 + qi;
#pragma unroll
            for (int dt = 0; dt < 2; ++dt)
#pragma unroll
                for (int gp = 0; gp < 2; ++gp) {
                    u32x2 w[2];
#pragma unroll
                    for (int k = 0; k < 2; ++k) {
                        const int g4 = 2 * gp + k;
                        const int dim = 32 * dt + 8 * g4 + 4 * hh;
                        const f32x4 gn = *(const f32x4*)(P.attn_out_gain + head * 64 + dim);
                        const f32x16& od = qt == 0 ? (dt == 0 ? oA0 : oA1) : (dt == 0 ? oB0 : oB1);
                        w[k].x = pk2(od[4 * g4] * rstd * gn[0], od[4 * g4 + 1] * rstd * gn[1]); w[k].y = pk2(od[4 * g4 + 2] * rstd * gn[2], od[4 * g4 + 3] * rstd * gn[3]);
                    }
                    const unsigned sx = hh ? w[0].x : w[1].x, sy = hh ? w[0].y : w[1].y;
                    const unsigned rx = (unsigned)__shfl_xor((int)sx, 32), ry = (unsigned)__shfl_xor((int)sy, 32);
                    u32x4 o;
                    o.x = hh ? rx : w[0].x; o.y = hh ? ry : w[0].y; o.z = hh ? w[1].x : rx; o.w = hh ? w[1].y : ry;
                    *(u32x4*)(mix + tok * DM + head * 64 + 32 * dt + 8 * (2 * gp + hh)) = o;
                }
        }
        __syncthreads();
    }
}

constexpr int RP = 136, TP = 72, AP = 72, AIP = 24, LDB = 273, RAWP = 784  , STGP = 136  ;
constexpr int L_KB = 0, L_KK = 17408, L_QS = 34816, L_UT = 0, L_WT = 18432, L_AINV = 36864, L_QG = 52224, L_VBT = 69632, L_KBGT = 88064, L_KDT = 106496,
              L_NL = 124928, L_LD = 134144, L_AM = 138752, L_GC = 147968, L_RED = 148480;
static_assert(L_AINV + 4 * 16 * AIP * 2 <= L_QG && L_LD + 4 * LDB * 4 <= L_AM && L_RED + 4096 <= LDS_BYTES - 16, "lds map");

__device__ void dn1_phase(const Params& P, unsigned char* lds, int bid, int nblk) {
    const int tid0 = opaque_tid();
    bf16_t* KB = (bf16_t*)(lds + L_KB); bf16_t* KK = (bf16_t*)(lds + L_KK); bf16_t* QS = (bf16_t*)(lds + L_QS);
    bf16_t* UT = (bf16_t*)(lds + L_UT); bf16_t* WT = (bf16_t*)(lds + L_WT); bf16_t* AINV = (bf16_t*)(lds + L_AINV); bf16_t* QG = (bf16_t*)(lds + L_QG);
    bf16_t* VBT = (bf16_t*)(lds + L_VBT); bf16_t* KBGT = (bf16_t*)(lds + L_KBGT); bf16_t* KDT = (bf16_t*)(lds + L_KDT);
    bf16_t* NL = (bf16_t*)(lds + L_NL); float* LD = (float*)(lds + L_LD); bf16_t* AM = (bf16_t*)(lds + L_AM);
    float* gcs = (float*)(lds + L_GC); float* bts = gcs + 64; float* red = (float*)(lds + L_RED);
    const bf16_t* pb = (const bf16_t*)(P.ws + WS_PB);
    const float* betaG = (const float*)(P.ws + WS_BETA); const float* gG = (const float*)(P.ws + WS_G);
    bf16_t* negM = (bf16_t*)(P.ws + WS_NEGM); bf16_t* BmT = (bf16_t*)P.out; bf16_t* Qp = (bf16_t*)(P.ws + WS_QP); bf16_t* Ol = (bf16_t*)(P.ws + WS_OL);
    float* egl = (float*)(P.ws + WS_EGL);
    u32x4 rv[7]; float gpre = 0.f, bpre = 0.f;
#define DN1_PREFETCH(IT)                                                                                                   \
    {                                                                                                                      \
        const int tidp_ = tid0, n_ = (IT) & 31, bh_ = (IT) >> 5, h_ = bh_ & 3, b_ = bh_ >> 2;                               \
        _Pragma("unroll") for (int q = 0; q < 7; ++q) {                                                                    \
            const int ci = tidp_ + 512 * q, row = ci / 48, c16 = ci - row * 48, mat = c16 >> 4, cc = c16 & 15;             \
            const int srow = n_ * 64 - 3 + row;                                                                            \
            const bool ok = (ci < 67 * 48) && (srow >= 0);                                                                 \
            const bf16_t* src = pb + (size_t)(b_ * SEQ + (ok ? srow : 0)) * PBW + mat * 512 + h_ * 128 + cc * 8;           \
            rv[q] = *(const u32x4*)src;                                                                                    \
            if (!ok) rv[q] = (u32x4){0u, 0u, 0u, 0u};                                                                      \
        }                                                                                                                  \
        if (tidp_ < 64) { const size_t tg_ = (size_t)(b_ * SEQ + n_ * 64 + tidp_) * 4 + h_; gpre = gG[tg_]; bpre = betaG[tg_]; } \
    }
    unsigned* qctr = (unsigned*)P.ws + 4000;
    volatile int* qnext = (volatile int*)(lds + LDS_BYTES - 32);
    if (bid < 2048) { DN1_PREFETCH(bid) }
    int item = bid;
    while (item < 2048) {
        if (tid0 == 0) *qnext = nblk + (int)__hip_atomic_fetch_add(qctr, 1u, __ATOMIC_RELAXED, __HIP_MEMORY_SCOPE_AGENT);
        int tid = tid0; asm volatile("" : "+v"(tid));
        const int wid = tid >> 6, lane = tid & 63, fr = lane & 15, fq = lane >> 4;
        const int n = item & 31, bh = item >> 5, h = bh & 3, b = bh >> 2;
        const int t0 = b * SEQ + n * 64;
        if (wid == 0) {
            float gv = gpre;
#pragma unroll
            for (int o = 1; o < 64; o <<= 1) { const float t = __shfl_up(gv, o); if (lane >= o) gv += t; }
            gcs[lane] = gv; bts[lane] = bpre;
        }
#pragma unroll
        for (int q = 0; q < 7; ++q) {
            const int ci = tid + 512 * q, row = ci / 48, c16 = ci - row * 48;
            if (ci < 67 * 48) *(u32x4*)(lds + row * RAWP + c16 * 16) = rv[q];
        }
        __syncthreads();
        const int r = lane, cg = __builtin_amdgcn_readfirstlane(wid);
        float cv[3][16];
#pragma unroll
        for (int mat = 0; mat < 3; ++mat) {
            const int col = mat * 512 + h * 128 + 16 * cg;
            float* a = cv[mat];
#pragma unroll
            for (int i = 0; i < 16; ++i) a[i] = 0.f;
#pragma unroll
            for (int tap = 0; tap < 4; ++tap) {
                const unsigned char* src = lds + (r + tap) * RAWP + (mat * 128 + 16 * cg) * 2;
                const u32x4 x0 = *(const u32x4*)src, x1 = *(const u32x4*)(src + 16);
                const float* wp = P.conv_w + tap * 1536 + col;
                const f32x4 w0 = *(const f32x4*)wp, w1 = *(const f32x4*)(wp + 4), w2 = *(const f32x4*)(wp + 8), w3 = *(const f32x4*)(wp + 12);
                a[0] += bflo(x0.x) * w0[0]; a[1] += bfhi(x0.x) * w0[1]; a[2] += bflo(x0.y) * w0[2]; a[3] += bfhi(x0.y) * w0[3];
                a[4] += bflo(x0.z) * w1[0]; a[5] += bfhi(x0.z) * w1[1]; a[6] += bflo(x0.w) * w1[2]; a[7] += bfhi(x0.w) * w1[3];
                a[8] += bflo(x1.x) * w2[0]; a[9] += bfhi(x1.x) * w2[1]; a[10] += bflo(x1.y) * w2[2]; a[11] += bfhi(x1.y) * w2[3];
                a[12] += bflo(x1.z) * w3[0]; a[13] += bfhi(x1.z) * w3[1]; a[14] += bflo(x1.w) * w3[2]; a[15] += bfhi(x1.w) * w3[3];
            }
            float ss = 0.f;
#pragma unroll
            for (int i = 0; i < 16; ++i) { a[i] = silu_f(a[i]); ss += a[i] * a[i]; }
            if (mat < 2) red[(mat * 8 + cg) * 64 + r] = ss;
        }
        __syncthreads();
        {
            float sq = 0.f, sk = 0.f;
#pragma unroll
            for (int g8 = 0; g8 < 8; ++g8) { sq += red[g8 * 64 + r]; sk += red[(8 + g8) * 64 + r]; }
            const float gc = gcs[r], bt = bts[r], gl = gcs[63];
            const float eg = __expf(gc), edk = __expf(gl - gc);
            if (tid == 0) egl[item] = __expf(gl);
            const float rq = rsqrtf(sq + EPS) * 0.08838834764831845f, rk = rsqrtf(sk + EPS);
            u32x4 o0, o1;
#define STORE_ROW(ARR, A, F)                                                                                                             \
    {                                                                                                                                    \
        o0.x = pk2(A[0] * (F), A[1] * (F)); o0.y = pk2(A[2] * (F), A[3] * (F)); o0.z = pk2(A[4] * (F), A[5] * (F)); o0.w = pk2(A[6] * (F), A[7] * (F));       \
        o1.x = pk2(A[8] * (F), A[9] * (F)); o1.y = pk2(A[10] * (F), A[11] * (F)); o1.z = pk2(A[12] * (F), A[13] * (F)); o1.w = pk2(A[14] * (F), A[15] * (F)); \
        *(u32x4*)(ARR + r * RP + 16 * cg) = o0; *(u32x4*)(ARR + r * RP + 16 * cg + 8) = o1;                                              \
    }
            const float rqe = rq * eg, rkb = rk * bt, f1 = rk * bt * eg, f2 = rk * edk;
            STORE_ROW(QS, cv[0], rq)
            STORE_ROW(QG, cv[0], rqe)
            STORE_ROW(KK, cv[1], rk)
            STORE_ROW(KB, cv[1], rkb)
#undef STORE_ROW
#pragma unroll
            for (int i = 0; i < 16; ++i) {
                const int c = 16 * cg + i;
                KBGT[c * TP + r] = (bf16_t)f2bf(cv[1][i] * f1);
                KDT[c * TP + r] = (bf16_t)f2bf(cv[1][i] * f2);
                VBT[c * TP + r] = (bf16_t)f2bf(cv[2][i] * bt);
            }
        }
        __syncthreads();
        const int item_next = __builtin_amdgcn_readfirstlane(*qnext);
        if (item_next < 2048) { DN1_PREFETCH(item_next) }
        {
            const int mat = wid >> 2, ti = wid & 3;
            const bf16_t* Asrc = mat ? QS : KB;
            bf16x8 af[4];
#pragma unroll
            for (int ks = 0; ks < 4; ++ks) af[ks] = *(const bf16x8*)(Asrc + (16 * ti + fr) * RP + 32 * ks + 8 * fq);
            for (int tj = 0; tj < 4; ++tj) {
                const int j = 16 * tj + fr;
                if (tj > ti) {
                    if (mat) {
#pragma unroll
                        for (int rr = 0; rr < 4; ++rr) AM[(16 * ti + 4 * fq + rr) * AP + j] = 0;
                    }
                    continue;
                }
                f32x4 acc = (f32x4){0.f, 0.f, 0.f, 0.f};
#pragma unroll
                for (int ks = 0; ks < 4; ++ks) { const bf16x8 bf = *(const bf16x8*)(KK + j * RP + 32 * ks + 8 * fq); acc = mfma16(af[ks], bf, acc); }
                const float gj = gcs[j];
#pragma unroll
                for (int rr = 0; rr < 4; ++rr) {
                    const int i = 16 * ti + 4 * fq + rr;
                    const float dec = __expf(gcs[i] - gj);
                    if (mat == 0) {
                        if (tj < ti) NL[i * AP + j] = (bf16_t)f2bf(-acc[rr] * dec);
                        else LD[ti * LDB + (4 * fq + rr) * 17 + fr] = (i > j) ? acc[rr] * dec : 0.f;
                    } else AM[i * AP + j] = (bf16_t)f2bf((i >= j) ? acc[rr] * dec : 0.f);
                }
            }
        }
        __syncthreads();
        {
            {
                const int blk = lane >> 4, cp = lane & 15;
                float xv[16];
#pragma unroll
                for (int i = 0; i < 16; ++i) {
                    float a = (i == cp) ? 1.0f : 0.0f;
#pragma unroll
                    for (int jj = 0; jj < i; ++jj) a -= LD[blk * LDB + i * 17 + jj] * xv[jj];
                    xv[i] = a;
                }
#pragma unroll
                for (int i = 0; i < 16; ++i) AINV[(blk * 16 + i) * AIP + cp] = (bf16_t)f2bf(xv[i]);
            }
#pragma unroll 1
            for (int cti = 0; cti < 2; ++cti) {
                const int ct = 2 * wid + cti;
                const bf16_t* RT = (ct < 8) ? (VBT + (16 * ct) * TP) : (KBGT + (16 * (ct - 8)) * TP);
                bf16_t* XT = (ct < 8) ? (UT + (16 * ct) * TP) : (WT + (16 * (ct - 8)) * TP);
#pragma unroll
                for (int bq = 0; bq < 4; ++bq) {
                    const u32x2 r2 = *(const u32x2*)(RT + fr * TP + 16 * bq + 4 * fq);
                    f32x4 acc = (f32x4){bflo(r2.x), bfhi(r2.x), bflo(r2.y), bfhi(r2.y)};
                    if (bq > 0) {
#pragma unroll
                        for (int ks = 0; ks < (16 * bq + 31) / 32; ++ks) {
                            bf16x8 a = *(const bf16x8*)(NL + (16 * bq + fr) * AP + 32 * ks + 8 * fq);
                            bf16x8 xb = *(const bf16x8*)(XT + fr * TP + 32 * ks + 8 * fq);
                            if (32 * ks + 8 * fq >= 16 * bq) { a = (bf16x8){0, 0, 0, 0, 0, 0, 0, 0}; xb = (bf16x8){0, 0, 0, 0, 0, 0, 0, 0}; }
                            acc = mfma16(a, xb, acc);
                        }
                    }
                    u32x4 uf; uf.x = pk2(acc[0], acc[1]); uf.y = pk2(acc[2], acc[3]); uf.z = 0u; uf.w = 0u;
                    const u32x2 ai2 = *(const u32x2*)(AINV + (bq * 16 + fr) * AIP + 4 * fq);
                    u32x4 af; af.x = ai2.x; af.y = ai2.y; af.z = 0u; af.w = 0u;
                    f32x4 xo = (f32x4){0.f, 0.f, 0.f, 0.f};
                    xo = mfma16(__builtin_bit_cast(bf16x8, af), __builtin_bit_cast(bf16x8, uf), xo);
                    u32x2 o; o.x = pk2(xo[0], xo[1]); o.y = pk2(xo[2], xo[3]);
                    *(u32x2*)(XT + fr * TP + 16 * bq + 4 * fq) = o;
                }
            }
        }
        __syncthreads();
        {
            const size_t ib = (size_t)item * 16384;
            bf16_t* stg = (bf16_t*)(lds + L_VBT) + wid * (16 * STGP);
            if (n != 31) {
                const bf16x8 b0 = *(const bf16x8*)(KDT + (16 * wid + fr) * TP + 8 * fq), b1 = *(const bf16x8*)(KDT + (16 * wid + fr) * TP + 32 + 8 * fq);
#pragma unroll
                for (int t = 0; t < 8; ++t) {
                    const bf16x8 a0 = *(const bf16x8*)(WT + (16 * t + fr) * TP + 8 * fq), a1 = *(const bf16x8*)(WT + (16 * t + fr) * TP + 32 + 8 * fq);
                    f32x4 acc = (f32x4){0.f, 0.f, 0.f, 0.f};
                    acc = mfma16(a0, b0, acc); acc = mfma16(a1, b1, acc);
                    u32x2 o; o.x = pk2(-acc[0], -acc[1]); o.y = pk2(-acc[2], -acc[3]);
                    *(u32x2*)(stg + fr * STGP + 16 * t + 4 * fq) = o;
                }
#pragma unroll
                for (int q = 0; q < 4; ++q) {
                    const int row = (lane >> 4) + 4 * q;
                    const u32x4 v = *(const u32x4*)(stg + row * STGP + (lane & 15) * 8);
                    *(u32x4*)(negM + ib + (size_t)(16 * wid + row) * 128 + (lane & 15) * 8) = v;
                }
            }
            if (n != 31) {
                const bf16x8 b0 = *(const bf16x8*)(UT + (16 * wid + fr) * TP + 8 * fq), b1 = *(const bf16x8*)(UT + (16 * wid + fr) * TP + 32 + 8 * fq);
#pragma unroll
                for (int t = 0; t < 8; ++t) {
                    const bf16x8 a0 = *(const bf16x8*)(KDT + (16 * t + fr) * TP + 8 * fq), a1 = *(const bf16x8*)(KDT + (16 * t + fr) * TP + 32 + 8 * fq);
                    f32x4 acc = (f32x4){0.f, 0.f, 0.f, 0.f};
                    acc = mfma16(a0, b0, acc); acc = mfma16(a1, b1, acc);
                    u32x2 o; o.x = pk2(acc[0], acc[1]); o.y = pk2(acc[2], acc[3]);
                    *(u32x2*)(stg + fr * STGP + 16 * t + 4 * fq) = o;
                }
#pragma unroll
                for (int q = 0; q < 4; ++q) {
                    const int row = (lane >> 4) + 4 * q;
                    const u32x4 v = *(const u32x4*)(stg + row * STGP + (lane & 15) * 8);
                    *(u32x4*)(BmT + ib + (size_t)(16 * wid + row) * 128 + (lane & 15) * 8) = v;
                }
            }
            {
                const int it4 = wid & 3, hf = wid >> 2;
                const bf16x8 b0 = *(const bf16x8*)(AM + (16 * it4 + fr) * AP + 8 * fq), b1 = *(const bf16x8*)(AM + (16 * it4 + fr) * AP + 32 + 8 * fq);
#pragma unroll
                for (int tt = 0; tt < 4; ++tt) {
                    const int t = 4 * hf + tt;
                    const bf16x8 a0 = *(const bf16x8*)(WT + (16 * t + fr) * TP + 8 * fq), a1 = *(const bf16x8*)(WT + (16 * t + fr) * TP + 32 + 8 * fq);
                    f32x4 acc = (f32x4){0.f, 0.f, 0.f, 0.f};
                    acc = mfma16(a0, b0, acc); acc = mfma16(a1, b1, acc);
                    const u32x2 qg = *(const u32x2*)(QG + (16 * it4 + fr) * RP + 16 * t + 4 * fq);
                    u32x2 o; o.x = pk2(bflo(qg.x) - acc[0], bfhi(qg.x) - acc[1]); o.y = pk2(bflo(qg.y) - acc[2], bfhi(qg.y) - acc[3]);
                    *(u32x2*)(stg + fr * STGP + 16 * tt + 4 * fq) = o;
                }
#pragma unroll
                for (int q = 0; q < 2; ++q) {
                    const int row = (lane >> 3) + 8 * q;
                    const u32x4 v = *(const u32x4*)(stg + row * STGP + (lane & 7) * 8);
                    *(u32x4*)(Qp + (size_t)item * 8192 + (size_t)(16 * it4 + row) * 128 + 64 * hf + (lane & 7) * 8) = v;
                }
#pragma unroll
                for (int tt = 0; tt < 4; ++tt) {
                    const int t = 4 * hf + tt;
                    const bf16x8 a0 = *(const bf16x8*)(UT + (16 * t + fr) * TP + 8 * fq), a1 = *(const bf16x8*)(UT + (16 * t + fr) * TP + 32 + 8 * fq);
                    f32x4 acc = (f32x4){0.f, 0.f, 0.f, 0.f};
                    acc = mfma16(a0, b0, acc); acc = mfma16(a1, b1, acc);
                    u32x2 o; o.x = pk2(acc[0], acc[1]); o.y = pk2(acc[2], acc[3]);
                    *(u32x2*)(stg + fr * STGP + 16 * tt + 4 * fq) = o;
                }
#pragma unroll
                for (int q = 0; q < 2; ++q) {
                    const int row = (lane >> 3) + 8 * q;
                    const u32x4 v = *(const u32x4*)(stg + row * STGP + (lane & 7) * 8);
                    *(u32x4*)(Ol + (size_t)item * 8192 + (size_t)(16 * it4 + row) * 128 + 64 * hf + (lane & 7) * 8) = v;
                }
            }
        }
        __syncthreads();
        item = item_next;
    }
}
#undef DN1_PREFETCH

__device__ void dn2_phase(const Params& P, unsigned char* lds, int bid, int nblk) {
    const int tid = opaque_tid(), wid = tid >> 6, lane = tid & 63, fr = lane & 15, fq = lane >> 4;
    const bf16_t* negM = (const bf16_t*)(P.ws + WS_NEGM); const bf16_t* BmT = (const bf16_t*)P.out;
    const float* egl = (const float*)(P.ws + WS_EGL); bf16_t* SnT = (bf16_t*)(P.ws + WS_SNT);
    constexpr int SP = 136;
    bf16_t* ST = (bf16_t*)lds;
    for (int sid = bid; sid < 256; sid += nblk) {
        const int bh = sid >> 2, sl = sid & 3;
        f32x4 acc[2];
        acc[0] = (f32x4){0.f, 0.f, 0.f, 0.f}; acc[1] = (f32x4){0.f, 0.f, 0.f, 0.f};
        bf16x8 an[4]; u32x2 bmn[2]; float egn;
        {
            const size_t ib = ((size_t)bh * 32) * 16384;
#pragma unroll
            for (int ks = 0; ks < 4; ++ks) an[ks] = *(const bf16x8*)(negM + ib + (size_t)(16 * wid + fr) * 128 + 32 * ks + 8 * fq);
#pragma unroll
            for (int nn = 0; nn < 2; ++nn) bmn[nn] = *(const u32x2*)(BmT + ib + (size_t)(32 * sl + 16 * nn + fr) * 128 + 16 * wid + 4 * fq);
            egn = egl[bh * 32];
        }
        __syncthreads();
#pragma unroll
        for (int nn = 0; nn < 2; ++nn) *(u32x2*)(ST + (16 * nn + fr) * SP + 16 * wid + 4 * fq) = (u32x2){0u, 0u};
        __syncthreads();
        for (int n = 0; n < 32; ++n) {
            const bf16_t* cur = ST + (n & 1) * 32 * SP; bf16_t* nxt = ST + ((n & 1) ^ 1) * 32 * SP;
            const size_t ib = ((size_t)bh * 32 + n) * 16384;
            {
                const int col = tid >> 4, chn = tid & 15;
                *(u32x4*)(SnT + ib + (size_t)(32 * sl + col) * 128 + 8 * chn) = *(const u32x4*)(cur + col * SP + 8 * chn);
            }
            if (n == 31) break;
            bf16x8 a[4]; u32x2 bm[2];
#pragma unroll
            for (int ks = 0; ks < 4; ++ks) a[ks] = an[ks];
            bm[0] = bmn[0]; bm[1] = bmn[1];
            const float eg = egn;
            if (n + 1 < 31) {
                const size_t ib2 = ib + 16384;
#pragma unroll
                for (int ks = 0; ks < 4; ++ks) an[ks] = *(const bf16x8*)(negM + ib2 + (size_t)(16 * wid + fr) * 128 + 32 * ks + 8 * fq);
#pragma unroll
                for (int nn = 0; nn < 2; ++nn) bmn[nn] = *(const u32x2*)(BmT + ib2 + (size_t)(32 * sl + 16 * nn + fr) * 128 + 16 * wid + 4 * fq);
                egn = egl[bh * 32 + n + 1];
            }
#pragma unroll
            for (int nn = 0; nn < 2; ++nn) {
                acc[nn][0] = eg * acc[nn][0] + bflo(bm[nn].x); acc[nn][1] = eg * acc[nn][1] + bfhi(bm[nn].x);
                acc[nn][2] = eg * acc[nn][2] + bflo(bm[nn].y); acc[nn][3] = eg * acc[nn][3] + bfhi(bm[nn].y);
#pragma unroll
                for (int ks = 0; ks < 4; ++ks) {
                    const bf16x8 sb = *(const bf16x8*)(cur + (16 * nn + fr) * SP + 32 * ks + 8 * fq);
                    acc[nn] = mfma16(a[ks], sb, acc[nn]);
                }
                u32x2 o; o.x = pk2(acc[nn][0], acc[nn][1]); o.y = pk2(acc[nn][2], acc[nn][3]);
                *(u32x2*)(nxt + (16 * nn + fr) * SP + 16 * wid + 4 * fq) = o;
            }
            __syncthreads();
        }
    }
}

__device__ void dn3_phase(const Params& P, unsigned char* lds, int bid, int nblk) {
    const int tid = opaque_tid(), wid = tid >> 6, lane = tid & 63, fr = lane & 15, fq = lane >> 4;
    const bf16_t* SnT = (const bf16_t*)(P.ws + WS_SNT); const bf16_t* Qp = (const bf16_t*)(P.ws + WS_QP); const bf16_t* Ol = (const bf16_t*)(P.ws + WS_OL);
    const bf16_t* pb = (const bf16_t*)(P.ws + WS_PB); bf16_t* mix = (bf16_t*)(P.ws + WS_H);
    constexpr int SP3 = 136, SBUF = 128 * SP3 * 2;
    static_assert(4 * SBUF <= LDS_BYTES - 32, "dn3 staging");
    const int half = wid >> 2, q4 = wid & 3, th = tid & 255;
    struct Ops { u32x4 sv[8]; bf16x8 bq[4]; u32x2 olv[8], zv[8]; };
    auto loadOps = [&](int it2, Ops& o) {
        const int item = it2 * 2 + half;
        const int n = item & 31, bh = item >> 5, h = bh & 3, b = bh >> 2;
        const int i = 16 * q4 + fr;
        const bf16_t* sb = SnT + (size_t)item * 16384;
#pragma unroll
        for (int k = 0; k < 8; ++k) o.sv[k] = *(const u32x4*)(sb + (size_t)(th + 256 * k) * 8);
        const bf16_t* qrow = Qp + (size_t)item * 8192 + (size_t)i * 128;
#pragma unroll
        for (int ks = 0; ks < 4; ++ks) o.bq[ks] = *(const bf16x8*)(qrow + 32 * ks + 8 * fq);
        const bf16_t* olr = Ol + (size_t)item * 8192 + (size_t)i * 128;
        const size_t tok = (size_t)b * SEQ + n * 64 + i;
#pragma unroll
        for (int dt = 0; dt < 8; ++dt) { o.olv[dt] = *(const u32x2*)(olr + 16 * dt + 4 * fq); o.zv[dt] = *(const u32x2*)(pb + tok * PBW + 1536 + h * 128 + 16 * dt + 4 * fq); }
    };
    Ops cur;
    if (bid < 1024) loadOps(bid, cur);
    int par = 0;
    for (int it2 = bid; it2 < 1024; it2 += nblk, par ^= 1) {
        const int item = it2 * 2 + half;
        const int n = item & 31, bh = item >> 5, h = bh & 3, b = bh >> 2;
        const int i = 16 * q4 + fr;
        const size_t tok = (size_t)b * SEQ + n * 64 + i;
        unsigned char* SB = lds + (par * 2 + half) * SBUF;
#pragma unroll
        for (int k = 0; k < 8; ++k) { const int piece = th + 256 * k; *(u32x4*)(SB + (piece >> 4) * (SP3 * 2) + (piece & 15) * 16) = cur.sv[k]; }
        bf16x8 bq[4]; u32x2 olv[8], zv[8];
#pragma unroll
        for (int ks = 0; ks < 4; ++ks) bq[ks] = cur.bq[ks];
#pragma unroll
        for (int dt = 0; dt < 8; ++dt) { olv[dt] = cur.olv[dt]; zv[dt] = cur.zv[dt]; }
        __syncthreads();
        if (it2 + nblk < 1024) loadOps(it2 + nblk, cur);
        __builtin_amdgcn_sched_barrier(0);
        f32x4 acc[8];
#pragma unroll
        for (int dt = 0; dt < 8; ++dt) {
            acc[dt] = (f32x4){bflo(olv[dt].x), bfhi(olv[dt].x), bflo(olv[dt].y), bfhi(olv[dt].y)};
#pragma unroll
            for (int ks = 0; ks < 4; ++ks) { const bf16x8 a = *(const bf16x8*)(SB + (16 * dt + fr) * (SP3 * 2) + (32 * ks + 8 * fq) * 2); acc[dt] = mfma16(a, bq[ks], acc[dt]); }
        }
        float ss = 0.f;
#pragma unroll
        for (int dt = 0; dt < 8; ++dt) ss += acc[dt][0] * acc[dt][0] + acc[dt][1] * acc[dt][1] + acc[dt][2] * acc[dt][2] + acc[dt][3] * acc[dt][3];
        ss += __shfl_xor(ss, 16); ss += __shfl_xor(ss, 32);
        const float rstd = rsqrtf(ss * (1.0f / 128.0f) + EPS);
        const bool fodd = (fq & 1) != 0;
#pragma unroll
        for (int dp = 0; dp < 4; ++dp) {
            u32x2 w[2];
#pragma unroll
            for (int k = 0; k < 2; ++k) {
                const int dt = 2 * dp + k;
                const int dv = 16 * dt + 4 * fq;
                const u32x2 z = zv[dt];
                const f32x4 gn = *(const f32x4*)(P.dn_out_gain + dv);
                w[k].x = pk2(acc[dt][0] * rstd * gn[0] * silu_f(bflo(z.x)), acc[dt][1] * rstd * gn[1] * silu_f(bfhi(z.x)));
                w[k].y = pk2(acc[dt][2] * rstd * gn[2] * silu_f(bflo(z.y)), acc[dt][3] * rstd * gn[3] * silu_f(bfhi(z.y)));
            }
            const unsigned sx = fodd ? w[0].x : w[1].x, sy = fodd ? w[0].y : w[1].y;
            const unsigned rx = (unsigned)__shfl_xor((int)sx, 16), ry = (unsigned)__shfl_xor((int)sy, 16);
            u32x4 o;
            o.x = fodd ? rx : w[0].x; o.y = fodd ? ry : w[0].y; o.z = fodd ? w[1].x : rx; o.w = fodd ? w[1].y : ry;
            *(u32x4*)(mix + tok * DM + 512 + h * 128 + 16 * (2 * dp + (fodd ? 1 : 0)) + 4 * (fq & ~1)) = o;
        }
    }
}

__device__ __forceinline__ void sort16_desc(float (&v)[16]) {
#define CE_(A, B) { const float hi_ = fmaxf(v[A], v[B]), lo_ = fminf(v[A], v[B]); v[A] = hi_; v[B] = lo_; }
    CE_(0,13) CE_(1,12) CE_(2,15) CE_(3,14) CE_(4,8) CE_(5,6) CE_(7,11) CE_(9,10)
    CE_(0,5) CE_(1,7) CE_(2,9) CE_(3,4) CE_(6,13) CE_(8,14) CE_(10,15) CE_(11,12)
    CE_(0,1) CE_(2,3) CE_(4,5) CE_(6,8) CE_(7,9) CE_(10,11) CE_(12,13) CE_(14,15)
    CE_(0,2) CE_(1,3) CE_(4,10) CE_(5,11) CE_(6,7) CE_(8,9) CE_(12,14) CE_(13,15)
    CE_(1,2) CE_(3,12) CE_(4,6) CE_(5,7) CE_(8,10) CE_(9,11) CE_(13,14)
    CE_(1,4) CE_(2,6) CE_(5,8) CE_(7,10) CE_(9,13) CE_(11,14)
    CE_(2,4) CE_(3,6) CE_(9,12) CE_(11,13)
    CE_(3,5) CE_(6,8) CE_(7,9) CE_(10,12)
    CE_(3,4) CE_(5,6) CE_(7,8) CE_(9,10) CE_(11,12)
    CE_(6,7) CE_(8,9)
#undef CE_
}
__device__ __forceinline__ void merge_top16(float (&a)[16], const float (&b)[16]) {
#pragma unroll
    for (int i = 0; i < 16; ++i) a[i] = fmaxf(a[i], b[15 - i]);
#pragma unroll
    for (int j = 8; j > 0; j >>= 1) {
#pragma unroll
        for (int i = 0; i < 16; ++i) {
            const int l = i ^ j;
            if (l > i) { const float hi = fmaxf(a[i], a[l]), lo = fminf(a[i], a[l]); a[i] = hi; a[l] = lo; }
        }
    }
}
__device__ __forceinline__ unsigned lut16(unsigned long long lo, unsigned long long hi, unsigned idx) {
    const unsigned long long w = (idx & 8u) ? hi : lo;
    return (unsigned)(w >> ((idx & 7u) * 8u)) & 127u;
}

__device__ void route_phase(const Params& P, unsigned char* lds, int bid, int nblk) {
    const int tid = opaque_tid(), wid = tid >> 6, lane = tid & 63, l31 = lane & 31, hh = lane >> 5;
    const bf16_t* qry = (const bf16_t*)(P.ws + WS_PB); const bf16_t* skp = (const bf16_t*)(P.ws + WS_SK);
    {
#pragma unroll
        for (int i = 0; i < 8; ++i) {
            const int f = wid * 8 + i, p = f >> 5, kt = (f >> 3) & 3, ks = f & 7;
            const u32x4 v = *(const u32x4*)(skp + p * 16384 + (32 * kt + l31) * 128 + 16 * ks + 8 * hh);
            *(u32x4*)(lds + f * 1024 + lane * 16) = v;
        }
        __syncthreads();
    }
    for (int wi = bid * 8 + wid; wi < 1024 * 8; wi += nblk * 8) {
        const int tg = wi >> 3, hd = wi & 7;
        const int tok = tg * 32 + l31;
        const bf16_t* qrow = qry + (size_t)tok * 2048 + hd * 256;
        float top[2][16];
        float ssq = 0.f;
        bf16x8 bq[2][8];
#pragma unroll
        for (int p = 0; p < 2; ++p)
#pragma unroll
            for (int ks = 0; ks < 8; ++ks) {
                bq[p][ks] = *(const bf16x8*)(qrow + 128 * p + 16 * ks + 8 * hh);
                const u32x4 u = __builtin_bit_cast(u32x4, bq[p][ks]);
                ssq += bflo(u.x) * bflo(u.x) + bfhi(u.x) * bfhi(u.x) + bflo(u.y) * bflo(u.y) + bfhi(u.y) * bfhi(u.y) + bflo(u.z) * bflo(u.z) + bfhi(u.z) * bfhi(u.z) +
                       bflo(u.w) * bflo(u.w) + bfhi(u.w) * bfhi(u.w);
            }
        ssq += __shfl_xor(ssq, 32);
        const float rstd = rsqrtf(ssq * (1.0f / 256.0f) + EPS);
#pragma unroll
        for (int p = 0; p < 2; ++p) {
            float run[16];
#pragma unroll
            for (int kt = 0; kt < 4; ++kt) {
                __builtin_amdgcn_sched_barrier(0);
                f32x16 s;
#pragma unroll
                for (int r = 0; r < 16; ++r) s[r] = 0.f;
#pragma unroll
                for (int ks = 0; ks < 8; ++ks) { const bf16x8 a = *(const bf16x8*)(lds + ((p * 4 + kt) * 8 + ks) * 1024 + lane * 16); s = mfma32(a, bq[p][ks], s); }
                float cur[16];
#pragma unroll
                for (int r = 0; r < 16; ++r) {
                    const unsigned key = 32 * kt + (r & 3) + 8 * (r >> 2) + 4 * hh;
                    cur[r] = __uint_as_float((__float_as_uint(s[r] * rstd) & ~127u) | key);
                }
                sort16_desc(cur);
                if (kt == 0) {
#pragma unroll
                    for (int r = 0; r < 16; ++r) run[r] = cur[r];
                } else merge_top16(run, cur);
            }
            float oth[16];
#pragma unroll
            for (int r = 0; r < 16; ++r) oth[r] = __shfl_xor(run[r], 32);
            merge_top16(run, oth);
#pragma unroll
            for (int r = 0; r < 16; ++r) top[p][r] = run[r];
        }
        f32x4 tv[4][4];
        const int trow0 = __builtin_amdgcn_readfirstlane(wi) * 4;
#pragma unroll
        for (int j = 0; j < 4; ++j) {
            const int row = trow0 + j; const bool up = row >= NEXP; const int er = up ? row - NEXP : row;
            const float* src = (up ? P.e_up : P.e_down) + (size_t)er * 1024 + 16 * lane;
#pragma unroll
            for (int q = 0; q < 4; ++q) tv[j][q] = *(const f32x4*)(src + 4 * q);
        }
        __builtin_amdgcn_sched_barrier(0);
        float v1[16], v2[16];
        unsigned long long p1lo = 0ull, p1hi = 0ull, p2lo = 0ull, p2hi = 0ull;
#pragma unroll
        for (int r = 0; r < 16; ++r) {
            const unsigned u1 = __float_as_uint(top[0][r]), u2 = __float_as_uint(top[1][r]);
            v1[r] = __uint_as_float(u1 & ~127u); v2[r] = __uint_as_float(u2 & ~127u);
            if (r < 8) { p1lo |= (unsigned long long)(u1 & 127u) << (8 * r); p2lo |= (unsigned long long)(u2 & 127u) << (8 * r); }
            else { p1hi |= (unsigned long long)(u1 & 127u) << (8 * (r - 8)); p2hi |= (unsigned long long)(u2 & 127u) << (8 * (r - 8)); }
        }
#define CAND(a, b) __uint_as_float((__float_as_uint(v1[a] + v2[b]) & ~255u) | (unsigned)((a) * 16 + (b)))
        const float NEG = -3.0e38f;
        float g0[16], g1[16], g2[16], g3[16];
#pragma unroll
        for (int r = 0; r < 16; ++r) g0[r] = CAND(0, r);
        g1[0] = CAND(1, 0); g1[1] = CAND(1, 1); g1[2] = CAND(1, 2); g1[3] = CAND(1, 3); g1[4] = CAND(1, 4); g1[5] = CAND(1, 5); g1[6] = CAND(1, 6); g1[7] = CAND(1, 7);
        g1[8] = CAND(2, 0); g1[9] = CAND(2, 1); g1[10] = CAND(2, 2); g1[11] = CAND(2, 3); g1[12] = CAND(2, 4); g1[13] = CAND(4, 0); g1[14] = CAND(4, 1); g1[15] = CAND(4, 2);
        g2[0] = CAND(3, 0); g2[1] = CAND(3, 1); g2[2] = CAND(3, 2); g2[3] = CAND(3, 3); g2[4] = CAND(5, 0); g2[5] = CAND(5, 1); g2[6] = CAND(6, 0); g2[7] = CAND(6, 1);
        g2[8] = CAND(7, 0); g2[9] = CAND(7, 1); g2[10] = CAND(8, 0); g2[11] = CAND(9, 0); g2[12] = CAND(10, 0); g2[13] = CAND(11, 0); g2[14] = CAND(12, 0); g2[15] = CAND(13, 0);
        g3[0] = CAND(14, 0); g3[1] = CAND(15, 0);
#pragma unroll
        for (int r = 2; r < 16; ++r) g3[r] = NEG;
#undef CAND
        sort16_desc(g1); sort16_desc(g2); sort16_desc(g3);
        merge_top16(g0, g1); merge_top16(g2, g3); merge_top16(g0, g2);
        float e[16], es = 0.f; int eid[16];
        const float m0 = __uint_as_float(__float_as_uint(g0[0]) & ~255u);
#pragma unroll
        for (int r = 0; r < 16; ++r) {
            const unsigned u = __float_as_uint(g0[r]);
            const float sv = __uint_as_float(u & ~255u);
            e[r] = __expf(sv - m0); es += e[r];
            const unsigned a = (u >> 4) & 15u, bb = u & 15u;
            eid[r] = (int)(lut16(p1lo, p1hi, a) * 128u + lut16(p2lo, p2hi, bb));
        }
        const float inv = 1.0f / es;
        if (hh == 0) {
            {
                bf16_t* i16 = (bf16_t*)(P.ws + WS_IDS16) + ((size_t)tok * 8 + hd) * 16;
                u32x4 a0, a1;
                a0.x = (unsigned)eid[0] | ((unsigned)eid[1] << 16); a0.y = (unsigned)eid[2] | ((unsigned)eid[3] << 16); a0.z = (unsigned)eid[4] | ((unsigned)eid[5] << 16); a0.w = (unsigned)eid[6] | ((unsigned)eid[7] << 16);
                a1.x = (unsigned)eid[8] | ((unsigned)eid[9] << 16); a1.y = (unsigned)eid[10] | ((unsigned)eid[11] << 16); a1.z = (unsigned)eid[12] | ((unsigned)eid[13] << 16); a1.w = (unsigned)eid[14] | ((unsigned)eid[15] << 16);
                *(u32x4*)i16 = a0; *(u32x4*)(i16 + 8) = a1;
                bf16_t* g16 = (bf16_t*)(P.ws + WS_GATES16) + ((size_t)tok * 8 + hd) * 16;
                u32x4 c0, c1;
                c0.x = pk2(e[0] * inv, e[1] * inv); c0.y = pk2(e[2] * inv, e[3] * inv); c0.z = pk2(e[4] * inv, e[5] * inv); c0.w = pk2(e[6] * inv, e[7] * inv);
                c1.x = pk2(e[8] * inv, e[9] * inv); c1.y = pk2(e[10] * inv, e[11] * inv); c1.z = pk2(e[12] * inv, e[13] * inv); c1.w = pk2(e[14] * inv, e[15] * inv);
                *(u32x4*)g16 = c0; *(u32x4*)(g16 + 8) = c1;
            }
        }
        __builtin_amdgcn_sched_barrier(0);
#pragma unroll
        for (int j = 0; j < 4; ++j) {
            const int row = trow0 + j; const bool up = row >= NEXP; const int er = up ? row - NEXP : row;
            float am = 0.f;
#pragma unroll
            for (int q = 0; q < 4; ++q) am = fmaxf(am, fmaxf(fmaxf(fabsf(tv[j][q][0]), fabsf(tv[j][q][1])), fmaxf(fabsf(tv[j][q][2]), fabsf(tv[j][q][3]))));
#pragma unroll
            for (int o = 32; o > 0; o >>= 1) am = fmaxf(am, __shfl_xor(am, o));
            am = am > 0.f ? am : 1.0f;
            const float sc = am * (1.0f / 127.0f), inv = 127.0f / am;
            u32x4 o4;
#pragma unroll
            for (int q = 0; q < 4; ++q) {
                const int b0 = (int)rintf(tv[j][q][0] * inv), b1 = (int)rintf(tv[j][q][1] * inv), b2 = (int)rintf(tv[j][q][2] * inv), b3 = (int)rintf(tv[j][q][3] * inv);
                o4[q] = (unsigned)(b0 & 255) | ((unsigned)(b1 & 255) << 8) | ((unsigned)(b2 & 255) << 16) | ((unsigned)(b3 & 255) << 24);
            }
            *(u32x4*)((signed char*)(P.ws + (up ? WS_EU8 : WS_ED8)) + ((size_t)(lane >> 3) * NEXP + er) * 128 + 16 * (lane & 7)) = o4;
            if (lane == 0) ((float*)(P.ws + (up ? WS_SU : WS_SD)))[er] = sc;
        }
    }
}


#define XL_RANK(j) (3520 + 64 * (j))
struct XLabel { int NL, x, j, nloc; };
__device__ __forceinline__ XLabel xcd_label(const Params& P, const unsigned char* lds, int bid, int nblk) {
    XLabel L;
    L.NL = nblk < 8 ? nblk : 8; L.x = bid % L.NL; L.j = bid / L.NL; L.nloc = (nblk - L.x + L.NL - 1) / L.NL;
    const volatile unsigned* st = (const volatile unsigned*)(lds + LDS_BYTES - 16);
    const unsigned myx = st[2], myr = st[3];
    unsigned* bar = (unsigned*)P.ws;
    unsigned sum = 0u, mine = 0u; bool ok = true;
#pragma unroll
    for (unsigned k = 0; k < 8; ++k) { const unsigned c = __hip_atomic_load(&bar[256 + 64 * k], __ATOMIC_RELAXED, __HIP_MEMORY_SCOPE_AGENT); sum += c; ok = ok && (c > 0u); mine = (k == myx) ? c : mine; }
    if (ok && sum == (unsigned)nblk && myx < 8u && myr < mine) { L.NL = 8; L.x = (int)myx; L.j = (int)myr; L.nloc = (int)mine; }
    L.NL = __builtin_amdgcn_readfirstlane(L.NL); L.x = __builtin_amdgcn_readfirstlane(L.x); L.j = __builtin_amdgcn_readfirstlane(L.j); L.nloc = __builtin_amdgcn_readfirstlane(L.nloc);
    return L;
}

typedef int i32x2 __attribute__((ext_vector_type(2)));
typedef _Float16 f16x2h __attribute__((ext_vector_type(2)));
struct DnIds { u32x4 i0, i1; };
constexpr int DTB = 32;
constexpr int DR_IDS = 0, DR_H = 8192, DN_REGION = 12288;
static_assert(8 * DN_REGION <= LDS_BYTES - 32, "down-pass staging regions");
__device__ void peer_down_phase(const Params& P, unsigned char* lds, int bid, int nblk) {
    const int tid0 = opaque_tid(), wid = __builtin_amdgcn_readfirstlane(tid0 >> 6);
    int lane_v = tid0 & 63;
    const signed char* ed8 = (const signed char*)(P.ws + WS_ED8); const signed char* h8 = (const signed char*)(P.ws + WS_H8);
    const bf16_t* ids16 = (const bf16_t*)(P.ws + WS_IDS16); int* part = (int*)(P.ws + WS_PART);
    const XLabel XL = xcd_label(P, lds, bid, nblk);
    const int NL = XL.NL, x = XL.x, j = XL.j, nloc = XL.nloc;
    const int nw = nloc * 8, widx = j * 8 + wid;
    const int per = (((NTOK + nw - 1) / nw) + DTB - 1) / DTB * DTB;
    const int t0 = widx * per, t1 = (t0 + per) < NTOK ? (t0 + per) : NTOK;
    if (t0 >= t1) return;
    unsigned char* R = lds + wid * DN_REGION;
    for (int s = x; s < 8; s += NL) {
        asm volatile("" : "+v"(lane_v));
        const int lane = lane_v, e = lane >> 3, ch = lane & 7;
        const bool c0 = (lane & 1) != 0, c1 = (lane & 2) != 0, c2 = (lane & 4) != 0;
        auto issueH = [&](u32x4 (&S)[8], const DnIds& c, const int hf) {
            const signed char* base = ed8 + (size_t)s * NEXP * 128 + 16 * ch;
#pragma unroll
            for (int b = 0; b < 8; ++b) {
                const unsigned word = hf ? c.i1[b >> 1] : c.i0[b >> 1];
                const unsigned id = (b & 1) ? (word >> 16) : (word & 0xffffu);
                S[b] = *(const u32x4*)(base + (size_t)id * 128);
            }
        };
        auto computeH = [&](const u32x4 (&S)[8], const u32x4& h, int (&d)[16], const int hf) {
#pragma unroll
            for (int b = 0; b < 8; ++b) {
                int t = 0;
                t = __builtin_amdgcn_sdot4((int)S[b].x, (int)h.x, t, false); t = __builtin_amdgcn_sdot4((int)S[b].y, (int)h.y, t, false);
                t = __builtin_amdgcn_sdot4((int)S[b].z, (int)h.z, t, false); t = __builtin_amdgcn_sdot4((int)S[b].w, (int)h.w, t, false);
                const int bb = 8 * hf + b;
                d[(bb >> 1) + 8 * (bb & 1)] = t;
            }
        };
        int nbn = DTB - 4 * wid;
        for (int blk = t0, nb; blk < t1; blk += nb, nbn = DTB) {
            nb = nbn;
            nb = (t1 - blk) < nb ? (t1 - blk) : nb;
            {
                u32x4 st[12];
                const char* gi = (const char*)ids16 + (size_t)blk * 256 + lane * 16;
#pragma unroll
                for (int k = 0; k < 8; ++k) st[k] = *(const u32x4*)(gi + k * 1024);
                const char* gh = (const char*)h8 + ((size_t)(blk + (lane >> 3)) * DM + 128 * s) + (lane & 7) * 16;
#pragma unroll
                for (int k = 0; k < 4; ++k) st[8 + k] = *(const u32x4*)(gh + (size_t)k * 8 * DM);
                unsigned char* Rl = R + lane * 16;
#pragma unroll
                for (int k = 0; k < 8; ++k) *(u32x4*)(Rl + DR_IDS + k * 1024) = st[k];
#pragma unroll
                for (int k = 0; k < 4; ++k) *(u32x4*)(Rl + DR_H + k * 1024) = st[8 + k];
            }
            auto ldsIds = [&](int tt) -> DnIds { const u32x4* p = (const u32x4*)(R + DR_IDS + tt * 256 + 32 * e); DnIds c; c.i0 = p[0]; c.i1 = p[1]; return c; };
            u32x4 HA[8], HB[8];
            {
                const DnIds ic = ldsIds(0);
                issueH(HA, ic, 0); __builtin_amdgcn_sched_barrier(0); issueH(HB, ic, 1);
                __builtin_amdgcn_sched_barrier(0);
            }
            auto iter = [&](const int tt, auto moreTag) -> unsigned {
                constexpr bool more = decltype(moreTag)::value;
                const DnIds inx = ldsIds(more ? tt + 1 : tt);
                const u32x4 hreg = *(const u32x4*)(R + DR_H + tt * 128 + 16 * ch);
                int d[16];
                computeH(HA, hreg, d, 0); __builtin_amdgcn_sched_barrier(0); if constexpr (more) issueH(HA, inx, 0); __builtin_amdgcn_sched_barrier(0);
                computeH(HB, hreg, d, 1); __builtin_amdgcn_sched_barrier(0); if constexpr (more) issueH(HB, inx, 1); __builtin_amdgcn_sched_barrier(0);
                int e8[8], f4[4], g2[2];
#pragma unroll
                for (int q = 0; q < 8; ++q) { const int keep = c0 ? d[2 * q + 1] : d[2 * q], send = c0 ? d[2 * q] : d[2 * q + 1]; e8[q] = keep + __shfl_xor(send, 1); }
#pragma unroll
                for (int q = 0; q < 4; ++q) { const int keep = c1 ? e8[2 * q + 1] : e8[2 * q], send = c1 ? e8[2 * q] : e8[2 * q + 1]; f4[q] = keep + __shfl_xor(send, 2); }
#pragma unroll
                for (int q = 0; q < 2; ++q) { const int keep = c2 ? f4[2 * q + 1] : f4[2 * q], send = c2 ? f4[2 * q] : f4[2 * q + 1]; g2[q] = keep + __shfl_xor(send, 4); }
                const auto pk = __builtin_amdgcn_cvt_pkrtz((float)g2[0] * 0.015625f, (float)g2[1] * 0.015625f);
                return __builtin_bit_cast(unsigned, pk);
            };
            u32x4* pq = (u32x4*)part + ((size_t)s * (NTOK / 4) + (size_t)(blk >> 2)) * 64 + lane;
            for (int tt = 0; tt + 4 < nb; tt += 4, pq += 64) {
                u32x4 o;
                o.x = iter(tt, std::true_type{}); o.y = iter(tt + 1, std::true_type{}); o.z = iter(tt + 2, std::true_type{}); o.w = iter(tt + 3, std::true_type{});
                *pq = o;
            }
            {
                u32x4 o;
                o.x = iter(nb - 4, std::true_type{}); o.y = iter(nb - 3, std::true_type{}); o.z = iter(nb - 2, std::true_type{}); o.w = iter(nb - 1, std::false_type{});
                *pq = o;
            }
        }
    }
}

__device__ __forceinline__ float gelu_erf(float v) {
    const float av = fabsf(v), t = __builtin_amdgcn_rcpf(av * 0.2316418882f + 1.0f);
    float q = t * 0.5307027145f + (-0.7265760135f); q = q * t + 0.7107068705f; q = q * t + (-0.142248368f); q = q * t + 0.127414796f; q = q * t;
    const float ex = __builtin_amdgcn_exp2f(v * v * (-0.72134752044f));
    const float m = v * (q * ex);
    return v < 0.f ? m : v - m;
}
__device__ void peer_combine_phase(const Params& P, unsigned char* lds, int bid, int nblk) {
    const int tid = opaque_tid(), wid = tid >> 6, lane = tid & 63;
    const int* part = (const int*)(P.ws + WS_PART);
    const float* SD = (const float*)(P.ws + WS_SD); const float* SU = (const float*)(P.ws + WS_SU); const float* HS = (const float*)(P.ws + WS_HS);
    const unsigned* ids16 = (const unsigned*)(P.ws + WS_IDS16); const unsigned* gates16 = (const unsigned*)(P.ws + WS_GATES16);
    unsigned short* wq = (unsigned short*)(P.ws + WS_WQ8); float* wsc = (float*)(P.ws + WS_WSC);
    static_assert(2 * NEXP * 4 <= LDS_BYTES - 32, "combine tables");
    float* sdL = (float*)lds; float* suL = sdL + NEXP;
    {
#pragma unroll
        for (int k = 0; k < 8; ++k) { const int o = (tid + 512 * k) * 4; *(f32x4*)(sdL + o) = *(const f32x4*)(SD + o); *(f32x4*)(suL + o) = *(const f32x4*)(SU + o); }
        __syncthreads();
    }
    constexpr int CU_ = 4;
    const int tstep = nblk * 8;
    for (int qd = bid * 8 + wid; qd < NTOK / 4; qd += tstep) {
        unsigned pv[CU_][8]; unsigned idp[CU_], gtp[CU_]; float hs[CU_]; int tk[CU_];
#pragma unroll
        for (int s = 0; s < 8; ++s) {
            const u32x4 q4 = *((const u32x4*)part + ((size_t)s * (NTOK / 4) + (size_t)qd) * 64 + lane);
            pv[0][s] = q4.x; pv[1][s] = q4.y; pv[2][s] = q4.z; pv[3][s] = q4.w;
        }
#pragma unroll
        for (int u = 0; u < CU_; ++u) {
            tk[u] = qd * 4 + u;
            idp[u] = ids16[(size_t)tk[u] * 64 + lane]; gtp[u] = gates16[(size_t)tk[u] * 64 + lane]; hs[u] = HS[tk[u]];
        }
        __builtin_amdgcn_sched_barrier(0);
        float sd0[CU_], sd1[CU_], su0[CU_], su1[CU_];
#pragma unroll
        for (int u = 0; u < CU_; ++u) { const unsigned id0 = idp[u] & 0xffffu, id1 = idp[u] >> 16; sd0[u] = sdL[id0]; sd1[u] = sdL[id1]; su0[u] = suL[id0]; su1[u] = suL[id1]; }
        __builtin_amdgcn_sched_barrier(0);
#pragma unroll
        for (int u = 0; u < CU_; ++u) {
            float a0 = 0.f, a1 = 0.f;
#pragma unroll
            for (int s = 0; s < 8; ++s) { const f16x2h hv = __builtin_bit_cast(f16x2h, pv[u][s]); a0 += (float)hv[0]; a1 += (float)hv[1]; }
            const float f0 = a0 * 64.0f * sd0[u] * hs[u], f1 = a1 * 64.0f * sd1[u] * hs[u];
            const float w0 = bflo(gtp[u]) * gelu_erf(f0) * su0[u], w1 = bfhi(gtp[u]) * gelu_erf(f1) * su1[u];
            float am = fmaxf(fabsf(w0), fabsf(w1));
            am = fmaxf(am, __shfl_xor(am, 1)); am = fmaxf(am, __shfl_xor(am, 2)); am = fmaxf(am, __shfl_xor(am, 4)); am = fmaxf(am, __shfl_xor(am, 16)); am = fmaxf(am, __shfl_xor(am, 32));
            am = am > 0.f ? am : 1.0f;
            const float inv = 127.0f / am;
            const int q0 = (int)rintf(w0 * inv), q1 = (int)rintf(w1 * inv);
            wq[(size_t)tk[u] * 64 + lane] = (unsigned short)((unsigned)(q0 & 255) | ((unsigned)(q1 & 255) << 8));
            if ((lane & 0x37) == 0) wsc[(size_t)tk[u] * 2 + (lane >> 3)] = am * (1.0f / 127.0f);
        }
    }
}

typedef float f32x2 __attribute__((ext_vector_type(2)));
typedef int i32x4 __attribute__((ext_vector_type(4)));
struct UpIds { u32x4 i0, i1; };
constexpr int UTB = 24;
constexpr int UR_IDS = 0, UR_WQ = UTB * 256, UR_DL = UR_WQ + UTB * 128, UR_SC = UR_DL + UTB * 256, UP_REGION = UR_SC + UTB * 8;
static_assert(8 * UP_REGION <= LDS_BYTES - 32, "up-pass staging regions");
__device__ void peer_up_phase(const Params& P, unsigned char* lds, int bid, int nblk) {
    const int tid0 = opaque_tid(), wid = __builtin_amdgcn_readfirstlane(tid0 >> 6);
    int lane_v = tid0 & 63;
    const signed char* eu8 = (const signed char*)(P.ws + WS_EU8);
    const bf16_t* dlt = (const bf16_t*)(P.ws + WS_DLT);
    const bf16_t* ids16 = (const bf16_t*)(P.ws + WS_IDS16); const signed char* wq8 = (const signed char*)(P.ws + WS_WQ8); const float* wsc = (const float*)(P.ws + WS_WSC);
    const float* mod = (const float*)(P.ws + WS_MOD);
    const XLabel XL = xcd_label(P, lds, bid, nblk);
    const int NL = XL.NL, x = XL.x, j = XL.j, nloc = XL.nloc;
    const int nw = nloc * 8, widx = j * 8 + wid;
    const int per = (((NTOK + nw - 1) / nw) + 7) / 8 * 8;
    const int t0 = widx * per, t1 = (t0 + per) < NTOK ? (t0 + per) : NTOK;
    if (t0 >= t1) return;
    unsigned char* R = lds + wid * UP_REGION;
    for (int s = x; s < 8; s += NL) {
        asm volatile("" : "+v"(lane_v));
        const int lane = lane_v, e = lane >> 3, ch = lane & 7;
        const bool hi = (lane & 8) != 0;
        const int col4p = 16 * ch + 4 * (lane >> 4);
        unsigned SEL[4][4];
#pragma unroll
        for (int r = 0; r < 4; ++r)
#pragma unroll
            for (int k = 0; k < 4; ++k)
                SEL[r][k] = (((lane & 15) >> 2) == r) ? ((0x0c0c0c0cu & ~(0xFFu << (8 * (lane & 3)))) | ((unsigned)k << (8 * (lane & 3)))) : 0x0c0c0c0cu;
        auto issueH = [&](u32x4 (&S)[8], const UpIds& c, const int hf) {
            const signed char* sbase = eu8 + (size_t)s * NEXP * 128;
            const unsigned choff = 16u * (unsigned)ch;
#pragma unroll
            for (int b = 0; b < 8; ++b) {
                const unsigned word = hf ? c.i1[b >> 1] : c.i0[b >> 1];
                const unsigned off = (b & 1) ? (((word >> 9) & 0x7FFF80u) | choff) : (((word << 7) & 0x7FFF80u) | choff);
                S[b] = *(const u32x4*)(sbase + off);
            }
        };
        auto computeH = [&](const u32x4 (&S)[8], const u32x4& wa, const u32x4& wb, i32x4& acc0, i32x4& acc1, const int hf) {
#pragma unroll
            for (int b = 0; b < 8; ++b) {
                const int bb = 8 * hf + b;
                const unsigned W0 = wa[bb >> 2], W1 = wb[bb >> 2];
                const i32x4 A0 = {(int)__builtin_amdgcn_perm(W0, W0, SEL[0][bb & 3]), (int)__builtin_amdgcn_perm(W0, W0, SEL[1][bb & 3]), (int)__builtin_amdgcn_perm(W0, W0, SEL[2][bb & 3]), (int)__builtin_amdgcn_perm(W0, W0, SEL[3][bb & 3])};
                const i32x4 A1 = {(int)__builtin_amdgcn_perm(W1, W1, SEL[0][bb & 3]), (int)__builtin_amdgcn_perm(W1, W1, SEL[1][bb & 3]), (int)__builtin_amdgcn_perm(W1, W1, SEL[2][bb & 3]), (int)__builtin_amdgcn_perm(W1, W1, SEL[3][bb & 3])};
                const i32x4 Bv = {(int)S[b].x, (int)S[b].y, (int)S[b].z, (int)S[b].w};
                acc0 = __builtin_amdgcn_mfma_i32_16x16x64_i8(A0, Bv, acc0, 0, 0, 0);
                acc1 = __builtin_amdgcn_mfma_i32_16x16x64_i8(A1, Bv, acc1, 0, 0, 0);
            }
        };
        int nbn = UTB - 2 * wid;
        for (int blk = t0, nb; blk < t1; blk += nb, nbn = UTB) {
            nb = nbn;
            nb = (t1 - blk) < nb ? (t1 - blk) : nb;
            nb = (2048 - (blk & 2047)) < nb ? (2048 - (blk & 2047)) : nb;
            {
                u32x4 st[UTB / 4 + UTB / 8 + UTB / 4];
                const u32x4 stsc = *(const u32x4*)((const char*)wsc + (size_t)blk * 8 + (lane & 15) * 16);
                const char* gi = (const char*)ids16 + (size_t)blk * 256 + lane * 16;
#pragma unroll
                for (int k = 0; k < UTB / 4; ++k) st[k] = *(const u32x4*)(gi + k * 1024);
                const char* gw = (const char*)wq8 + (size_t)blk * 128 + lane * 16;
#pragma unroll
                for (int k = 0; k < UTB / 8; ++k) st[UTB / 4 + k] = *(const u32x4*)(gw + k * 1024);
                const char* gd = (const char*)dlt + ((size_t)(blk + (lane >> 4)) * DM + 128 * s) * 2 + (lane & 15) * 16;
#pragma unroll
                for (int k = 0; k < UTB / 4; ++k) st[3 * UTB / 8 + k] = *(const u32x4*)(gd + (size_t)k * 4 * DM * 2);
                unsigned char* Rl = R + lane * 16;
#pragma unroll
                for (int k = 0; k < UTB / 4; ++k) *(u32x4*)(Rl + UR_IDS + k * 1024) = st[k];
#pragma unroll
                for (int k = 0; k < UTB / 8; ++k) *(u32x4*)(Rl + UR_WQ + k * 1024) = st[UTB / 4 + k];
#pragma unroll
                for (int k = 0; k < UTB / 4; ++k) *(u32x4*)(Rl + UR_DL + k * 1024) = st[3 * UTB / 8 + k];
                if (lane < UTB / 2) *(u32x4*)(Rl + UR_SC) = stsc;
            }
            const f32x4 g4 = *(const f32x4*)(mod + (blk >> 11) * 6144 + 5120 + 128 * s + col4p);
            auto ldsIds = [&](int tt) -> UpIds { const u32x4* p = (const u32x4*)(R + UR_IDS + tt * 256 + 32 * e); UpIds c; c.i0 = p[0]; c.i1 = p[1]; return c; };
            u32x4 HA[8], HB[8];
            {
                const UpIds ic = ldsIds(0);
                issueH(HA, ic, 0); __builtin_amdgcn_sched_barrier(0); issueH(HB, ic, 1);
                __builtin_amdgcn_sched_barrier(0);
            }
            auto iter = [&](const int tt, auto moreTag) -> f32x4 {
                constexpr bool more = decltype(moreTag)::value;
                const UpIds inx = ldsIds(more ? tt + 1 : tt);
                const u32x4* wp = (const u32x4*)(R + UR_WQ + tt * 128 + 32 * (lane >> 4));
                const u32x4 w0 = wp[0], w1 = wp[1];
                const float scl = *(const float*)(R + UR_SC + tt * 8 + (hi ? 4 : 0));
                i32x4 acc0 = {0, 0, 0, 0}, acc1 = {0, 0, 0, 0};
                computeH(HA, w0, w1, acc0, acc1, 0); __builtin_amdgcn_sched_barrier(0); if constexpr (more) issueH(HA, inx, 0); __builtin_amdgcn_sched_barrier(0);
                computeH(HB, w0, w1, acc0, acc1, 1); __builtin_amdgcn_sched_barrier(0); if constexpr (more) issueH(HB, inx, 1); __builtin_amdgcn_sched_barrier(0);
                f32x4 v;
#pragma unroll
                for (int r = 0; r < 4; ++r) v[r] = (float)(hi ? acc1[r] : acc0[r]) * scl;
                return v;
            };
            auto store2 = [&](const int tt, const f32x4& va, const f32x4& vb) {
                f32x4 y;
#pragma unroll
                for (int r = 0; r < 4; ++r) {
                    const float snd = hi ? va[r] : vb[r];
                    y[r] = (hi ? vb[r] : va[r]) + __uint_as_float(dpp_u32<0x128>(__float_as_uint(snd)));
                }
                const int tk = tt + (hi ? 1 : 0);
                const u32x2 dv = *(const u32x2*)(R + UR_DL + tk * 256 + 2 * col4p);
                f32x4 o;
                o[0] = bflo(dv.x) + g4[0] * y[0]; o[1] = bfhi(dv.x) + g4[1] * y[1]; o[2] = bflo(dv.y) + g4[2] * y[2]; o[3] = bfhi(dv.y) + g4[3] * y[3];
                *(f32x4*)(P.out + (size_t)(blk + tk) * DM + 128 * s + col4p) = o;
            };
            for (int tt = 0; tt + 2 < nb; tt += 2) { const f32x4 va = iter(tt, std::true_type{}); const f32x4 vb = iter(tt + 1, std::true_type{}); store2(tt, va, vb); }
            { const f32x4 va = iter(nb - 2, std::true_type{}); const f32x4 vb = iter(nb - 1, std::false_type{}); store2(nb - 2, va, vb); }
        }
    }
}

#define XB_TMO      128
#define XB_XCNT(j)  (256  + 64 * (j))
#define XB_XSUB(j)  (1280 + 64 * (j))
#define XB_XGEN(j)  (2304 + 64 * (j))
#define XB_TOP      3328
#define XB_TOPGEN   3392
#define XCD_BAR_WORDS 3456
#define XB_SPIN_CAP (1u << 23)
__device__ __forceinline__ unsigned xb_ld(unsigned* p)              { return __hip_atomic_load(p, __ATOMIC_RELAXED, __HIP_MEMORY_SCOPE_AGENT); }
__device__ __forceinline__ unsigned xb_add(unsigned* p, unsigned v) { return __hip_atomic_fetch_add(p, v, __ATOMIC_RELAXED, __HIP_MEMORY_SCOPE_AGENT); }
__device__ __forceinline__ unsigned xb_xcc_id() { return (unsigned)__builtin_amdgcn_s_getreg((3 << 11) | 20) & 0xFu; }
#define XB_SPIN(cond, bar) do { unsigned _sp = 0; while (cond) { __builtin_amdgcn_s_sleep(1); \
    if ((++_sp & 255u) == 0u) { if (xb_ld(&(bar)[XB_TMO])) break; if (_sp > XB_SPIN_CAP) { atomicAdd(&(bar)[XB_TMO], 1u); break; } } } } while (0)
struct XcdBarrier { unsigned* bar; unsigned x; volatile unsigned* st; };
__device__ __forceinline__ XcdBarrier xcd_barrier_post(unsigned* bar, volatile unsigned* st) {
    XcdBarrier b; b.bar = bar; b.x = xb_xcc_id(); b.st = st;
    if (threadIdx.x == 0) (void)xb_add(&bar[XB_XCNT(b.x)], 1u);
    return b;
}
__device__ __forceinline__ void xcd_barrier_complete(unsigned* bar, unsigned x, unsigned& nloc, unsigned& nx) {
    const unsigned G = gridDim.x * gridDim.y * gridDim.z;
    unsigned sum, cnt, mine, sp = 0u;
    for (;;) {
        sum = 0u; cnt = 0u; mine = 0u;
#pragma unroll
        for (unsigned j = 0; j < 16; ++j) { const unsigned c = xb_ld(&bar[XB_XCNT(j)]); sum += c; cnt += (c > 0u) ? 1u : 0u; mine = (j == x) ? c : mine; }
        if (sum == G) break;
        __builtin_amdgcn_s_sleep(1);
        if ((++sp & 255u) == 0u) { if (xb_ld(&bar[XB_TMO])) break; if (sp > XB_SPIN_CAP) { atomicAdd(&bar[XB_TMO], 1u); break; } }
    }
    nloc = mine > 0u ? mine : 1u; nx = cnt > 0u ? cnt : 1u;
}
__device__ __forceinline__ void xcd_barrier(const XcdBarrier& b) {
    asm volatile("s_waitcnt vmcnt(0)" ::: "memory");
    __syncthreads();
    if (threadIdx.x == 0) {
        unsigned* bar = b.bar;
        __builtin_amdgcn_s_waitcnt(0);
        unsigned nloc = b.st[0], nx = b.st[1];
        if (nloc == 0u) { xcd_barrier_complete(bar, b.x, nloc, nx); b.st[0] = nloc; b.st[1] = nx; }
        const unsigned old = xb_add(&bar[XB_XSUB(b.x)], 1u);
        const unsigned gen = old / nloc;
        if (old + 1u == (gen + 1u) * nloc) {
            __builtin_amdgcn_fence(__ATOMIC_RELEASE, "agent");
            asm volatile("s_waitcnt vmcnt(0)" ::: "memory");
            const unsigned og = xb_add(&bar[XB_TOP], 1u);
            const unsigned tg = og / nx;
            if (og + 1u == (tg + 1u) * nx) xb_add(&bar[XB_TOPGEN], 1u);
            else XB_SPIN(xb_ld(&bar[XB_TOPGEN]) == tg, bar);
            __builtin_amdgcn_fence(__ATOMIC_ACQUIRE, "agent");
            xb_add(&bar[XB_XGEN(b.x)], 1u);
            asm volatile("s_waitcnt vmcnt(0)" ::: "memory");
        } else {
            XB_SPIN(xb_ld(&bar[XB_XGEN(b.x)]) == gen, bar);
            __builtin_amdgcn_fence(__ATOMIC_ACQUIRE, "agent");
            asm volatile("s_waitcnt vmcnt(0)" ::: "memory");
        }
    }
    __syncthreads();
}

constexpr int NPHASES = 11;
__device__ __forceinline__ void run_phase(const Params& P, int ph, unsigned char* lds, int bid, int nblk) {
    const float* mod = (const float*)(P.ws + WS_MOD);
    switch (ph) {
        case 0: phase0(P, lds, bid, nblk); break;
        case 1: norm_mod_phase<true, false>(P, P.x, nullptr, nullptr, P.norm1_gain, mod, 0, 1024, (bf16_t*)(P.ws + WS_H), bid, nblk); break;
        case 2: {
            const bf16_t* h1 = (const bf16_t*)(P.ws + WS_H); const bf16_t* wt = (const bf16_t*)(P.ws + WS_WINT);
            EpiInAll e{EpiQK{P.q_gain, P.k_gain, (bf16_t*)(P.ws + WS_QA), (bf16_t*)(P.ws + WS_KA)}, EpiV{(bf16_t*)(P.ws + WS_VT)}, EpiBf{(bf16_t*)(P.ws + WS_PB), PBW}};
            gemm_run(h1, wt, NTOK, 3584, DM, e, lds, bid, nblk);
        } break;
        case 3: attn_phase(P, lds, bid, nblk); __syncthreads(); dn1_phase(P, lds, bid, nblk); break;
        case 4: dn2_phase(P, lds, bid, nblk); break;
        case 5: dn3_phase(P, lds, bid, nblk); break;
        case 6: {
            EpiOut e{mod, (bf16_t*)(P.ws + WS_DLT)};
            gemm_run((const bf16_t*)(P.ws + WS_H), (const bf16_t*)(P.ws + WS_WOUTT), NTOK, DM, DM, e, lds, bid, nblk);
        } break;
        case 7: norm_mod_phase<false, true>(P, P.x, (const bf16_t*)(P.ws + WS_DLT), P.out, P.norm2_gain, mod, 3072, 4096, (bf16_t*)(P.ws + WS_H), bid, nblk); break;
        case 8: {
            EpiBf e{(bf16_t*)(P.ws + WS_PB), 2048};
            gemm_run((const bf16_t*)(P.ws + WS_H), (const bf16_t*)(P.ws + WS_WQT), NTOK, 2048, DM, e, lds, bid, nblk);
        } break;
        case 9: route_phase(P, lds, bid, nblk); break;
        case 10: peer_down_phase(P, lds, bid, nblk); break;
        case 12: peer_combine_phase(P, lds, bid, nblk); break;
        case 11: peer_up_phase(P, lds, bid, nblk); break;
        default: break;
    }
}

#if MULTI_LAUNCH
template <int PH>
__global__ void __launch_bounds__(NTHREADS) k_phase(Params P) {
    __shared__ __attribute__((aligned(16))) unsigned char lds[LDS_BYTES];
    run_phase(P, PH, lds, blockIdx.x, gridDim.x);
}
#else
__global__ void __launch_bounds__(NTHREADS) k_mega(Params P) {
    __shared__ __attribute__((aligned(16))) unsigned char lds[LDS_BYTES];
    cg::grid_group grid = cg::this_grid();
    const int bid = blockIdx.x, nblk = gridDim.x;
    volatile unsigned* st = (volatile unsigned*)(lds + LDS_BYTES - 16);
    if (threadIdx.x == 0) {
        st[0] = 0u; st[1] = 0u;
        const unsigned xcc = xb_xcc_id();
        st[2] = xcc; st[3] = __hip_atomic_fetch_add((unsigned*)P.ws + XL_RANK(xcc & 7u), 1u, __ATOMIC_RELAXED, __HIP_MEMORY_SCOPE_AGENT);
    }
    __syncthreads();
    const XcdBarrier xb = xcd_barrier_post((unsigned*)P.ws, st);
#define PH_(N) run_phase(P, N, lds, bid, nblk)
#define XBAR() xcd_barrier(xb)
    if (P.ws == nullptr) grid.sync();
    PH_(0); XBAR(); PH_(1); XBAR(); PH_(2); XBAR(); PH_(3); XBAR(); PH_(4); XBAR(); PH_(5); XBAR();
    PH_(6); XBAR(); PH_(7); XBAR(); PH_(8); XBAR(); PH_(9); XBAR(); PH_(10); XBAR(); PH_(12); XBAR(); PH_(11);
#undef PH_
#undef XBAR
}
#endif

extern "C" void kernel_launch(void* const* d_in, const int* in_sizes, int n_in, void* d_out, int out_size, void* d_ws, size_t ws_size, hipStream_t stream) {
    static int grid = 0;
    if (grid == 0) {
        if (n_in != 22 || out_size != NTOK * DM || ws_size < WS_END) { fprintf(stderr, "kernel_launch: unexpected shapes (n_in %d out %d ws %zu)\n", n_in, out_size, ws_size); grid = -1; return; }
        int dev = 0, cus = 0, per_cu = 0;
        (void)hipGetDevice(&dev);
        (void)hipDeviceGetAttribute(&cus, hipDeviceAttributeMultiprocessorCount, dev);
#if MULTI_LAUNCH
        (void)hipOccupancyMaxActiveBlocksPerMultiprocessor(&per_cu, k_phase<3>, NTHREADS, 0);
#else
        (void)hipOccupancyMaxActiveBlocksPerMultiprocessor(&per_cu, k_mega, NTHREADS, 0);
#endif
        if (per_cu < 1) { fprintf(stderr, "kernel_launch: occupancy query says %d blocks per CU\n", per_cu); per_cu = 1; }
        grid = cus;
        (void)hipGetLastError();
    }
    if (grid < 0) return;
    Params p{};
    const float** pp = (const float**)&p;
    for (int i = 0; i < 22; ++i) pp[i] = (const float*)d_in[i];
    p.out = (float*)d_out; p.ws = (unsigned char*)d_ws;
#if MULTI_LAUNCH
    (void)hipMemsetAsync(d_ws, 0, 16384, stream);
#define LP_(PH) hipLaunchKernelGGL(k_phase<PH>, dim3(grid), dim3(NTHREADS), 0, stream, p)
    LP_(0); LP_(1); LP_(2); LP_(3); LP_(4); LP_(5); LP_(6); LP_(7); LP_(8); LP_(9); LP_(10); LP_(12); LP_(11);
#undef LP_
#else
    (void)hipMemsetAsync(d_ws, 0, 16384, stream);
    void* args[] = {&p};
    hipError_t e = hipLaunchCooperativeKernel((void*)k_mega, dim3(grid), dim3(NTHREADS), args, 0, stream);
    if (e != hipSuccess) fprintf(stderr, "cooperative launch failed: %s (grid %d)\n", hipGetErrorString(e), grid);
#endif
}
```
